# Optimizing an MI355X kernel written in HIP

```python
import math
import jax, jax.numpy as jnp
from jax import lax
import numpy as np

D_MODEL = 1024
BATCH = 16
SEQ = 4096
DEPTH = 2

CTX_LEN = 256
GRID_W = 64
N_BRANCH = 4
MIX_W = 256
GLA_HEADS = 4
GLA_DK = 32
GLA_DV = 64
GLA_RANK = 16
GLA_TAU = 16.0
HY_WIDTH = 256
HY_ORDER = 2
HY_BANDS = 16
HY_FEAT = 1 + 2 * HY_BANDS
HY_FFN = 64
HY_SHIFT = 0.05
HG_HEADS = 4
HG_DK = 64
HG_DV = 64
DA_HEADS = 4
DA_DK = 32
DA_DV = 64
ROPE_BASE = 10000.0
Q_BLOCK = 128
CHUNK = 64
N_EXPERTS = 16
EXPERT_FF = 1024
CAPACITY_FACTOR = 2
ADA_CHUNKS = 6
EPS = 1e-6
F_TINY = 1e-20

IN_NAMES = ('gla_q', 'gla_k', 'gla_v', 'gla_af', 'gla_ab', 'gla_g', 'hy',
            'hg_q', 'hg_ff', 'hg_fb', 'hg_i', 'hg_g', 'da_q', 'da_k', 'da_v', 'merge')
IN_WIDTHS = (GLA_HEADS * GLA_DK, GLA_HEADS * GLA_DK, GLA_HEADS * GLA_DV, GLA_RANK, GLA_RANK, GLA_HEADS * GLA_DV,
             (1 + HY_ORDER) * HY_WIDTH,
             HG_HEADS * HG_DK, HG_HEADS * HG_DK, HG_HEADS * HG_DK, HG_HEADS * HG_DV, HG_HEADS * HG_DV,
             DA_HEADS * 2 * DA_DK, DA_HEADS * 2 * DA_DK, DA_HEADS * DA_DV,
             N_BRANCH * D_MODEL)
N_IN = sum(IN_WIDTHS)

kernel_name = 'hybrid_flow_backbone'


def rms_norm(x, g):
    xf = x.astype(jnp.float32)
    y = xf * lax.rsqrt(jnp.mean(xf * xf, axis=-1, keepdims=True) + EPS)
    return (y * g.astype(jnp.float32)).astype(x.dtype)


def modulate(x, g, shift, scale):
    return rms_norm(x, g) * (1 + scale) + shift


def heads(t, n):
    B, L, W = t.shape
    return t.reshape(B, L, n, W // n).transpose(0, 2, 1, 3)


def merge_heads(t):
    B, H, L, d = t.shape
    return t.transpose(0, 2, 1, 3).reshape(B, L, H * d)


def short_conv(u, w):
    up = jnp.pad(u, ((0, 0), (1, 1), (0, 0)))
    return up[:, :-2] * w[0] + up[:, 1:-1] * w[1] + up[:, 2:] * w[2]


def chunk_recurrence(q, k, v, log_g, s0):
    B, H, L, dk = q.shape
    dv = v.shape[-1]
    n = L // CHUNK

    def to_chunks(t):
        return t.astype(jnp.float32).reshape(B, H, n, CHUNK, t.shape[-1]).transpose(2, 0, 1, 3, 4)

    mask = jnp.tril(jnp.ones((CHUNK, CHUNK), bool))[:, :, None]

    def step(S, xs):
        qc, kc, vc, gc = xs
        b = jnp.cumsum(gc, axis=-2)
        o_inter = jnp.einsum('bhtd,bhde->bhte', qc * jnp.exp(b), S)
        diff = b[:, :, :, None, :] - b[:, :, None, :, :]
        decay = jnp.where(mask, jnp.exp(jnp.where(mask, diff, 0.0)), 0.0)
        scores = jnp.einsum('bhtd,bhsd,bhtsd->bhts', qc, kc, decay)
        o_intra = jnp.einsum('bhts,bhse->bhte', scores, vc)
        b_end = b[:, :, -1:, :]
        S_new = jnp.exp(b_end[:, :, 0, :, None]) * S + jnp.einsum('bhsd,bhse->bhde', kc * jnp.exp(b_end - b), vc)
        return S_new, o_inter + o_intra

    S_fin, o = lax.scan(step, s0, (to_chunks(q), to_chunks(k), to_chunks(v), to_chunks(log_g)))
    o = o.transpose(1, 2, 0, 3, 4).reshape(B, H, L, dv)
    return o.astype(v.dtype), S_fin


def bidir_recurrence(ctx_in, lat_in):
    qc, kfc, kbc, vc, gfc, gbc = ctx_in
    ql, kfl, kbl, vl, gfl, gbl = lat_in
    B, H, _, dk = qc.shape
    s0 = jnp.zeros((B, H, dk, vc.shape[-1]), jnp.float32)
    flip = lambda t: jnp.flip(t, axis=2)
    oc_f, sc_f = chunk_recurrence(qc, kfc, vc, gfc, s0)
    ol_f, _ = chunk_recurrence(ql, kfl, vl, gfl, sc_f)
    oc_b, sc_b = chunk_recurrence(flip(qc), flip(kbc), flip(vc), flip(gbc), s0)
    ol_b, _ = chunk_recurrence(flip(ql), flip(kbl), flip(vl), flip(gbl), sc_b)
    return oc_f + flip(oc_b), ol_f + flip(ol_b)


def gla_inputs(parts, wa2, ba):
    q = heads(parts['gla_q'], GLA_HEADS) * (GLA_DK ** -0.5)
    k = heads(parts['gla_k'], GLA_HEADS)
    v = heads(parts['gla_v'], GLA_HEADS)
    gf = heads(jax.nn.log_sigmoid((parts['gla_af'] @ wa2[0] + ba[0]).astype(jnp.float32)) / GLA_TAU, GLA_HEADS)
    gb = heads(jax.nn.log_sigmoid((parts['gla_ab'] @ wa2[1] + ba[1]).astype(jnp.float32)) / GLA_TAU, GLA_HEADS)
    return (q, k, k, v, gf, gb)


def hgrn_inputs(parts, lb):
    q = heads(jax.nn.silu(parts['hg_q']), HG_HEADS)
    v = heads(parts['hg_i'], HG_HEADS)
    res = []
    for d, name in enumerate(('hg_ff', 'hg_fb')):
        z = parts[name].astype(jnp.float32)
        f = lb[d] + (1 - lb[d]) * jax.nn.sigmoid(z)
        log_f = jnp.log(jnp.maximum(f, F_TINY))
        k = (1 - lb[d]) * jax.nn.sigmoid(-z)
        res.append((heads(k, HG_HEADS), heads(log_f, HG_HEADS)))
    (kf, gf), (kb, gb) = res
    return (q, kf, kb, v, gf, gb)


def gated_branch(o, g, gate):
    return merge_heads(rms_norm(o, g)) * jax.nn.silu(gate)


def hyena_filters(L, p):
    j = jnp.arange(L, dtype=jnp.float32)
    t = j / max(L - 1, 1)
    w = 2 * math.pi * j / L
    f = jnp.linspace(1e-4, HY_BANDS - 1, HY_BANDS, dtype=jnp.float32)
    feats = jnp.concatenate([t[:, None], jnp.cos(w[:, None] * f), -jnp.sin(w[:, None] * f)], axis=-1)
    h = jnp.sin(p['hy_freq'][0] * (feats @ p['hy_w1'] + p['hy_b1']))
    h = jnp.sin(p['hy_freq'][1] * (h @ p['hy_w2'] + p['hy_b2']))
    h = (h @ p['hy_w3']).astype(jnp.float32)
    dist = jnp.abs(j - L // 2) / (L // 2)
    h = h * (jnp.exp(-dist[:, None] * jnp.abs(p['hy_decay'].astype(jnp.float32))) + HY_SHIFT)
    h = h / jnp.sum(jnp.abs(h), axis=0, keepdims=True)
    return h.reshape(L, HY_ORDER, HY_WIDTH)


def fft_conv(u, h):
    L = u.shape[1]
    n = 2 * L
    U = jnp.fft.rfft(u.astype(jnp.float32), n=n, axis=1)
    Hf = jnp.fft.rfft(h, n=n, axis=0)
    y = jnp.fft.irfft(U * Hf[None], n=n, axis=1)[:, L // 2: L // 2 + L]
    return y.astype(u.dtype)


def hyena_branch(u3, p):
    L = u3.shape[1]
    v, x1, x2 = jnp.split(short_conv(u3, p['hy_conv_w']), 1 + HY_ORDER, axis=-1)
    h = hyena_filters(L, p)
    z = v
    for o, gate in enumerate((x1, x2)):
        z = gate * (fft_conv(z, h[:, o]) + p['hy_bias'][o] * z)
    return z


def rope_axis(t, pos):
    half = t.shape[-1] // 2
    freqs = ROPE_BASE ** (-jnp.arange(half, dtype=jnp.float32) / half)
    ang = pos.astype(jnp.float32)[:, None] * freqs
    cos, sin = jnp.cos(ang).astype(t.dtype), jnp.sin(ang).astype(t.dtype)
    t1, t2 = t[..., :half], t[..., half:]
    return jnp.concatenate([t1 * cos - t2 * sin, t1 * sin + t2 * cos], axis=-1)


def rope2d(t, row, col):
    a = t.shape[-1] // 2
    return jnp.concatenate([rope_axis(t[..., :a], row), rope_axis(t[..., a:], col)], axis=-1)


def da_qk(t, g):
    B, L, _ = t.shape
    t = rms_norm(t.reshape(B, L, DA_HEADS, 2, DA_DK), g).transpose(0, 2, 1, 3, 4)
    return t[..., 0, :], t[..., 1, :]


def diff_attend(q1, q2, k1, k2, v, lam):
    B, H, Lq, d = q1.shape
    nb = Lq // Q_BLOCK
    scale = d ** -0.5

    def blocks(t):
        return t.reshape(B, H, nb, Q_BLOCK, d).transpose(2, 0, 1, 3, 4)

    def one(qs):
        qa, qb = qs
        p1 = jax.nn.softmax(jnp.einsum('bhqd,bhkd->bhqk', qa, k1).astype(jnp.float32) * scale, axis=-1)
        p2 = jax.nn.softmax(jnp.einsum('bhqd,bhkd->bhqk', qb, k2).astype(jnp.float32) * scale, axis=-1)
        return jnp.einsum('bhqk,bhkd->bhqd', (p1 - lam * p2).astype(v.dtype), v)

    o = lax.map(one, (blocks(q1), blocks(q2)))
    return o.transpose(1, 2, 0, 3, 4).reshape(B, H, Lq, v.shape[-1])


def merge_branches(outs, gate_cols, w_branch, w_out):
    B, L, _ = gate_cols.shape
    gates = jax.nn.sigmoid(gate_cols.reshape(B, L, N_BRANCH, D_MODEL))
    merged = gates[:, :, 0] * (outs[0] @ w_branch[0])
    for i in range(1, N_BRANCH):
        merged = merged + gates[:, :, i] * (outs[i] @ w_branch[i])
    return merged @ w_out


def token_mixer(hc, hx, p, lb, row, col, lam_init, last):
    split_idx = np.cumsum(IN_WIDTHS)[:-1].tolist()
    pc = dict(zip(IN_NAMES, jnp.split(hc @ p['w_in'], split_idx, axis=-1)))
    px = dict(zip(IN_NAMES, jnp.split(hx @ p['w_in'], split_idx, axis=-1)))
    gla_c, gla_x = bidir_recurrence(gla_inputs(pc, p['gla_wa2'], p['gla_ba']), gla_inputs(px, p['gla_wa2'], p['gla_ba']))
    hg_c, hg_x = bidir_recurrence(hgrn_inputs(pc, lb), hgrn_inputs(px, lb))
    q1c, q2c = da_qk(pc['da_q'], p['da_qnorm_g'])
    k1c, k2c = da_qk(pc['da_k'], p['da_knorm_g'])
    vc = heads(pc['da_v'], DA_HEADS)
    q1x, q2x = [rope2d(t, row, col) for t in da_qk(px['da_q'], p['da_qnorm_g'])]
    k1x, k2x = [rope2d(t, row, col) for t in da_qk(px['da_k'], p['da_knorm_g'])]
    vx = heads(px['da_v'], DA_HEADS)
    lp = p['da_lam'].astype(jnp.float32)
    lam = jnp.exp(jnp.sum(lp[0] * lp[1])) - jnp.exp(jnp.sum(lp[2] * lp[3])) + lam_init
    cat = lambda a, b: jnp.concatenate([a, b], axis=2)
    da_x = diff_attend(q1x, q2x, cat(k1c, k1x), cat(k2c, k2x), cat(vc, vx), lam)

    def finish(parts, gla_o, hg_o, da_o):
        outs = (gated_branch(gla_o, p['gla_norm_g'], parts['gla_g']),
                hyena_branch(parts['hy'], p),
                gated_branch(hg_o, p['hg_norm_g'], parts['hg_g']),
                merge_heads(rms_norm(da_o, p['da_norm_g']) * (1 - lam_init)))
        return merge_branches(outs, parts['merge'], p['w_branch'], p['w_out'])

    mx = finish(px, gla_x, hg_x, da_x)
    if last:
        return None, mx
    da_c = diff_attend(q1c, q2c, k1c, k2c, vc, lam)
    return finish(pc, gla_c, hg_c, da_c), mx


def expert_choice_moe(h, router, w1, w3, w2):
    B, L, D = h.shape
    cap = CAPACITY_FACTOR * L // N_EXPERTS
    aff = jax.nn.softmax((h @ router).astype(jnp.float32), axis=-1)
    g, idx = lax.top_k(aff.transpose(0, 2, 1), cap)
    xg = jax.vmap(lambda hb, ib: hb[ib])(h, idx)
    a = jnp.einsum('becd,edf->becf', xg, w1)
    b = jnp.einsum('becd,edf->becf', xg, w3)
    y = jnp.einsum('becf,efd->becd', jax.nn.silu(a) * b, w2) * g[..., None].astype(h.dtype)
    return jax.vmap(lambda yb, ib: jnp.zeros((L, D), h.dtype).at[ib.reshape(-1)].add(yb.reshape(-1, D)))(y, idx)


def setup_inputs(seed: int = 0) -> dict:
    key = jax.random.key(seed)
    ks = jax.random.split(key, 34)
    D = D_MODEL
    nrm = lambda k, shape, s: jax.random.normal(k, shape, jnp.float32) * s
    return {
        'x': nrm(ks[0], (BATCH, SEQ, D), 1.0),
        'c': nrm(ks[1], (BATCH, D), 1.0),
        'ctx': nrm(ks[2], (BATCH, CTX_LEN, D), 1.0),
        'c_ctx': nrm(ks[3], (D,), 1.0),
        'ada_w': nrm(ks[4], (DEPTH, D, ADA_CHUNKS * D), 0.5 * D ** -0.5),
        'ada_b': nrm(ks[5], (DEPTH, ADA_CHUNKS * D), 0.02),
        'norm1_g': 1 + nrm(ks[6], (DEPTH, D), 0.02),
        'norm2_g': 1 + nrm(ks[7], (DEPTH, D), 0.02),
        'w_in': nrm(ks[8], (DEPTH, D, N_IN), D ** -0.5),
        'gla_wa2': nrm(ks[9], (DEPTH, 2, GLA_RANK, GLA_HEADS * GLA_DK), GLA_RANK ** -0.5),
        'gla_ba': nrm(ks[10], (DEPTH, 2, GLA_HEADS * GLA_DK), 0.1),
        'gla_norm_g': 1 + nrm(ks[11], (DEPTH, GLA_DV), 0.02),
        'hy_conv_w': nrm(ks[12], (DEPTH, 3, (1 + HY_ORDER) * HY_WIDTH), 3 ** -0.5),
        'hy_w1': nrm(ks[13], (DEPTH, HY_FEAT, HY_FFN), HY_FEAT ** -0.5),
        'hy_b1': nrm(ks[14], (DEPTH, HY_FFN), 0.1),
        'hy_w2': nrm(ks[15], (DEPTH, HY_FFN, HY_FFN), HY_FFN ** -0.5),
        'hy_b2': nrm(ks[16], (DEPTH, HY_FFN), 0.1),
        'hy_w3': nrm(ks[17], (DEPTH, HY_FFN, HY_ORDER * HY_WIDTH), HY_FFN ** -0.5),
        'hy_freq': 1 + nrm(ks[18], (DEPTH, 2, HY_FFN), 0.02),
        'hy_decay': jnp.linspace(3.0, 15.0, HY_ORDER * HY_WIDTH, dtype=jnp.float32)[None] + nrm(ks[19], (DEPTH, HY_ORDER * HY_WIDTH), 0.1),
        'hy_bias': nrm(ks[20], (DEPTH, HY_ORDER, HY_WIDTH), 0.5),
        'hg_lower': nrm(ks[21], (DEPTH, 2, HG_HEADS * HG_DK), 0.1),
        'hg_norm_g': 1 + nrm(ks[22], (DEPTH, HG_DV), 0.02),
        'da_qnorm_g': 1 + nrm(ks[23], (DEPTH, DA_DK), 0.02),
        'da_knorm_g': 1 + nrm(ks[24], (DEPTH, DA_DK), 0.02),
        'da_lam': nrm(ks[25], (DEPTH, 4, DA_DK), 0.1),
        'da_norm_g': 1 + nrm(ks[26], (DEPTH, DA_DV), 0.02),
        'w_branch': nrm(ks[27], (DEPTH, N_BRANCH, MIX_W, D), MIX_W ** -0.5),
        'w_out': nrm(ks[28], (DEPTH, D, D), D ** -0.5),
        'moe_router': nrm(ks[29], (DEPTH, D, N_EXPERTS), D ** -0.5),
        'moe_w1': nrm(ks[30], (DEPTH, N_EXPERTS, D, EXPERT_FF), D ** -0.5),
        'moe_w3': nrm(ks[31], (DEPTH, N_EXPERTS, D, EXPERT_FF), D ** -0.5),
        'moe_w2': nrm(ks[32], (DEPTH, N_EXPERTS, EXPERT_FF, D), EXPERT_FF ** -0.5),
    }


def reference(x, c, ctx, c_ctx, ada_w, ada_b, norm1_g, norm2_g, w_in, gla_wa2, gla_ba, gla_norm_g,
              hy_conv_w, hy_w1, hy_b1, hy_w2, hy_b2, hy_w3, hy_freq, hy_decay, hy_bias,
              hg_lower, hg_norm_g, da_qnorm_g, da_knorm_g, da_lam, da_norm_g, w_branch, w_out,
              moe_router, moe_w1, moe_w3, moe_w2):
    L = x.shape[1]
    ROWS = L // GRID_W
    row = jnp.repeat(jnp.arange(ROWS), GRID_W)
    col = jnp.tile(jnp.arange(GRID_W), ROWS)
    P = jax.nn.softmax(hg_lower.astype(jnp.float32), axis=0)
    lower = jnp.cumsum(P, axis=0) - P[0]
    sc = jax.nn.silu(c)
    scc = jax.nn.silu(c_ctx)
    xc, xx = ctx, x
    for l in range(DEPTH):
        last = l == DEPTH - 1
        lam_init = 0.8 - 0.6 * math.exp(-0.3 * l)
        p = {'w_in': w_in[l], 'gla_wa2': gla_wa2[l], 'gla_ba': gla_ba[l], 'gla_norm_g': gla_norm_g[l],
             'hy_conv_w': hy_conv_w[l], 'hy_w1': hy_w1[l], 'hy_b1': hy_b1[l], 'hy_w2': hy_w2[l], 'hy_b2': hy_b2[l],
             'hy_w3': hy_w3[l], 'hy_freq': hy_freq[l], 'hy_decay': hy_decay[l], 'hy_bias': hy_bias[l],
             'hg_norm_g': hg_norm_g[l], 'da_qnorm_g': da_qnorm_g[l], 'da_knorm_g': da_knorm_g[l],
             'da_lam': da_lam[l], 'da_norm_g': da_norm_g[l], 'w_branch': w_branch[l], 'w_out': w_out[l]}
        mod_x = jnp.split((sc @ ada_w[l] + ada_b[l])[:, None, :], ADA_CHUNKS, axis=-1)
        mod_c = jnp.split((scc @ ada_w[l] + ada_b[l])[None, None, :], ADA_CHUNKS, axis=-1)
        hx = modulate(xx, norm1_g[l], mod_x[0], mod_x[1])
        hc = modulate(xc, norm1_g[l], mod_c[0], mod_c[1])
        mc, mx = token_mixer(hc, hx, p, lower[l], row, col, lam_init, last)
        xx = xx + mod_x[2] * mx
        hx = modulate(xx, norm2_g[l], mod_x[3], mod_x[4])
        xx = xx + mod_x[5] * expert_choice_moe(hx, moe_router[l], moe_w1[l], moe_w3[l], moe_w2[l])
        if not last:
            xc = xc + mod_c[2] * mc
            hc = modulate(xc, norm2_g[l], mod_c[3], mod_c[4])
            xc = xc + mod_c[5] * expert_choice_moe(hc, moe_router[l], moe_w1[l], moe_w3[l], moe_w2[l])
    return xx
```

```cpp
#include <hip/hip_runtime.h>
#include <stdint.h>

#ifndef FUSED
#define FUSED 0
#endif

typedef unsigned short bf16_t;
typedef short bf16x8 __attribute__((ext_vector_type(8)));
typedef float f32x4 __attribute__((ext_vector_type(4)));
typedef unsigned u32x4 __attribute__((ext_vector_type(4)));
typedef unsigned u32x2 __attribute__((ext_vector_type(2)));

#define NTHR 512
constexpr int D = 1024, NB = 16, LQ = 4096, LC = 256, TT = 4352, NLAYER = 2;
constexpr int BG = 8, NGRP = NB / BG, R = BG * TT;
constexpr int NP1 = 3840;
constexpr int C_GQ = 0, C_GK = 128, C_GV = 256, C_GAF = 512, C_GAB = 528, C_GG = 544, C_HY = 800, C_HQ = 1568, C_HFF = 1824, C_HFB = 2080,
              C_HI = 2336, C_HGG = 2592, C_DQ = 2848, C_DK = 3104, C_DV = 3360, C_MG = 3616, N_IN = 7712;
constexpr int NEXP = 16, CAPL = 512, CAPC = 32, LATS = BG * NEXP * CAPL, NSLOT = LATS + BG * NEXP * CAPC;
constexpr int SMEM_BYTES = 114688;

constexpr size_t al256(size_t x) { return (x + 255) & ~(size_t)255; }
constexpr size_t OFF_BAR = 0;
constexpr size_t OFF_BTIN1 = 65536;
constexpr size_t OFF_BTGATE = OFF_BTIN1 + (size_t)NLAYER * NP1 * D * 2;
constexpr size_t OFF_BTBR = OFF_BTGATE + (size_t)NLAYER * 4096 * D * 2;
constexpr size_t OFF_BTOUT = OFF_BTBR + (size_t)NLAYER * 4 * 1024 * 256 * 2;
constexpr size_t OFF_BTW13 = OFF_BTOUT + (size_t)NLAYER * D * D * 2;
constexpr size_t OFF_BTW2 = OFF_BTW13 + (size_t)NLAYER * NEXP * 2048 * D * 2;
constexpr size_t OFF_MODX = OFF_BTW2 + (size_t)NLAYER * NEXP * D * D * 2;
constexpr size_t OFF_MODC = OFF_MODX + (size_t)NLAYER * NB * 6144 * 4;
constexpr size_t OFF_HRAW = OFF_MODC + (size_t)NLAYER * 6144 * 4;
constexpr size_t HRAW_L = (size_t)512 * (LQ + LC);
constexpr size_t OFF_PSUM = OFF_HRAW + (size_t)NLAYER * HRAW_L * 4;
constexpr size_t OFF_XC = OFF_PSUM + (size_t)NLAYER * 68 * 512 * 4;
constexpr size_t OFF_HX = OFF_XC + (size_t)NB * LC * D * 4;
constexpr size_t OFF_BIG = OFF_HX + (size_t)R * D * 2;
constexpr size_t BIG_BYTES = (size_t)2 * NSLOT * D * 2;
constexpr size_t OFF_OUTS = OFF_BIG + BIG_BYTES;
constexpr size_t OFF_QA = OFF_OUTS + (size_t)R * D * 2;
constexpr size_t OFF_KA = OFF_QA + (size_t)BG * 4 * TT * 64 * 2;
constexpr size_t OFF_VA = OFF_KA + (size_t)BG * 4 * TT * 64 * 2;
constexpr size_t OFF_OBUF = OFF_VA + (size_t)BG * 4 * TT * 64 * 2;
constexpr size_t OFF_HYT = OFF_OBUF + (size_t)4 * R * 256 * 4;
constexpr size_t OFF_AFF = OFF_HYT + (size_t)BG * 768 * TT * 4;
constexpr size_t OFF_INV = OFF_AFF + (size_t)BG * NEXP * TT * 4;
constexpr size_t OFF_SIDX = OFF_INV + (size_t)R * NEXP * 4;
constexpr size_t OFF_SGV = OFF_SIDX + (size_t)NSLOT * 4;
constexpr size_t WS_END = OFF_SGV + (size_t)NSLOT * 4;
static_assert(WS_END < (size_t)1000 * 1024 * 1024, "workspace too big");
static_assert(BIG_BYTES >= (size_t)R * NP1 * 2, "big region");

struct P {
    const float* in[33];
    float* out;
    char* ws;
};

__device__ __forceinline__ bf16_t f2bf(float f) { unsigned u = __float_as_uint(f); u += 0x7fffu + ((u >> 16) & 1u); return (bf16_t)(u >> 16); }
__device__ __forceinline__ float bf2f(bf16_t h) { return __uint_as_float((unsigned)h << 16); }
__device__ __forceinline__ unsigned pack2(float a, float b) { return (unsigned)f2bf(a) | ((unsigned)f2bf(b) << 16); }
__device__ __forceinline__ float sigmoidf_(float x) { return 1.0f / (1.0f + __expf(-x)); }
__device__ __forceinline__ float siluf_(float x) { return x / (1.0f + __expf(-x)); }
__device__ __forceinline__ float wave_sum(float v) {
#pragma unroll
    for (int o = 32; o > 0; o >>= 1) v += __shfl_xor(v, o);
    return v;
}

template <class T> __device__ __forceinline__ T* wsp(const P& p, size_t off) { return (T*)(p.ws + off); }

__device__ __forceinline__ const float* stream_src(const P& p, int l, int b, int pp) {
    if (pp < LC) return (l == 0 ? p.in[2] : wsp<const float>(p, OFF_XC)) + ((size_t)b * LC + pp) * D;
    return (l == 0 ? p.in[0] : (const float*)p.out) + ((size_t)b * LQ + (pp - LC)) * D;
}
__device__ __forceinline__ float* stream_dst(const P& p, int b, int pp) {
    if (pp < LC) return wsp<float>(p, OFF_XC) + ((size_t)b * LC + pp) * D;
    return p.out + ((size_t)b * LQ + (pp - LC)) * D;
}

__device__ void xpose_job(const float* __restrict__ src, int ldS, int K, int N, bf16_t* __restrict__ dst, int mode, int which, float* tile) {
    const int tid = threadIdx.x;
    const int tk = K / 64, tn = (N + 63) / 64, nt = tk * tn;
    for (int t = blockIdx.x; t < nt; t += gridDim.x) {
        const int k0 = (t % tk) * 64, n0 = (t / tk) * 64;
        __syncthreads();
#pragma unroll
        for (int ps = 0; ps < 2; ++ps) {
            const int i = (tid >> 4) + 32 * ps, j4 = (tid & 15) * 4;
            f32x4 v = {0.f, 0.f, 0.f, 0.f};
            if (n0 + j4 < N) v = *(const f32x4*)(src + (size_t)(k0 + i) * ldS + n0 + j4);
            tile[i * 65 + j4 + 0] = v[0]; tile[i * 65 + j4 + 1] = v[1]; tile[i * 65 + j4 + 2] = v[2]; tile[i * 65 + j4 + 3] = v[3];
        }
        __syncthreads();
        const int n = tid >> 3, kc = (tid & 7) * 8;
        if (n0 + n < N) {
            const int ng = n0 + n;
            const int drow = mode == 0 ? ng : ((ng >> 4) * 32 + which * 16 + (ng & 15));
            u32x4 w;
            w[0] = pack2(tile[(kc + 0) * 65 + n], tile[(kc + 1) * 65 + n]);
            w[1] = pack2(tile[(kc + 2) * 65 + n], tile[(kc + 3) * 65 + n]);
            w[2] = pack2(tile[(kc + 4) * 65 + n], tile[(kc + 5) * 65 + n]);
            w[3] = pack2(tile[(kc + 6) * 65 + n], tile[(kc + 7) * 65 + n]);
            *(u32x4*)(dst + (size_t)drow * K + k0 + kc) = w;
        }
    }
}

__device__ void ph_weights(const P& p, char* smem) {
    float* tile = (float*)smem;
    for (int l = 0; l < NLAYER; ++l) {
        const float* win = p.in[8] + (size_t)l * D * N_IN;
        bf16_t* bt1 = wsp<bf16_t>(p, OFF_BTIN1) + (size_t)l * NP1 * D;
        xpose_job(win, N_IN, D, C_MG, bt1, 0, 0, tile);
        for (size_t i = (size_t)blockIdx.x * NTHR + threadIdx.x; i < (size_t)(NP1 - C_MG) * D / 8; i += (size_t)gridDim.x * NTHR)
            *(u32x4*)(bt1 + (size_t)C_MG * D + i * 8) = (u32x4){0u, 0u, 0u, 0u};
        xpose_job(win + C_MG, N_IN, D, 4096, wsp<bf16_t>(p, OFF_BTGATE) + (size_t)l * 4096 * D, 0, 0, tile);
        for (int i = 0; i < 4; ++i)
            xpose_job(p.in[27] + ((size_t)l * 4 + i) * 256 * D, D, 256, D, wsp<bf16_t>(p, OFF_BTBR) + ((size_t)l * 4 + i) * 1024 * 256, 0, 0, tile);
        xpose_job(p.in[28] + (size_t)l * D * D, D, D, D, wsp<bf16_t>(p, OFF_BTOUT) + (size_t)l * D * D, 0, 0, tile);
        for (int e = 0; e < NEXP; ++e) {
            const size_t le = (size_t)l * NEXP + e;
            xpose_job(p.in[30] + le * D * D, D, D, D, wsp<bf16_t>(p, OFF_BTW13) + le * 2048 * D, 1, 0, tile);
            xpose_job(p.in[31] + le * D * D, D, D, D, wsp<bf16_t>(p, OFF_BTW13) + le * 2048 * D, 1, 1, tile);
            xpose_job(p.in[32] + le * D * D, D, D, D, wsp<bf16_t>(p, OFF_BTW2) + le * D * D, 0, 0, tile);
        }
    }
}

__device__ void ph_mod(const P& p, char* smem) {
    float* s = (float*)smem;
    float* red = s + 17 * 1024;
    const int tid = threadIdx.x;
    for (int i = tid; i < 17 * 1024; i += NTHR) { const float v = i < 16384 ? p.in[1][i] : p.in[3][i - 16384]; s[i] = siluf_(v); }
    __syncthreads();
    for (int u = blockIdx.x; u < NLAYER * 96; u += gridDim.x) {
        const int l = u / 96, col = (u % 96) * 64 + (tid & 63), ks = tid >> 6;
        const float* w = p.in[4] + (size_t)l * D * 6144 + col;
        float acc[17];
#pragma unroll
        for (int r = 0; r < 17; ++r) acc[r] = 0.f;
        for (int k = ks * 128; k < ks * 128 + 128; ++k) {
            const float wv = w[(size_t)k * 6144];
#pragma unroll
            for (int r = 0; r < 17; ++r) acc[r] += s[r * 1024 + k] * wv;
        }
#pragma unroll
        for (int r = 0; r < 17; ++r) red[(ks * 17 + r) * 64 + (tid & 63)] = acc[r];
        __syncthreads();
        for (int i = tid; i < 17 * 64; i += NTHR) {
            const int r = i / 64, c = i % 64, cg = (u % 96) * 64 + c;
            float v = p.in[5][(size_t)l * 6144 + cg];
#pragma unroll
            for (int q = 0; q < 8; ++q) v += red[(q * 17 + r) * 64 + c];
            if (r < 16) wsp<float>(p, OFF_MODX)[((size_t)l * NB + r) * 6144 + cg] = v;
            else wsp<float>(p, OFF_MODC)[(size_t)l * 6144 + cg] = v;
        }
        __syncthreads();
    }
}

__device__ void ph_hfilt(const P& p, char* smem) {
    float* feats = (float*)smem;
    float* h1 = feats + 64 * 33;
    float* h2 = h1 + 64 * 64;
    const int tid = threadIdx.x;
    for (int u = blockIdx.x; u < NLAYER * 68; u += gridDim.x) {
        const int l = u / 68, ub = u % 68, w = ub >= 64 ? 1 : 0, jb = w ? ub - 64 : ub, L = w ? LC : LQ;
        __syncthreads();
        for (int i = tid; i < 64 * 33; i += NTHR) {
            const int pos = i / 33, fi = i % 33; const float j = (float)(jb * 64 + pos);
            float v;
            if (fi == 0) v = j / (float)(L - 1);
            else {
                const int k = (fi - 1) & 15; const float f = 1e-4f + (float)k * ((15.0f - 1e-4f) / 15.0f);
                const float wv = 6.283185307179586f * j / (float)L;
                v = fi <= 16 ? cosf(wv * f) : -sinf(wv * f);
            }
            feats[i] = v;
        }
        __syncthreads();
        const float* w1 = p.in[13] + (size_t)l * 33 * 64; const float* b1 = p.in[14] + l * 64;
        const float* w2 = p.in[15] + (size_t)l * 64 * 64; const float* b2 = p.in[16] + l * 64;
        const float* w3 = p.in[17] + (size_t)l * 64 * 512; const float* fr = p.in[18] + l * 128;
        for (int i = tid; i < 64 * 64; i += NTHR) {
            const int pos = i >> 6, k = i & 63; float a = b1[k];
            for (int f = 0; f < 33; ++f) a += feats[pos * 33 + f] * w1[f * 64 + k];
            h1[i] = sinf(fr[k] * a);
        }
        __syncthreads();
        for (int i = tid; i < 64 * 64; i += NTHR) {
            const int pos = i >> 6, k = i & 63; float a = b2[k];
            for (int f = 0; f < 64; ++f) a += h1[pos * 64 + f] * w2[f * 64 + k];
            h2[i] = sinf(fr[64 + k] * a);
        }
        __syncthreads();
        {
            const int n = tid; float asum = 0.f;
            const float dec = fabsf(p.in[19][(size_t)l * 512 + n]);
            float* hr = wsp<float>(p, OFF_HRAW) + (size_t)l * HRAW_L + (w ? (size_t)512 * LQ : 0) + (size_t)n * L + jb * 64;
            for (int pos = 0; pos < 64; ++pos) {
                float a = 0.f;
                for (int k = 0; k < 64; ++k) a += h2[pos * 64 + k] * w3[k * 512 + n];
                const int j = jb * 64 + pos; const float dist = fabsf((float)(j - L / 2)) / (float)(L / 2);
                a *= __expf(-dist * dec) + 0.05f;
                hr[pos] = a; asum += fabsf(a);
            }
            wsp<float>(p, OFF_PSUM)[((size_t)l * 68 + ub) * 512 + n] = asum;
        }
    }
}

template <int WHICH>
__device__ void ph_norm(const P& p, int l, int grp, char* smem) {
    const int tid = threadIdx.x, lane = tid & 63, wid = tid >> 6;
    float* rt = (float*)smem;
    if (WHICH == 1) {
        const float* rsrc = p.in[29] + (size_t)l * D * NEXP;
        for (int i = tid; i < D * NEXP / 4; i += NTHR) ((f32x4*)rt)[i] = ((const f32x4*)rsrc)[i];
        __syncthreads();
    }
    const float* gain = p.in[WHICH ? 7 : 6] + (size_t)l * D;
    bf16_t* hx = wsp<bf16_t>(p, OFF_HX);
    for (int r = blockIdx.x * 8 + wid; r < R; r += gridDim.x * 8) {
        const int bl = r / TT, pp = r % TT, b = grp * BG + bl; const bool isctx = pp < LC;
        if (WHICH == 1 && l == NLAYER - 1 && isctx) continue;
        const float* src = WHICH == 0 ? stream_src(p, l, b, pp) : (const float*)stream_dst(p, b, pp);
        const float* mod = isctx ? wsp<const float>(p, OFF_MODC) + (size_t)l * 6144 : wsp<const float>(p, OFF_MODX) + ((size_t)l * NB + b) * 6144;
        const float* shp = mod + (WHICH ? 3 : 0) * D; const float* scp = mod + (WHICH ? 4 : 1) * D;
        f32x4 x[4]; float ss = 0.f;
#pragma unroll
        for (int i = 0; i < 4; ++i) { x[i] = *(const f32x4*)(src + i * 256 + lane * 4); ss += x[i][0] * x[i][0] + x[i][1] * x[i][1] + x[i][2] * x[i][2] + x[i][3] * x[i][3]; }
        ss = wave_sum(ss);
        const float rs = rsqrtf(ss * (1.0f / D) + 1e-6f);
        float lg[NEXP];
#pragma unroll
        for (int e = 0; e < NEXP; ++e) lg[e] = 0.f;
#pragma unroll
        for (int i = 0; i < 4; ++i) {
            const int c = i * 256 + lane * 4;
            const f32x4 g = *(const f32x4*)(gain + c), sh = *(const f32x4*)(shp + c), sc = *(const f32x4*)(scp + c);
            f32x4 y;
#pragma unroll
            for (int j = 0; j < 4; ++j) y[j] = x[i][j] * rs * g[j] * (1.0f + sc[j]) + sh[j];
            u32x2 w; w[0] = pack2(y[0], y[1]); w[1] = pack2(y[2], y[3]);
            *(u32x2*)(hx + (size_t)r * D + c) = w;
            if (WHICH == 1) {
#pragma unroll
                for (int j = 0; j < 4; ++j) {
#pragma unroll
                    for (int e4 = 0; e4 < 4; ++e4) { const f32x4 rv = *(const f32x4*)(rt + (c + j) * NEXP + e4 * 4);
                        lg[e4 * 4 + 0] += y[j] * rv[0]; lg[e4 * 4 + 1] += y[j] * rv[1]; lg[e4 * 4 + 2] += y[j] * rv[2]; lg[e4 * 4 + 3] += y[j] * rv[3]; }
                }
            }
        }
        if (WHICH == 1) {
            float mx = -1e30f;
#pragma unroll
            for (int e = 0; e < NEXP; ++e) { lg[e] = wave_sum(lg[e]); mx = fmaxf(mx, lg[e]); }
            float sum = 0.f, mine = 0.f;
#pragma unroll
            for (int e = 0; e < NEXP; ++e) { const float ev = __expf(lg[e] - mx); sum += ev; mine = (lane == e) ? ev : mine; }
            if (lane < NEXP) {
                float* aff = wsp<float>(p, OFF_AFF);
                if (isctx) aff[(size_t)BG * NEXP * LQ + ((size_t)bl * NEXP + lane) * LC + pp] = mine / sum;
                else aff[((size_t)bl * NEXP + lane) * LQ + (pp - LC)] = mine / sum;
                wsp<int>(p, OFF_INV)[(size_t)r * NEXP + lane] = -1;
            }
        }
    }
}

template <int WR, int WC, int MT, int NT>
struct GC {
    static constexpr int BM = WR * MT * 16, BN = WC * NT * 16, ROWB = 144;
    static constexpr int A_BYTES = BM * ROWB, B_BYTES = BN * ROWB, STAGE = A_BYTES + B_BYTES;
    static constexpr int A_CH = BM * 8 / NTHR, B_CH = BN * 8 / NTHR;
    static_assert(2 * STAGE <= SMEM_BYTES, "lds");
    template <class AR, class BR>
    static __device__ __forceinline__ void run(char* smem, AR arow, BR brow, int K, f32x4 (&acc)[MT][NT]) {
        const int tid = threadIdx.x, lane = tid & 63, wid = tid >> 6, wr = wid / WC, wc = wid % WC, fr = lane & 15, fq = lane >> 4;
        const bf16_t* ap[A_CH]; const bf16_t* bp[B_CH]; int aoff[A_CH], boff[B_CH];
#pragma unroll
        for (int i = 0; i < A_CH; ++i) { const int c = tid + NTHR * i, row = c >> 3, kc = c & 7; ap[i] = arow(row) + kc * 8; aoff[i] = row * ROWB + kc * 16; }
#pragma unroll
        for (int i = 0; i < B_CH; ++i) { const int c = tid + NTHR * i, row = c >> 3, kc = c & 7; bp[i] = brow(row) + kc * 8; boff[i] = A_BYTES + row * ROWB + kc * 16; }
        u32x4 ra[A_CH], rb[B_CH];
        const int nk = K / 64;
#pragma unroll
        for (int i = 0; i < A_CH; ++i) ra[i] = *(const u32x4*)(ap[i]);
#pragma unroll
        for (int i = 0; i < B_CH; ++i) rb[i] = *(const u32x4*)(bp[i]);
        __syncthreads();
#pragma unroll
        for (int i = 0; i < A_CH; ++i) *(u32x4*)(smem + aoff[i]) = ra[i];
#pragma unroll
        for (int i = 0; i < B_CH; ++i) *(u32x4*)(smem + boff[i]) = rb[i];
        __syncthreads();
        for (int kt = 0; kt < nk; ++kt) {
            const char* cur = smem + (kt & 1) * STAGE; char* nxt = smem + ((kt + 1) & 1) * STAGE;
            if (kt + 1 < nk) {
#pragma unroll
                for (int i = 0; i < A_CH; ++i) ra[i] = *(const u32x4*)(ap[i] + (kt + 1) * 64);
#pragma unroll
                for (int i = 0; i < B_CH; ++i) rb[i] = *(const u32x4*)(bp[i] + (kt + 1) * 64);
            }
#pragma unroll
            for (int kk = 0; kk < 2; ++kk) {
                bf16x8 af[MT], bfr[NT];
#pragma unroll
                for (int m = 0; m < MT; ++m) af[m] = *(const bf16x8*)(cur + (wr * MT * 16 + m * 16 + fr) * ROWB + kk * 64 + fq * 16);
#pragma unroll
                for (int n = 0; n < NT; ++n) bfr[n] = *(const bf16x8*)(cur + A_BYTES + (wc * NT * 16 + n * 16 + fr) * ROWB + kk * 64 + fq * 16);
#pragma unroll
                for (int m = 0; m < MT; ++m)
#pragma unroll
                    for (int n = 0; n < NT; ++n) acc[m][n] = __builtin_amdgcn_mfma_f32_16x16x32_bf16(bfr[n], af[m], acc[m][n], 0, 0, 0);
            }
            if (kt + 1 < nk) {
#pragma unroll
                for (int i = 0; i < A_CH; ++i) *(u32x4*)(nxt + aoff[i]) = ra[i];
#pragma unroll
                for (int i = 0; i < B_CH; ++i) *(u32x4*)(nxt + boff[i]) = rb[i];
            }
            __syncthreads();
        }
    }
};
typedef GC<4, 2, 4, 4> GBig;
typedef GC<2, 4, 4, 2> GSq;

#define ZERO_ACC(acc, MT, NT) _Pragma("unroll") for (int _m = 0; _m < MT; ++_m) _Pragma("unroll") for (int _n = 0; _n < NT; ++_n) acc[_m][_n] = (f32x4){0.f, 0.f, 0.f, 0.f}

__device__ void ph_g1(const P& p, int l, char* smem) {
    const int tid = threadIdx.x, lane = tid & 63, wid = tid >> 6, wr = wid / 2, wc = wid % 2, fr = lane & 15, fq = lane >> 4;
    const bf16_t* hx = wsp<const bf16_t>(p, OFF_HX);
    const bf16_t* bt = wsp<const bf16_t>(p, OFF_BTIN1) + (size_t)l * NP1 * D;
    bf16_t* proj = wsp<bf16_t>(p, OFF_BIG);
    constexpr int NPN = NP1 / 128;
    for (int u = blockIdx.x; u < (R / 256) * NPN; u += gridDim.x) {
        const int pm = u / NPN, pn = u % NPN;
        f32x4 acc[4][4]; ZERO_ACC(acc, 4, 4);
        GBig::run(smem, [&](int i) { return hx + (size_t)(pm * 256 + i) * D; }, [&](int i) { return bt + (size_t)(pn * 128 + i) * D; }, D, acc);
#pragma unroll
        for (int m = 0; m < 4; ++m) {
            const int row = pm * 256 + wr * 64 + m * 16 + fr;
#pragma unroll
            for (int n = 0; n < 4; ++n) {
                const int col = pn * 128 + wc * 64 + n * 16 + fq * 4;
                u32x2 w; w[0] = pack2(acc[m][n][0], acc[m][n][1]); w[1] = pack2(acc[m][n][2], acc[m][n][3]);
                *(u32x2*)(proj + (size_t)row * NP1 + col) = w;
            }
        }
    }
}

__device__ void ph_attn_prep(const P& p, int l) {
    const int tid = threadIdx.x, lane = tid & 63, wid = tid >> 6;
    const bf16_t* proj = wsp<const bf16_t>(p, OFF_BIG);
    bf16_t* Qa = wsp<bf16_t>(p, OFF_QA); bf16_t* Ka = wsp<bf16_t>(p, OFF_KA); bf16_t* Va = wsp<bf16_t>(p, OFF_VA);
    const int j = lane & 7, d0 = j * 4;
    const float* gq = p.in[23] + l * 32; const float* gk = p.in[24] + l * 32;
    for (int r = blockIdx.x * 8 + wid; r < R; r += gridDim.x * 8) {
        const int bl = r / TT, pp = r % TT; const bool lat = pp >= LC; const int t = pp - LC;
        const int h = lane >> 4;
        float cs[4], sn[4];
        if (lat) {
            const float pos = (float)((j < 4) ? (t >> 6) : (t & 63));
#pragma unroll
            for (int c = 0; c < 4; ++c) { const int i = (j & 1) * 4 + c; const float fq_ = exp2f(-(float)i * (13.287712379549449f / 8.0f)); sincosf(pos * fq_, &sn[c], &cs[c]); }
        }
#pragma unroll
        for (int which = 0; which < 2; ++which) {
            const u32x2 raw = *(const u32x2*)(proj + (size_t)r * NP1 + (which ? C_DK : C_DQ) + lane * 4);
            float v[4] = {bf2f((bf16_t)(raw[0] & 0xffff)), bf2f((bf16_t)(raw[0] >> 16)), bf2f((bf16_t)(raw[1] & 0xffff)), bf2f((bf16_t)(raw[1] >> 16))};
            float ss = v[0] * v[0] + v[1] * v[1] + v[2] * v[2] + v[3] * v[3];
            ss += __shfl_xor(ss, 1); ss += __shfl_xor(ss, 2); ss += __shfl_xor(ss, 4);
            const float rs = rsqrtf(ss * (1.0f / 32.0f) + 1e-6f);
            const float* g = which ? gk : gq;
#pragma unroll
            for (int c = 0; c < 4; ++c) v[c] = v[c] * rs * g[d0 + c];
            if (lat) {
#pragma unroll
                for (int c = 0; c < 4; ++c) {
                    const float o = __shfl_xor(v[c], 2);
                    v[c] = (j & 2) ? (o * sn[c] + v[c] * cs[c]) : (v[c] * cs[c] - o * sn[c]);
                }
            }
            u32x2 w; w[0] = pack2(v[0], v[1]); w[1] = pack2(v[2], v[3]);
            *(u32x2*)((which ? Ka : Qa) + (((size_t)bl * 4 + h) * TT + pp) * 64 + (lane & 15) * 4) = w;
        }
        *(u32x2*)(Va + (((size_t)bl * 4 + h) * TT + pp) * 64 + (lane & 15) * 4) = *(const u32x2*)(proj + (size_t)r * NP1 + C_DV + lane * 4);
    }
}

__device__ void ph_hy_prep(const P& p, int l, char* smem) {
    float* tile = (float*)smem;
    const int tid = threadIdx.x;
    const bf16_t* proj = wsp<const bf16_t>(p, OFF_BIG);
    float* hyT = wsp<float>(p, OFF_HYT);
    const float* cw = p.in[12] + (size_t)l * 3 * 768;
    constexpr int NTT = TT / 64;
    for (int u = blockIdx.x; u < BG * NTT * 12; u += gridDim.x) {
        const int ct = u % 12, tt = (u / 12) % NTT, bl = u / (12 * NTT);
        const int p0 = tt * 64; const bool lat = p0 >= LC; const int seg0 = lat ? LC : 0, segL = lat ? LQ : LC;
        __syncthreads();
        for (int i = tid; i < 66 * 16; i += NTHR) {
            const int rr = i >> 4, c4 = (i & 15) * 4; const int pp = p0 - 1 + rr;
            float v[4] = {0.f, 0.f, 0.f, 0.f};
            if (pp >= seg0 && pp < seg0 + segL) {
                const u32x2 raw = *(const u32x2*)(proj + (size_t)(bl * TT + pp) * NP1 + C_HY + ct * 64 + c4);
                v[0] = bf2f((bf16_t)(raw[0] & 0xffff)); v[1] = bf2f((bf16_t)(raw[0] >> 16)); v[2] = bf2f((bf16_t)(raw[1] & 0xffff)); v[3] = bf2f((bf16_t)(raw[1] >> 16));
            }
            tile[rr * 65 + c4] = v[0]; tile[rr * 65 + c4 + 1] = v[1]; tile[rr * 65 + c4 + 2] = v[2]; tile[rr * 65 + c4 + 3] = v[3];
        }
        __syncthreads();
        const int ch = tid >> 3, t8 = (tid & 7) * 8, cg = ct * 64 + ch;
        const float w0 = cw[cg], w1 = cw[768 + cg], w2 = cw[1536 + cg];
        float o[8];
#pragma unroll
        for (int q = 0; q < 8; ++q) { const int rr = t8 + q + 1; o[q] = tile[(rr - 1) * 65 + ch] * w0 + tile[rr * 65 + ch] * w1 + tile[(rr + 1) * 65 + ch] * w2; }
        float* dst = lat ? hyT + ((size_t)bl * 768 + cg) * LQ + (p0 - LC) + t8 : hyT + (size_t)BG * 768 * LQ + ((size_t)bl * 768 + cg) * LC + p0 + t8;
        *(f32x4*)dst = (f32x4){o[0], o[1], o[2], o[3]}; *(f32x4*)(dst + 4) = (f32x4){o[4], o[5], o[6], o[7]};
    }
}

template <int DK>
__device__ void recur_unit(const P& p, int l, int bl, int h, int br, int dir, char* smem) {
    constexpr int DPL = DK / 8;
    float* qS = (float*)smem;
    float* kS = qS + 64 * DK;
    float* gS = kS + 64 * DK;
    float* vS = gS + 64 * DK;
    float* oS = vS + 64 * 64;
    const int tid = threadIdx.x, lane = tid & 63, wid = tid >> 6;
    const bf16_t* proj = wsp<const bf16_t>(p, OFF_BIG);
    float* obuf = wsp<float>(p, OFF_OBUF) + ((size_t)dir * 2 + br) * R * 256;
    const int e = wid * 8 + (lane & 7), d0 = (lane >> 3) * DPL;
    float S[DPL];
#pragma unroll
    for (int j = 0; j < DPL; ++j) S[j] = 0.f;
    const float* wa2 = p.in[9] + ((size_t)l * 2 + dir) * 16 * 128; const float* ba = p.in[10] + ((size_t)l * 2 + dir) * 128;
    const float* hl = p.in[21];
    for (int ch = 0; ch < TT / 64; ++ch) {
        __syncthreads();
        for (int i = tid; i < 64 * DK; i += NTHR) {
            const int tk = i / DK, d = i % DK, n = ch * 64 + tk;
            const int pp = dir == 0 ? n : (n < LC ? LC - 1 - n : LC + (LQ - 1 - (n - LC)));
            const bf16_t* row = proj + (size_t)(bl * TT + pp) * NP1;
            float q, k, g;
            if (br == 0) {
                q = bf2f(row[C_GQ + h * 32 + d]) * 0.17677669529663687f; k = bf2f(row[C_GK + h * 32 + d]);
                float z = ba[h * 32 + d];
#pragma unroll
                for (int rr = 0; rr < 16; ++rr) z += bf2f(row[(dir ? C_GAB : C_GAF) + rr]) * wa2[rr * 128 + h * 32 + d];
                const float ls = fminf(z, 0.f) - log1pf(__expf(-fabsf(z)));
                g = __expf(ls * (1.0f / 16.0f));
            } else {
                q = siluf_(bf2f(row[C_HQ + h * 64 + d]));
                const float z = bf2f(row[(dir ? C_HFB : C_HFF) + h * 64 + d]);
                float lb = 0.f;
                if (l == 1) { const float a0 = hl[(0 * 2 + dir) * 256 + h * 64 + d], a1 = hl[(1 * 2 + dir) * 256 + h * 64 + d]; lb = 1.0f / (1.0f + __expf(a0 - a1)); }
                g = fmaxf(lb + (1.0f - lb) * sigmoidf_(z), 1e-20f);
                k = (1.0f - lb) * sigmoidf_(-z);
            }
            qS[i] = q; kS[i] = k; gS[i] = g;
        }
        for (int i = tid; i < 64 * 64; i += NTHR) {
            const int tk = i >> 6, ee = i & 63, n = ch * 64 + tk;
            const int pp = dir == 0 ? n : (n < LC ? LC - 1 - n : LC + (LQ - 1 - (n - LC)));
            vS[i] = bf2f(proj[(size_t)(bl * TT + pp) * NP1 + (br == 0 ? C_GV : C_HI) + h * 64 + ee]);
        }
        __syncthreads();
        for (int tk = 0; tk < 64; ++tk) {
            const float v = vS[tk * 64 + e]; float o = 0.f;
#pragma unroll
            for (int j = 0; j < DPL; ++j) {
                S[j] = gS[tk * DK + d0 + j] * S[j] + kS[tk * DK + d0 + j] * v;
                o += S[j] * qS[tk * DK + d0 + j];
            }
            o += __shfl_xor(o, 8); o += __shfl_xor(o, 16); o += __shfl_xor(o, 32);
            if ((lane >> 3) == 0) oS[tk * 64 + e] = o;
        }
        __syncthreads();
        {
            const int tk = tid >> 3, e8 = (tid & 7) * 8, n = ch * 64 + tk;
            const int pp = dir == 0 ? n : (n < LC ? LC - 1 - n : LC + (LQ - 1 - (n - LC)));
            float* dst = obuf + (size_t)(bl * TT + pp) * 256 + h * 64 + e8;
            *(f32x4*)dst = *(const f32x4*)(oS + tk * 64 + e8); *(f32x4*)(dst + 4) = *(const f32x4*)(oS + tk * 64 + e8 + 4);
        }
    }
}

template <int L>
__device__ void hyena_unit(const P& p, int l, int bl, int c, char* smem) {
    constexpr int W = L == LQ ? 0 : 1, NU = L / 64;
    float* upad = (float*)smem;
    float* hS = upad + 2 * L;
    const int tid = threadIdx.x;
    const float* hyT = wsp<const float>(p, OFF_HYT) + (W ? (size_t)BG * 768 * LQ : 0) + (size_t)bl * 768 * L;
    const float* hraw = wsp<const float>(p, OFF_HRAW) + (size_t)l * HRAW_L + (W ? (size_t)512 * LQ : 0);
    const float* psum = wsp<const float>(p, OFF_PSUM) + (size_t)l * 68 * 512 + (W ? 64 * 512 : 0);
    bf16_t* outs = wsp<bf16_t>(p, OFF_OUTS);
    const bool act = tid * 8 < L; const int t0 = tid * 8;
    float z[8];
    __syncthreads();
    for (int i = tid; i < 2 * L; i += NTHR) { const int s = i - L / 2; upad[i] = (s >= 0 && s < L) ? hyT[(size_t)c * L + s] : 0.f; }
    if (act) {
#pragma unroll
        for (int i = 0; i < 8; ++i) z[i] = hyT[(size_t)c * L + t0 + i];
    }
    for (int o = 0; o < 2; ++o) {
        const int n = o * 256 + c;
        float sc = 0.f;
        for (int q = 0; q < NU; ++q) sc += psum[q * 512 + n];
        const float inv = 1.0f / sc;
        for (int i = tid; i < L; i += NTHR) hS[i] = hraw[(size_t)n * L + i];
        __syncthreads();
        float acc[8];
#pragma unroll
        for (int i = 0; i < 8; ++i) acc[i] = 0.f;
        if (act) {
            float hi[8], lo[8];
            const float* wp = upad + t0 + L - 8;
#pragma unroll
            for (int m = 0; m < 8; ++m) hi[m] = wp[8 + m];
            for (int J = 0; J < L / 8; ++J) {
                const f32x4 l0 = *(const f32x4*)(wp - 8 * J), l1 = *(const f32x4*)(wp - 8 * J + 4);
                lo[0] = l0[0]; lo[1] = l0[1]; lo[2] = l0[2]; lo[3] = l0[3]; lo[4] = l1[0]; lo[5] = l1[1]; lo[6] = l1[2]; lo[7] = l1[3];
                const f32x4 h0 = *(const f32x4*)(hS + 8 * J), h1 = *(const f32x4*)(hS + 8 * J + 4);
                const float hv[8] = {h0[0], h0[1], h0[2], h0[3], h1[0], h1[1], h1[2], h1[3]};
#pragma unroll
                for (int jj = 0; jj < 8; ++jj)
#pragma unroll
                    for (int i = 0; i < 8; ++i) { const int m = i - jj + 8; acc[i] += hv[jj] * (m >= 8 ? hi[m - 8] : lo[m]); }
#pragma unroll
                for (int m = 0; m < 8; ++m) hi[m] = lo[m];
            }
        }
        const float bias = p.in[20][((size_t)l * 2 + o) * 256 + c];
        if (act) {
#pragma unroll
            for (int i = 0; i < 8; ++i) { const float gate = hyT[(size_t)((o + 1) * 256 + c) * L + t0 + i]; z[i] = gate * (acc[i] * inv + bias * z[i]); }
        }
        __syncthreads();
        if (o == 0) {
            if (act) {
#pragma unroll
                for (int i = 0; i < 8; ++i) upad[L / 2 + t0 + i] = z[i];
            }
        } else if (act) {
#pragma unroll
            for (int i = 0; i < 8; ++i) outs[(size_t)(bl * TT + (W ? 0 : LC) + t0 + i) * D + 256 + c] = f2bf(z[i]);
        }
        __syncthreads();
    }
}

__device__ void attn_unit(const P& p, int l, int bl, int h, int q0, int nkeys, char* smem) {
    float* Ks = (float*)smem;
    float* Vs = Ks + 64 * 64;
    const int tid = threadIdx.x, which = tid & 1;
    const bf16_t* Qa = wsp<const bf16_t>(p, OFF_QA) + ((size_t)bl * 4 + h) * TT * 64;
    const bf16_t* Ka = wsp<const bf16_t>(p, OFF_KA) + ((size_t)bl * 4 + h) * TT * 64;
    const bf16_t* Va = wsp<const bf16_t>(p, OFF_VA) + ((size_t)bl * 4 + h) * TT * 64;
    const int ln32 = tid & 31;
    float gqm = fabsf(p.in[23][l * 32 + ln32]), gkm = fabsf(p.in[24][l * 32 + ln32]);
#pragma unroll
    for (int o = 16; o > 0; o >>= 1) { gqm = fmaxf(gqm, __shfl_xor(gqm, o)); gkm = fmaxf(gkm, __shfl_xor(gkm, o)); }
    const float scale = 0.17677669529663687f, Mx = 32.0f * scale * gqm * gkm;
    const float* lp = p.in[25] + (size_t)l * 128;
    float s01 = lp[ln32] * lp[32 + ln32], s23 = lp[64 + ln32] * lp[96 + ln32];
#pragma unroll
    for (int o = 16; o > 0; o >>= 1) { s01 += __shfl_xor(s01, o); s23 += __shfl_xor(s23, o); }
    const float lam_init = 0.8f - 0.6f * expf(-0.3f * (float)l);
    const float lam = expf(s01) - expf(s23) + lam_init;
    const int qp = q0 + (tid >> 1);
    float q[32], O[64], ls = 0.f;
#pragma unroll
    for (int i = 0; i < 32; ++i) q[i] = bf2f(Qa[(size_t)qp * 64 + which * 32 + i]) * scale;
#pragma unroll
    for (int i = 0; i < 64; ++i) O[i] = 0.f;
    for (int k0 = 0; k0 < nkeys; k0 += 64) {
        __syncthreads();
        {
            const int key = tid >> 3, c8 = (tid & 7) * 8;
            const u32x4 kr = *(const u32x4*)(Ka + (size_t)(k0 + key) * 64 + c8), vr = *(const u32x4*)(Va + (size_t)(k0 + key) * 64 + c8);
#pragma unroll
            for (int i = 0; i < 4; ++i) {
                Ks[key * 64 + c8 + 2 * i] = __uint_as_float(kr[i] << 16); Ks[key * 64 + c8 + 2 * i + 1] = __uint_as_float(kr[i] & 0xffff0000u);
                Vs[key * 64 + c8 + 2 * i] = __uint_as_float(vr[i] << 16); Vs[key * 64 + c8 + 2 * i + 1] = __uint_as_float(vr[i] & 0xffff0000u);
            }
        }
        __syncthreads();
#pragma unroll 1
        for (int key = 0; key < 64; ++key) {
            float a = 0.f;
#pragma unroll
            for (int i = 0; i < 32; i += 4) {
                const f32x4 kk = *(const f32x4*)(Ks + key * 64 + which * 32 + i);
                a += q[i] * kk[0] + q[i + 1] * kk[1] + q[i + 2] * kk[2] + q[i + 3] * kk[3];
            }
            const float pr = __expf(a - Mx);
            ls += pr;
#pragma unroll
            for (int i = 0; i < 64; i += 4) {
                const f32x4 v = *(const f32x4*)(Vs + key * 64 + i);
                O[i] += pr * v[0]; O[i + 1] += pr * v[1]; O[i + 2] += pr * v[2]; O[i + 3] += pr * v[3];
            }
        }
    }
    asm volatile("" ::: "memory");
    {
        const float w = (which ? -lam : 1.0f) / ls; float ss = 0.f;
#pragma unroll
        for (int i = 0; i < 64; ++i) { const float t = O[i] * w; O[i] = t + __shfl_xor(t, 1); ss += O[i] * O[i]; }
        const float rs = rsqrtf(ss * (1.0f / 64.0f) + 1e-6f) * (1.0f - lam_init);
        const float* gn = p.in[26] + l * 64;
        bf16_t* dst = wsp<bf16_t>(p, OFF_OUTS) + (size_t)(bl * TT + qp) * D + 768 + h * 64;
#pragma unroll
        for (int i = 0; i < 64; i += 8) {
            if ((i >> 5) == which) {
                u32x4 w4;
#pragma unroll
                for (int j = 0; j < 4; ++j) w4[j] = pack2(O[i + 2 * j] * rs * gn[i + 2 * j], O[i + 2 * j + 1] * rs * gn[i + 2 * j + 1]);
                *(u32x4*)(dst + i) = w4;
            }
        }
    }
}

__device__ void ph_recur(const P& p, int l, char* smem) {
    const int NR = BG * 4 * 2 * 2;
    for (int u = blockIdx.x; u < NR; u += gridDim.x) {
        const int dir = u & 1, br = (u >> 1) & 1, h = (u >> 2) & 3, bl = u >> 4;
        if (br == 0) recur_unit<32>(p, l, bl, h, 0, dir, smem); else recur_unit<64>(p, l, bl, h, 1, dir, smem);
    }
}
__device__ void ph_attn(const P& p, int l, char* smem) {
    const bool last = l == NLAYER - 1;
    const int per = 16 + (last ? 0 : 1), NA = BG * 4 * per;
    for (int u = blockIdx.x; u < NA; u += gridDim.x) {
        const int qb = u % per, h = (u / per) & 3, bl = u / (per * 4);
        if (qb < 16) attn_unit(p, l, bl, h, LC + qb * 256, TT, smem);
        else attn_unit(p, l, bl, h, 0, LC, smem);
    }
}
__device__ void ph_hyena(const P& p, int l, char* smem) {
    const bool last = l == NLAYER - 1;
    const int NHL = BG * 256, NHC = last ? 0 : BG * 256;
    for (int u = blockIdx.x; u < NHL + NHC; u += gridDim.x) {
        if (u < NHL) hyena_unit<LQ>(p, l, u / 256, u % 256, smem);
        else { const int v = u - NHL; hyena_unit<LC>(p, l, v / 256, v % 256, smem); }
    }
}

__device__ void ph_gated(const P& p, int l) {
    const int tid = threadIdx.x, lane = tid & 63, wid = tid >> 6;
    const bf16_t* proj = wsp<const bf16_t>(p, OFF_BIG);
    const float* obuf = wsp<const float>(p, OFF_OBUF);
    bf16_t* outs = wsp<bf16_t>(p, OFF_OUTS);
    for (int r = blockIdx.x * 8 + wid; r < R; r += gridDim.x * 8) {
#pragma unroll
        for (int br = 0; br < 2; ++br) {
            const f32x4 a = *(const f32x4*)(obuf + ((size_t)(0 * 2 + br) * R + r) * 256 + lane * 4);
            const f32x4 b = *(const f32x4*)(obuf + ((size_t)(1 * 2 + br) * R + r) * 256 + lane * 4);
            float o[4] = {a[0] + b[0], a[1] + b[1], a[2] + b[2], a[3] + b[3]};
            float ss = o[0] * o[0] + o[1] * o[1] + o[2] * o[2] + o[3] * o[3];
            ss += __shfl_xor(ss, 1); ss += __shfl_xor(ss, 2); ss += __shfl_xor(ss, 4); ss += __shfl_xor(ss, 8);
            const float rs = rsqrtf(ss * (1.0f / 64.0f) + 1e-6f);
            const float* gn = p.in[br ? 22 : 11] + l * 64 + (lane & 15) * 4;
            const u32x2 graw = *(const u32x2*)(proj + (size_t)r * NP1 + (br ? C_HGG : C_GG) + lane * 4);
            const float gt[4] = {bf2f((bf16_t)(graw[0] & 0xffff)), bf2f((bf16_t)(graw[0] >> 16)), bf2f((bf16_t)(graw[1] & 0xffff)), bf2f((bf16_t)(graw[1] >> 16))};
#pragma unroll
            for (int c = 0; c < 4; ++c) o[c] = o[c] * rs * gn[c] * siluf_(gt[c]);
            u32x2 w; w[0] = pack2(o[0], o[1]); w[1] = pack2(o[2], o[3]);
            *(u32x2*)(outs + (size_t)r * D + (br ? 512 : 0) + lane * 4) = w;
        }
    }
}

__device__ void ph_merge(const P& p, int l, char* smem) {
    const int tid = threadIdx.x, lane = tid & 63, wid = tid >> 6, wr = wid / 4, wc = wid % 4, fr = lane & 15, fq = lane >> 4;
    const bool last = l == NLAYER - 1;
    const bf16_t* hx = wsp<const bf16_t>(p, OFF_HX); const bf16_t* outs = wsp<const bf16_t>(p, OFF_OUTS);
    const bf16_t* btg = wsp<const bf16_t>(p, OFF_BTGATE) + (size_t)l * 4096 * D;
    const bf16_t* btb = wsp<const bf16_t>(p, OFF_BTBR) + (size_t)l * 4 * 1024 * 256;
    bf16_t* merged = wsp<bf16_t>(p, OFF_BIG);
    for (int u = blockIdx.x; u < (R / 128) * 8; u += gridDim.x) {
        const int pm = u / 8, pn = u % 8;
        if (last && (pm % 34) < 2) continue;
        f32x4 mg[4][2]; ZERO_ACC(mg, 4, 2);
#pragma unroll 1
        for (int i = 0; i < 4; ++i) {
            f32x4 ag[4][2]; ZERO_ACC(ag, 4, 2);
            GSq::run(smem, [&](int r) { return hx + (size_t)(pm * 128 + r) * D; }, [&](int r) { return btg + (size_t)(i * 1024 + pn * 128 + r) * D; }, D, ag);
#pragma unroll
            for (int m = 0; m < 4; ++m)
#pragma unroll
                for (int n = 0; n < 2; ++n)
#pragma unroll
                    for (int j = 0; j < 4; ++j) ag[m][n][j] = sigmoidf_(ag[m][n][j]);
            f32x4 ab[4][2]; ZERO_ACC(ab, 4, 2);
            GSq::run(smem, [&](int r) { return outs + (size_t)(pm * 128 + r) * D + i * 256; }, [&](int r) { return btb + ((size_t)i * 1024 + pn * 128 + r) * 256; }, 256, ab);
#pragma unroll
            for (int m = 0; m < 4; ++m)
#pragma unroll
                for (int n = 0; n < 2; ++n) mg[m][n] += ag[m][n] * ab[m][n];
        }
#pragma unroll
        for (int m = 0; m < 4; ++m) {
            const int row = pm * 128 + wr * 64 + m * 16 + fr;
#pragma unroll
            for (int n = 0; n < 2; ++n) {
                const int col = pn * 128 + wc * 32 + n * 16 + fq * 4;
                u32x2 w; w[0] = pack2(mg[m][n][0], mg[m][n][1]); w[1] = pack2(mg[m][n][2], mg[m][n][3]);
                *(u32x2*)(merged + (size_t)row * D + col) = w;
            }
        }
    }
}

__device__ void ph_wout(const P& p, int l, int grp, char* smem) {
    const int tid = threadIdx.x, lane = tid & 63, wid = tid >> 6, wr = wid / 2, wc = wid % 2, fr = lane & 15, fq = lane >> 4;
    const bool last = l == NLAYER - 1;
    const bf16_t* merged = wsp<const bf16_t>(p, OFF_BIG);
    const bf16_t* bt = wsp<const bf16_t>(p, OFF_BTOUT) + (size_t)l * D * D;
    for (int u = blockIdx.x; u < (R / 256) * 8; u += gridDim.x) {
        const int pm = u / 8, pn = u % 8;
        if (last && (pm % 17) == 0) continue;
        f32x4 acc[4][4]; ZERO_ACC(acc, 4, 4);
        GBig::run(smem, [&](int i) { return merged + (size_t)(pm * 256 + i) * D; }, [&](int i) { return bt + (size_t)(pn * 128 + i) * D; }, D, acc);
#pragma unroll
        for (int m = 0; m < 4; ++m) {
            const int r = pm * 256 + wr * 64 + m * 16 + fr, bl = r / TT, pp = r % TT, b = grp * BG + bl;
            const float* src = stream_src(p, l, b, pp); float* dst = stream_dst(p, b, pp);
            const float* mod = (pp < LC ? wsp<const float>(p, OFF_MODC) + (size_t)l * 6144 : wsp<const float>(p, OFF_MODX) + ((size_t)l * NB + b) * 6144) + 2 * D;
#pragma unroll
            for (int n = 0; n < 4; ++n) {
                const int col = pn * 128 + wc * 64 + n * 16 + fq * 4;
                const f32x4 s = *(const f32x4*)(src + col), md = *(const f32x4*)(mod + col);
                *(f32x4*)(dst + col) = s + md * acc[m][n];
            }
        }
    }
}

__device__ void ph_topk(const P& p, int l, char* smem) {
    unsigned* keys = (unsigned*)smem;
    unsigned* red = keys + 4096;
    const int tid = threadIdx.x, lane = tid & 63, wid = tid >> 6;
    const bool last = l == NLAYER - 1;
    const int NU = BG * NEXP * (last ? 1 : 2);
    for (int u = blockIdx.x; u < NU; u += gridDim.x) {
        const int isctx = u >= BG * NEXP, v = isctx ? u - BG * NEXP : u, bl = v / NEXP, e = v % NEXP;
        const int L = isctx ? LC : LQ, cap = isctx ? CAPC : CAPL;
        const float* aff = wsp<const float>(p, OFF_AFF) + (isctx ? (size_t)BG * NEXP * LQ + (size_t)v * LC : (size_t)v * LQ);
        __syncthreads();
        for (int i = tid; i < 4096; i += NTHR) keys[i] = i < L ? __float_as_uint(aff[i]) : 0u;
        __syncthreads();
        unsigned my[8];
#pragma unroll
        for (int i = 0; i < 8; ++i) my[i] = keys[tid * 8 + i];
        unsigned T = 0u;
        for (int bit = 30; bit >= 0; --bit) {
            const unsigned cand = T | (1u << bit);
            int c = 0;
#pragma unroll
            for (int i = 0; i < 8; ++i) c += (my[i] >= cand) ? 1 : 0;
            c = (int)wave_sum((float)c);
            if (lane == 0) red[wid] = (unsigned)c;
            __syncthreads();
            int tot = 0;
#pragma unroll
            for (int w = 0; w < 8; ++w) tot += (int)red[w];
            __syncthreads();
            if (tot >= cap) T = cand;
        }
        int cg = 0, ce = 0;
#pragma unroll
        for (int i = 0; i < 8; ++i) { cg += (my[i] > T) ? 1 : 0; ce += (my[i] == T) ? 1 : 0; }
        unsigned pk = (unsigned)cg | ((unsigned)ce << 16), inc = pk;
#pragma unroll
        for (int o = 1; o < 64; o <<= 1) { const unsigned t = __shfl_up(inc, o); if (lane >= o) inc += t; }
        if (lane == 63) red[8 + wid] = inc;
        __syncthreads();
        unsigned base = 0u, totpk = 0u;
#pragma unroll
        for (int w = 0; w < 8; ++w) { const unsigned t = red[8 + w]; if (w < wid) base += t; totpk += t; }
        const unsigned ex = base + inc - pk;
        int rg = (int)(ex & 0xffffu), re = (int)(ex >> 16); const int G = (int)(totpk & 0xffffu);
        const int sbase = isctx ? LATS + (e * BG + bl) * CAPC : (bl * NEXP + e) * CAPL;
        int* sidx = wsp<int>(p, OFF_SIDX); float* sgv = wsp<float>(p, OFF_SGV); int* inv = wsp<int>(p, OFF_INV);
#pragma unroll
        for (int i = 0; i < 8; ++i) {
            const int tok = tid * 8 + i; int slot = -1;
            if (my[i] > T) slot = rg++;
            else if (my[i] == T) { if (G + re < cap) slot = G + re; re++; }
            if (slot >= 0 && tok < L) {
                const int r = bl * TT + (isctx ? tok : LC + tok);
                sidx[sbase + slot] = r; sgv[sbase + slot] = __uint_as_float(my[i]); inv[(size_t)r * NEXP + e] = sbase + slot;
            }
        }
    }
}

__device__ __forceinline__ int mtile_expert(int mt) { return mt < LATS / 256 ? (mt >> 1) & 15 : mt - LATS / 256; }

__device__ void ph_moe1(const P& p, int l, char* smem) {
    const int tid = threadIdx.x, lane = tid & 63, wid = tid >> 6, wr = wid / 2, wc = wid % 2, fr = lane & 15, fq = lane >> 4;
    const bool last = l == NLAYER - 1;
    const bf16_t* hx = wsp<const bf16_t>(p, OFF_HX); const int* sidx = wsp<const int>(p, OFF_SIDX);
    bf16_t* H = wsp<bf16_t>(p, OFF_BIG) + (size_t)NSLOT * D;
    const int nmt = last ? LATS / 256 : NSLOT / 256;
    for (int u = blockIdx.x; u < nmt * 16; u += gridDim.x) {
        const int mt = u / 16, pn = u % 16, e = mtile_expert(mt);
        const bf16_t* bt = wsp<const bf16_t>(p, OFF_BTW13) + ((size_t)l * NEXP + e) * 2048 * D;
        f32x4 acc[4][4]; ZERO_ACC(acc, 4, 4);
        GBig::run(smem, [&](int i) { return hx + (size_t)sidx[mt * 256 + i] * D; }, [&](int i) { return bt + (size_t)(pn * 128 + i) * D; }, D, acc);
#pragma unroll
        for (int m = 0; m < 4; ++m) {
            const int slot = mt * 256 + wr * 64 + m * 16 + fr;
#pragma unroll
            for (int n2 = 0; n2 < 2; ++n2) {
                const int col = (pn * 4 + wc * 2 + n2) * 16 + fq * 4;
                float hv[4];
#pragma unroll
                for (int j = 0; j < 4; ++j) hv[j] = siluf_(acc[m][2 * n2][j]) * acc[m][2 * n2 + 1][j];
                u32x2 w; w[0] = pack2(hv[0], hv[1]); w[1] = pack2(hv[2], hv[3]);
                *(u32x2*)(H + (size_t)slot * D + col) = w;
            }
        }
    }
}

__device__ void ph_moe2(const P& p, int l, char* smem) {
    const int tid = threadIdx.x, lane = tid & 63, wid = tid >> 6, wr = wid / 2, wc = wid % 2, fr = lane & 15, fq = lane >> 4;
    const bool last = l == NLAYER - 1;
    const bf16_t* H = wsp<const bf16_t>(p, OFF_BIG) + (size_t)NSLOT * D;
    bf16_t* Y = wsp<bf16_t>(p, OFF_BIG);
    const float* sgv = wsp<const float>(p, OFF_SGV);
    const int nmt = last ? LATS / 256 : NSLOT / 256;
    for (int u = blockIdx.x; u < nmt * 8; u += gridDim.x) {
        const int mt = u / 8, pn = u % 8, e = mtile_expert(mt);
        const bf16_t* bt = wsp<const bf16_t>(p, OFF_BTW2) + ((size_t)l * NEXP + e) * D * D;
        f32x4 acc[4][4]; ZERO_ACC(acc, 4, 4);
        GBig::run(smem, [&](int i) { return H + (size_t)(mt * 256 + i) * D; }, [&](int i) { return bt + (size_t)(pn * 128 + i) * D; }, D, acc);
#pragma unroll
        for (int m = 0; m < 4; ++m) {
            const int slot = mt * 256 + wr * 64 + m * 16 + fr; const float g = sgv[slot];
#pragma unroll
            for (int n = 0; n < 4; ++n) {
                const int col = pn * 128 + wc * 64 + n * 16 + fq * 4;
                u32x2 w; w[0] = pack2(acc[m][n][0] * g, acc[m][n][1] * g); w[1] = pack2(acc[m][n][2] * g, acc[m][n][3] * g);
                *(u32x2*)(Y + (size_t)slot * D + col) = w;
            }
        }
    }
}

__device__ void ph_combine(const P& p, int l, int grp) {
    const int tid = threadIdx.x, lane = tid & 63, wid = tid >> 6;
    const bool last = l == NLAYER - 1;
    const bf16_t* Y = wsp<const bf16_t>(p, OFF_BIG); const int* inv = wsp<const int>(p, OFF_INV);
    for (int r = blockIdx.x * 8 + wid; r < R; r += gridDim.x * 8) {
        const int bl = r / TT, pp = r % TT, b = grp * BG + bl;
        if (last && pp < LC) continue;
        float* dst = stream_dst(p, b, pp);
        const float* mod = (pp < LC ? wsp<const float>(p, OFF_MODC) + (size_t)l * 6144 : wsp<const float>(p, OFF_MODX) + ((size_t)l * NB + b) * 6144) + 5 * D;
        const int myinv = lane < NEXP ? inv[(size_t)r * NEXP + lane] : -1;
        float acc[16];
#pragma unroll
        for (int i = 0; i < 16; ++i) acc[i] = 0.f;
        for (int e = 0; e < NEXP; ++e) {
            const int s = __shfl(myinv, e);
            if (s >= 0) {
#pragma unroll
                for (int i = 0; i < 2; ++i) {
                    const u32x4 w = *(const u32x4*)(Y + (size_t)s * D + i * 512 + lane * 8);
#pragma unroll
                    for (int j = 0; j < 4; ++j) { acc[i * 8 + 2 * j] += __uint_as_float(w[j] << 16); acc[i * 8 + 2 * j + 1] += __uint_as_float(w[j] & 0xffff0000u); }
                }
            }
        }
#pragma unroll
        for (int i = 0; i < 2; ++i)
#pragma unroll
            for (int j = 0; j < 2; ++j) {
                const int c = i * 512 + lane * 8 + j * 4;
                f32x4 x = *(const f32x4*)(dst + c); const f32x4 md = *(const f32x4*)(mod + c);
#pragma unroll
                for (int q = 0; q < 4; ++q) x[q] += md[q] * acc[i * 8 + j * 4 + q];
                *(f32x4*)(dst + c) = x;
            }
    }
}

enum { PH_WEIGHTS, PH_MOD, PH_HFILT, PH_NORM1, PH_G1, PH_PREP, PH_RECUR, PH_ATTN, PH_HYENA, PH_GATED, PH_MERGE, PH_WOUT, PH_NORM2, PH_TOPK, PH_MOE1, PH_MOE2, PH_COMBINE };

template <int PH>
__device__ __forceinline__ void run_phase(const P& p, int l, int grp, char* smem) {
    if (PH == PH_WEIGHTS) ph_weights(p, smem);
    if (PH == PH_MOD) ph_mod(p, smem);
    if (PH == PH_HFILT) ph_hfilt(p, smem);
    if (PH == PH_NORM1) ph_norm<0>(p, l, grp, smem);
    if (PH == PH_G1) ph_g1(p, l, smem);
    if (PH == PH_PREP) { ph_attn_prep(p, l); ph_hy_prep(p, l, smem); }
    if (PH == PH_RECUR) ph_recur(p, l, smem);
    if (PH == PH_ATTN) ph_attn(p, l, smem);
    if (PH == PH_HYENA) ph_hyena(p, l, smem);
    if (PH == PH_GATED) ph_gated(p, l);
    if (PH == PH_MERGE) ph_merge(p, l, smem);
    if (PH == PH_WOUT) ph_wout(p, l, grp, smem);
    if (PH == PH_NORM2) ph_norm<1>(p, l, grp, smem);
    if (PH == PH_TOPK) ph_topk(p, l, smem);
    if (PH == PH_MOE1) ph_moe1(p, l, smem);
    if (PH == PH_MOE2) ph_moe2(p, l, smem);
    if (PH == PH_COMBINE) ph_combine(p, l, grp);
}

template <int PH>
__global__ void __launch_bounds__(NTHR, 2) k_phase(P p, int l, int grp) {
    extern __shared__ __attribute__((aligned(16))) char smem[];
    run_phase<PH>(p, l, grp, smem);
}

template <int PH>
static void launch_phase(const P& p, int l, int grp, int grid, hipStream_t stream) {
    static bool attr = false;
    if (!attr) { (void)hipFuncSetAttribute((const void*)k_phase<PH>, hipFuncAttributeMaxDynamicSharedMemorySize, SMEM_BYTES); attr = true; }
    k_phase<PH><<<grid, NTHR, SMEM_BYTES, stream>>>(p, l, grp);
}

extern "C" void kernel_launch(void* const* d_in, const int* in_sizes, int n_in, void* d_out, int out_size, void* d_ws, size_t ws_size, hipStream_t stream) {
    P p{};
    for (int i = 0; i < 33; ++i) p.in[i] = (const float*)d_in[i];
    p.out = (float*)d_out; p.ws = (char*)d_ws;
    const int grid = 256;
    launch_phase<PH_WEIGHTS>(p, 0, 0, grid, stream);
    launch_phase<PH_MOD>(p, 0, 0, grid, stream);
    launch_phase<PH_HFILT>(p, 0, 0, grid, stream);
    for (int grp = 0; grp < NGRP; ++grp)
        for (int l = 0; l < NLAYER; ++l) {
            launch_phase<PH_NORM1>(p, l, grp, grid, stream);
            launch_phase<PH_G1>(p, l, grp, grid, stream);
            launch_phase<PH_PREP>(p, l, grp, grid, stream);
            launch_phase<PH_RECUR>(p, l, grp, grid, stream);
            launch_phase<PH_ATTN>(p, l, grp, grid, stream);
            launch_phase<PH_HYENA>(p, l, grp, grid, stream);
            launch_phase<PH_GATED>(p, l, grp, grid, stream);
            launch_phase<PH_MERGE>(p, l, grp, grid, stream);
            launch_phase<PH_WOUT>(p, l, grp, grid, stream);
            launch_phase<PH_NORM2>(p, l, grp, grid, stream);
            launch_phase<PH_TOPK>(p, l, grp, grid, stream);
            launch_phase<PH_MOE1>(p, l, grp, grid, stream);
            launch_phase<PH_MOE2>(p, l, grp, grid, stream);
            launch_phase<PH_COMBINE>(p, l, grp, grid, stream);
        }
}
```

```cpp
#include <hip/hip_runtime.h>
#include <stdint.h>

#ifndef FUSED
#define FUSED 1
#endif

typedef unsigned short bf16_t;
typedef short bf16x8 __attribute__((ext_vector_type(8)));
typedef float f32x4 __attribute__((ext_vector_type(4)));
typedef unsigned u32x4 __attribute__((ext_vector_type(4)));
typedef unsigned u32x2 __attribute__((ext_vector_type(2)));

#define NTHR 512
constexpr int D = 1024, NB = 16, LQ = 4096, LC = 256, TT = 4352, NLAYER = 2;
constexpr int BG = 8, NGRP = NB / BG, R = BG * TT;
constexpr int NP1 = 3840;
constexpr int C_GQ = 0, C_GK = 128, C_GV = 256, C_GAF = 512, C_GAB = 528, C_GG = 544, C_HY = 800, C_HQ = 1568, C_HFF = 1824, C_HFB = 2080,
              C_HI = 2336, C_HGG = 2592, C_DQ = 2848, C_DK = 3104, C_DV = 3360, C_MG = 3616, N_IN = 7712;
constexpr int NEXP = 16, CAPL = 512, CAPC = 32, LATS = BG * NEXP * CAPL, NSLOT = LATS + BG * NEXP * CAPC;
constexpr int SMEM_BYTES = 114688;

constexpr size_t al256(size_t x) { return (x + 255) & ~(size_t)255; }
constexpr size_t OFF_BAR = 0;
constexpr size_t OFF_BTIN1 = 65536;
constexpr size_t OFF_BTGATE = OFF_BTIN1 + (size_t)NLAYER * NP1 * D * 2;
constexpr size_t OFF_BTBR = OFF_BTGATE + (size_t)NLAYER * 4096 * D * 2;
constexpr size_t OFF_BTOUT = OFF_BTBR + (size_t)NLAYER * 4 * 1024 * 256 * 2;
constexpr size_t OFF_BTW13 = OFF_BTOUT + (size_t)NLAYER * D * D * 2;
constexpr size_t OFF_BTW2 = OFF_BTW13 + (size_t)NLAYER * NEXP * 2048 * D * 2;
constexpr size_t OFF_MODX = OFF_BTW2 + (size_t)NLAYER * NEXP * D * D * 2;
constexpr size_t OFF_MODC = OFF_MODX + (size_t)NLAYER * NB * 6144 * 4;
constexpr size_t OFF_HRAW = OFF_MODC + (size_t)NLAYER * 6144 * 4;
constexpr size_t HRAW_L = (size_t)512 * (LQ + LC);
constexpr size_t OFF_PSUM = OFF_HRAW + (size_t)NLAYER * HRAW_L * 4;
constexpr size_t OFF_XC = OFF_PSUM + (size_t)NLAYER * 68 * 512 * 4;
constexpr size_t OFF_HX = OFF_XC + (size_t)NB * LC * D * 4;
constexpr size_t OFF_BIG = OFF_HX + (size_t)R * D * 2;
constexpr size_t BIG_BYTES = (size_t)2 * NSLOT * D * 2;
constexpr size_t OFF_OUTS = OFF_BIG + BIG_BYTES;
constexpr size_t OFF_QA = OFF_OUTS + (size_t)R * D * 2;
constexpr size_t OFF_KA = OFF_QA + (size_t)BG * 4 * TT * 64 * 2;
constexpr size_t OFF_VA = OFF_KA + (size_t)BG * 4 * TT * 64 * 2;
constexpr size_t OFF_OBUF = OFF_VA + (size_t)BG * 4 * TT * 64 * 2;
constexpr size_t OFF_HYT = OFF_OBUF + (size_t)4 * R * 256 * 4;
constexpr size_t OFF_AFF = OFF_HYT + (size_t)BG * 768 * TT * 4;
constexpr size_t OFF_INV = OFF_AFF + (size_t)BG * NEXP * TT * 4;
constexpr size_t OFF_SIDX = OFF_INV + (size_t)R * NEXP * 4;
constexpr size_t OFF_SGV = OFF_SIDX + (size_t)NSLOT * 4;
constexpr size_t WS_END = OFF_SGV + (size_t)NSLOT * 4;
static_assert(WS_END < (size_t)1000 * 1024 * 1024, "workspace too big");
static_assert(BIG_BYTES >= (size_t)R * NP1 * 2, "big region");

struct P {
    const float* in[33];
    float* out;
    char* ws;
};

__device__ __forceinline__ bf16_t f2bf(float f) { unsigned u = __float_as_uint(f); u += 0x7fffu + ((u >> 16) & 1u); return (bf16_t)(u >> 16); }
__device__ __forceinline__ float bf2f(bf16_t h) { return __uint_as_float((unsigned)h << 16); }
__device__ __forceinline__ unsigned pack2(float a, float b) { return (unsigned)f2bf(a) | ((unsigned)f2bf(b) << 16); }
__device__ __forceinline__ float sigmoidf_(float x) { return 1.0f / (1.0f + __expf(-x)); }
__device__ __forceinline__ float siluf_(float x) { return x / (1.0f + __expf(-x)); }
__device__ __forceinline__ float wave_sum(float v) {
#pragma unroll
    for (int o = 32; o > 0; o >>= 1) v += __shfl_xor(v, o);
    return v;
}

template <class T> __device__ __forceinline__ T* wsp(const P& p, size_t off) { return (T*)(p.ws + off); }

__device__ __forceinline__ const float* stream_src(const P& p, int l, int b, int pp) {
    if (pp < LC) return (l == 0 ? p.in[2] : wsp<const float>(p, OFF_XC)) + ((size_t)b * LC + pp) * D;
    return (l == 0 ? p.in[0] : (const float*)p.out) + ((size_t)b * LQ + (pp - LC)) * D;
}
__device__ __forceinline__ float* stream_dst(const P& p, int b, int pp) {
    if (pp < LC) return wsp<float>(p, OFF_XC) + ((size_t)b * LC + pp) * D;
    return p.out + ((size_t)b * LQ + (pp - LC)) * D;
}

__device__ __forceinline__ int TID() { int t = threadIdx.x; asm volatile("" : "+v"(t)); return t; }
__device__ __forceinline__ int BID() { int t = blockIdx.x; asm volatile("" : "+s"(t)); return t; }

__device__ void xpose_job(const float* __restrict__ src, int ldS, int K, int N, bf16_t* __restrict__ dst, int mode, int which, float* tile) {
    const int tid = TID();
    const int tk = K / 64, tn = (N + 63) / 64, nt = tk * tn;
    for (int t = BID(); t < nt; t += gridDim.x) {
        const int k0 = (t % tk) * 64, n0 = (t / tk) * 64;
        __syncthreads();
#pragma unroll
        for (int ps = 0; ps < 2; ++ps) {
            const int i = (tid >> 4) + 32 * ps, j4 = (tid & 15) * 4;
            f32x4 v = {0.f, 0.f, 0.f, 0.f};
            if (n0 + j4 < N) v = *(const f32x4*)(src + (size_t)(k0 + i) * ldS + n0 + j4);
            tile[i * 65 + j4 + 0] = v[0]; tile[i * 65 + j4 + 1] = v[1]; tile[i * 65 + j4 + 2] = v[2]; tile[i * 65 + j4 + 3] = v[3];
        }
        __syncthreads();
        const int n = tid >> 3, kc = (tid & 7) * 8;
        if (n0 + n < N) {
            const int ng = n0 + n;
            const int drow = mode == 0 ? ng : ((ng >> 4) * 32 + which * 16 + (ng & 15));
            u32x4 w;
            w[0] = pack2(tile[(kc + 0) * 65 + n], tile[(kc + 1) * 65 + n]);
            w[1] = pack2(tile[(kc + 2) * 65 + n], tile[(kc + 3) * 65 + n]);
            w[2] = pack2(tile[(kc + 4) * 65 + n], tile[(kc + 5) * 65 + n]);
            w[3] = pack2(tile[(kc + 6) * 65 + n], tile[(kc + 7) * 65 + n]);
            *(u32x4*)(dst + (size_t)drow * K + k0 + kc) = w;
        }
    }
}

__device__ void ph_weights(const P& p, char* smem) {
    float* tile = (float*)smem;
    for (int l = 0; l < NLAYER; ++l) {
        const float* win = p.in[8] + (size_t)l * D * N_IN;
        bf16_t* bt1 = wsp<bf16_t>(p, OFF_BTIN1) + (size_t)l * NP1 * D;
        xpose_job(win, N_IN, D, C_MG, bt1, 0, 0, tile);
        for (size_t i = (size_t)BID() * NTHR + TID(); i < (size_t)(NP1 - C_MG) * D / 8; i += (size_t)gridDim.x * NTHR)
            *(u32x4*)(bt1 + (size_t)C_MG * D + i * 8) = (u32x4){0u, 0u, 0u, 0u};
        xpose_job(win + C_MG, N_IN, D, 4096, wsp<bf16_t>(p, OFF_BTGATE) + (size_t)l * 4096 * D, 0, 0, tile);
        for (int i = 0; i < 4; ++i)
            xpose_job(p.in[27] + ((size_t)l * 4 + i) * 256 * D, D, 256, D, wsp<bf16_t>(p, OFF_BTBR) + ((size_t)l * 4 + i) * 1024 * 256, 0, 0, tile);
        xpose_job(p.in[28] + (size_t)l * D * D, D, D, D, wsp<bf16_t>(p, OFF_BTOUT) + (size_t)l * D * D, 0, 0, tile);
        for (int e = 0; e < NEXP; ++e) {
            const size_t le = (size_t)l * NEXP + e;
            xpose_job(p.in[30] + le * D * D, D, D, D, wsp<bf16_t>(p, OFF_BTW13) + le * 2048 * D, 1, 0, tile);
            xpose_job(p.in[31] + le * D * D, D, D, D, wsp<bf16_t>(p, OFF_BTW13) + le * 2048 * D, 1, 1, tile);
            xpose_job(p.in[32] + le * D * D, D, D, D, wsp<bf16_t>(p, OFF_BTW2) + le * D * D, 0, 0, tile);
        }
    }
}

__device__ void ph_mod(const P& p, char* smem) {
    float* s = (float*)smem;
    float* red = s + 17 * 1024;
    const int tid = TID();
    for (int i = tid; i < 17 * 1024; i += NTHR) { const float v = i < 16384 ? p.in[1][i] : p.in[3][i - 16384]; s[i] = siluf_(v); }
    __syncthreads();
    for (int u = BID(); u < NLAYER * 96; u += gridDim.x) {
        const int l = u / 96, col = (u % 96) * 64 + (tid & 63), ks = tid >> 6;
        const float* w = p.in[4] + (size_t)l * D * 6144 + col;
        float acc[17];
#pragma unroll
        for (int r = 0; r < 17; ++r) acc[r] = 0.f;
        for (int k = ks * 128; k < ks * 128 + 128; ++k) {
            const float wv = w[(size_t)k * 6144];
#pragma unroll
            for (int r = 0; r < 17; ++r) acc[r] += s[r * 1024 + k] * wv;
        }
#pragma unroll
        for (int r = 0; r < 17; ++r) red[(ks * 17 + r) * 64 + (tid & 63)] = acc[r];
        __syncthreads();
        for (int i = tid; i < 17 * 64; i += NTHR) {
            const int r = i / 64, c = i % 64, cg = (u % 96) * 64 + c;
            float v = p.in[5][(size_t)l * 6144 + cg];
#pragma unroll
            for (int q = 0; q < 8; ++q) v += red[(q * 17 + r) * 64 + c];
            if (r < 16) wsp<float>(p, OFF_MODX)[((size_t)l * NB + r) * 6144 + cg] = v;
            else wsp<float>(p, OFF_MODC)[(size_t)l * 6144 + cg] = v;
        }
        __syncthreads();
    }
}

__device__ void ph_hfilt(const P& p, char* smem) {
    float* feats = (float*)smem;
    float* h1 = feats + 64 * 33;
    float* h2 = h1 + 64 * 64;
    const int tid = TID();
    for (int u = BID(); u < NLAYER * 68; u += gridDim.x) {
        const int l = u / 68, ub = u % 68, w = ub >= 64 ? 1 : 0, jb = w ? ub - 64 : ub, L = w ? LC : LQ;
        __syncthreads();
        for (int i = tid; i < 64 * 33; i += NTHR) {
            const int pos = i / 33, fi = i % 33; const float j = (float)(jb * 64 + pos);
            float v;
            if (fi == 0) v = j / (float)(L - 1);
            else {
                const int k = (fi - 1) & 15; const float f = 1e-4f + (float)k * ((15.0f - 1e-4f) / 15.0f);
                const float wv = 6.283185307179586f * j / (float)L;
                v = fi <= 16 ? cosf(wv * f) : -sinf(wv * f);
            }
            feats[i] = v;
        }
        __syncthreads();
        const float* w1 = p.in[13] + (size_t)l * 33 * 64; const float* b1 = p.in[14] + l * 64;
        const float* w2 = p.in[15] + (size_t)l * 64 * 64; const float* b2 = p.in[16] + l * 64;
        const float* w3 = p.in[17] + (size_t)l * 64 * 512; const float* fr = p.in[18] + l * 128;
        for (int i = tid; i < 64 * 64; i += NTHR) {
            const int pos = i >> 6, k = i & 63; float a = b1[k];
            for (int f = 0; f < 33; ++f) a += feats[pos * 33 + f] * w1[f * 64 + k];
            h1[i] = sinf(fr[k] * a);
        }
        __syncthreads();
        for (int i = tid; i < 64 * 64; i += NTHR) {
            const int pos = i >> 6, k = i & 63; float a = b2[k];
            for (int f = 0; f < 64; ++f) a += h1[pos * 64 + f] * w2[f * 64 + k];
            h2[i] = sinf(fr[64 + k] * a);
        }
        __syncthreads();
        {
            const int n = tid; float asum = 0.f;
            const float dec = fabsf(p.in[19][(size_t)l * 512 + n]);
            float* hr = wsp<float>(p, OFF_HRAW) + (size_t)l * HRAW_L + (w ? (size_t)512 * LQ : 0) + (size_t)n * L + jb * 64;
            for (int pos = 0; pos < 64; ++pos) {
                float a = 0.f;
                for (int k = 0; k < 64; ++k) a += h2[pos * 64 + k] * w3[k * 512 + n];
                const int j = jb * 64 + pos; const float dist = fabsf((float)(j - L / 2)) / (float)(L / 2);
                a *= __expf(-dist * dec) + 0.05f;
                hr[pos] = a; asum += fabsf(a);
            }
            wsp<float>(p, OFF_PSUM)[((size_t)l * 68 + ub) * 512 + n] = asum;
        }
    }
}

template <int WHICH>
__device__ void ph_norm(const P& p, int l, int grp, char* smem) {
    const int tid = TID(), lane = tid & 63, wid = tid >> 6;
    float* rt = (float*)smem;
    if (WHICH == 1) {
        const float* rsrc = p.in[29] + (size_t)l * D * NEXP;
        for (int i = tid; i < D * NEXP / 4; i += NTHR) ((f32x4*)rt)[i] = ((const f32x4*)rsrc)[i];
        __syncthreads();
    }
    const float* gain = p.in[WHICH ? 7 : 6] + (size_t)l * D;
    bf16_t* hx = wsp<bf16_t>(p, OFF_HX);
    for (int r = BID() * 8 + wid; r < R; r += gridDim.x * 8) {
        const int bl = r / TT, pp = r % TT, b = grp * BG + bl; const bool isctx = pp < LC;
        if (WHICH == 1 && l == NLAYER - 1 && isctx) continue;
        const float* src = WHICH == 0 ? stream_src(p, l, b, pp) : (const float*)stream_dst(p, b, pp);
        const float* mod = isctx ? wsp<const float>(p, OFF_MODC) + (size_t)l * 6144 : wsp<const float>(p, OFF_MODX) + ((size_t)l * NB + b) * 6144;
        const float* shp = mod + (WHICH ? 3 : 0) * D; const float* scp = mod + (WHICH ? 4 : 1) * D;
        f32x4 x[4]; float ss = 0.f;
#pragma unroll
        for (int i = 0; i < 4; ++i) { x[i] = *(const f32x4*)(src + i * 256 + lane * 4); ss += x[i][0] * x[i][0] + x[i][1] * x[i][1] + x[i][2] * x[i][2] + x[i][3] * x[i][3]; }
        ss = wave_sum(ss);
        const float rs = rsqrtf(ss * (1.0f / D) + 1e-6f);
        float lg[NEXP];
#pragma unroll
        for (int e = 0; e < NEXP; ++e) lg[e] = 0.f;
#pragma unroll
        for (int i = 0; i < 4; ++i) {
            const int c = i * 256 + lane * 4;
            const f32x4 g = *(const f32x4*)(gain + c), sh = *(const f32x4*)(shp + c), sc = *(const f32x4*)(scp + c);
            f32x4 y;
#pragma unroll
            for (int j = 0; j < 4; ++j) y[j] = x[i][j] * rs * g[j] * (1.0f + sc[j]) + sh[j];
            u32x2 w; w[0] = pack2(y[0], y[1]); w[1] = pack2(y[2], y[3]);
            *(u32x2*)(hx + (size_t)r * D + c) = w;
            if (WHICH == 1) {
#pragma unroll
                for (int j = 0; j < 4; ++j) {
#pragma unroll
                    for (int e4 = 0; e4 < 4; ++e4) { const f32x4 rv = *(const f32x4*)(rt + (c + j) * NEXP + e4 * 4);
                        lg[e4 * 4 + 0] += y[j] * rv[0]; lg[e4 * 4 + 1] += y[j] * rv[1]; lg[e4 * 4 + 2] += y[j] * rv[2]; lg[e4 * 4 + 3] += y[j] * rv[3]; }
                }
            }
        }
        if (WHICH == 1) {
            float mx = -1e30f;
#pragma unroll
            for (int e = 0; e < NEXP; ++e) { lg[e] = wave_sum(lg[e]); mx = fmaxf(mx, lg[e]); }
            float sum = 0.f, mine = 0.f;
#pragma unroll
            for (int e = 0; e < NEXP; ++e) { const float ev = __expf(lg[e] - mx); sum += ev; mine = (lane == e) ? ev : mine; }
            if (lane < NEXP) {
                float* aff = wsp<float>(p, OFF_AFF);
                if (isctx) aff[(size_t)BG * NEXP * LQ + ((size_t)bl * NEXP + lane) * LC + pp] = mine / sum;
                else aff[((size_t)bl * NEXP + lane) * LQ + (pp - LC)] = mine / sum;
                wsp<int>(p, OFF_INV)[(size_t)r * NEXP + lane] = -1;
            }
        }
    }
}

template <int WR, int WC, int MT, int NT>
struct GC {
    static constexpr int BM = WR * MT * 16, BN = WC * NT * 16, ROWB = 144;
    static constexpr int A_BYTES = BM * ROWB, B_BYTES = BN * ROWB, STAGE = A_BYTES + B_BYTES;
    static constexpr int A_CH = BM * 8 / NTHR, B_CH = BN * 8 / NTHR;
    static_assert(2 * STAGE <= SMEM_BYTES, "lds");
    template <class AR, class BR>
    static __device__ __forceinline__ void run(char* smem, AR arow, BR brow, int K, f32x4 (&acc)[MT][NT]) {
        const int tid = TID(), lane = tid & 63, wid = tid >> 6, wr = wid / WC, wc = wid % WC, fr = lane & 15, fq = lane >> 4;
        const bf16_t* ap[A_CH]; const bf16_t* bp[B_CH]; int aoff[A_CH], boff[B_CH];
#pragma unroll
        for (int i = 0; i < A_CH; ++i) { const int c = tid + NTHR * i, row = c >> 3, kc = c & 7; ap[i] = arow(row) + kc * 8; aoff[i] = row * ROWB + kc * 16; }
#pragma unroll
        for (int i = 0; i < B_CH; ++i) { const int c = tid + NTHR * i, row = c >> 3, kc = c & 7; bp[i] = brow(row) + kc * 8; boff[i] = A_BYTES + row * ROWB + kc * 16; }
        u32x4 ra[A_CH], rb[B_CH];
        const int nk = K / 64;
#pragma unroll
        for (int i = 0; i < A_CH; ++i) ra[i] = *(const u32x4*)(ap[i]);
#pragma unroll
        for (int i = 0; i < B_CH; ++i) rb[i] = *(const u32x4*)(bp[i]);
        __syncthreads();
#pragma unroll
        for (int i = 0; i < A_CH; ++i) *(u32x4*)(smem + aoff[i]) = ra[i];
#pragma unroll
        for (int i = 0; i < B_CH; ++i) *(u32x4*)(smem + boff[i]) = rb[i];
        __syncthreads();
        for (int kt = 0; kt < nk; ++kt) {
            const char* cur = smem + (kt & 1) * STAGE; char* nxt = smem + ((kt + 1) & 1) * STAGE;
            if (kt + 1 < nk) {
#pragma unroll
                for (int i = 0; i < A_CH; ++i) ra[i] = *(const u32x4*)(ap[i] + (kt + 1) * 64);
#pragma unroll
                for (int i = 0; i < B_CH; ++i) rb[i] = *(const u32x4*)(bp[i] + (kt + 1) * 64);
            }
#pragma unroll
            for (int kk = 0; kk < 2; ++kk) {
                bf16x8 af[MT], bfr[NT];
#pragma unroll
                for (int m = 0; m < MT; ++m) af[m] = *(const bf16x8*)(cur + (wr * MT * 16 + m * 16 + fr) * ROWB + kk * 64 + fq * 16);
#pragma unroll
                for (int n = 0; n < NT; ++n) bfr[n] = *(const bf16x8*)(cur + A_BYTES + (wc * NT * 16 + n * 16 + fr) * ROWB + kk * 64 + fq * 16);
#pragma unroll
                for (int m = 0; m < MT; ++m)
#pragma unroll
                    for (int n = 0; n < NT; ++n) acc[m][n] = __builtin_amdgcn_mfma_f32_16x16x32_bf16(bfr[n], af[m], acc[m][n], 0, 0, 0);
            }
            if (kt + 1 < nk) {
#pragma unroll
                for (int i = 0; i < A_CH; ++i) *(u32x4*)(nxt + aoff[i]) = ra[i];
#pragma unroll
                for (int i = 0; i < B_CH; ++i) *(u32x4*)(nxt + boff[i]) = rb[i];
            }
            __syncthreads();
        }
    }
};
typedef GC<4, 2, 4, 4> GBig;
typedef GC<2, 4, 4, 2> GSq;

#define ZERO_ACC(acc, MT, NT) _Pragma("unroll") for (int _m = 0; _m < MT; ++_m) _Pragma("unroll") for (int _n = 0; _n < NT; ++_n) acc[_m][_n] = (f32x4){0.f, 0.f, 0.f, 0.f}

__device__ void ph_g1(const P& p, int l, char* smem) {
    const int tid = TID(), lane = tid & 63, wid = tid >> 6, wr = wid / 2, wc = wid % 2, fr = lane & 15, fq = lane >> 4;
    const bf16_t* hx = wsp<const bf16_t>(p, OFF_HX);
    const bf16_t* bt = wsp<const bf16_t>(p, OFF_BTIN1) + (size_t)l * NP1 * D;
    bf16_t* proj = wsp<bf16_t>(p, OFF_BIG);
    constexpr int NPN = NP1 / 128;
    for (int u = BID(); u < (R / 256) * NPN; u += gridDim.x) {
        const int pm = u / NPN, pn = u % NPN;
        f32x4 acc[4][4]; ZERO_ACC(acc, 4, 4);
        GBig::run(smem, [&](int i) { return hx + (size_t)(pm * 256 + i) * D; }, [&](int i) { return bt + (size_t)(pn * 128 + i) * D; }, D, acc);
#pragma unroll
        for (int m = 0; m < 4; ++m) {
            const int row = pm * 256 + wr * 64 + m * 16 + fr;
#pragma unroll
            for (int n = 0; n < 4; ++n) {
                const int col = pn * 128 + wc * 64 + n * 16 + fq * 4;
                u32x2 w; w[0] = pack2(acc[m][n][0], acc[m][n][1]); w[1] = pack2(acc[m][n][2], acc[m][n][3]);
                *(u32x2*)(proj + (size_t)row * NP1 + col) = w;
            }
        }
    }
}

__device__ void ph_attn_prep(const P& p, int l) {
    const int tid = TID(), lane = tid & 63, wid = tid >> 6;
    const bf16_t* proj = wsp<const bf16_t>(p, OFF_BIG);
    bf16_t* Qa = wsp<bf16_t>(p, OFF_QA); bf16_t* Ka = wsp<bf16_t>(p, OFF_KA); bf16_t* Va = wsp<bf16_t>(p, OFF_VA);
    const int j = lane & 7, d0 = j * 4;
    const float* gq = p.in[23] + l * 32; const float* gk = p.in[24] + l * 32;
    for (int r = BID() * 8 + wid; r < R; r += gridDim.x * 8) {
        const int bl = r / TT, pp = r % TT; const bool lat = pp >= LC; const int t = pp - LC;
        const int h = lane >> 4;
        float cs[4], sn[4];
        if (lat) {
            const float pos = (float)((j < 4) ? (t >> 6) : (t & 63));
#pragma unroll
            for (int c = 0; c < 4; ++c) { const int i = (j & 1) * 4 + c; const float fq_ = exp2f(-(float)i * (13.287712379549449f / 8.0f)); sincosf(pos * fq_, &sn[c], &cs[c]); }
        }
#pragma unroll
        for (int which = 0; which < 2; ++which) {
            const u32x2 raw = *(const u32x2*)(proj + (size_t)r * NP1 + (which ? C_DK : C_DQ) + lane * 4);
            float v[4] = {bf2f((bf16_t)(raw[0] & 0xffff)), bf2f((bf16_t)(raw[0] >> 16)), bf2f((bf16_t)(raw[1] & 0xffff)), bf2f((bf16_t)(raw[1] >> 16))};
            float ss = v[0] * v[0] + v[1] * v[1] + v[2] * v[2] + v[3] * v[3];
            ss += __shfl_xor(ss, 1); ss += __shfl_xor(ss, 2); ss += __shfl_xor(ss, 4);
            const float rs = rsqrtf(ss * (1.0f / 32.0f) + 1e-6f);
            const float* g = which ? gk : gq;
#pragma unroll
            for (int c = 0; c < 4; ++c) v[c] = v[c] * rs * g[d0 + c];
            if (lat) {
#pragma unroll
                for (int c = 0; c < 4; ++c) {
                    const float o = __shfl_xor(v[c], 2);
                    v[c] = (j & 2) ? (o * sn[c] + v[c] * cs[c]) : (v[c] * cs[c] - o * sn[c]);
                }
            }
            u32x2 w; w[0] = pack2(v[0], v[1]); w[1] = pack2(v[2], v[3]);
            *(u32x2*)((which ? Ka : Qa) + (((size_t)bl * 4 + h) * TT + pp) * 64 + (lane & 15) * 4) = w;
        }
        *(u32x2*)(Va + (((size_t)bl * 4 + h) * TT + pp) * 64 + (lane & 15) * 4) = *(const u32x2*)(proj + (size_t)r * NP1 + C_DV + lane * 4);
    }
}

__device__ void ph_hy_prep(const P& p, int l, char* smem) {
    float* tile = (float*)smem;
    const int tid = TID();
    const bf16_t* proj = wsp<const bf16_t>(p, OFF_BIG);
    float* hyT = wsp<float>(p, OFF_HYT);
    const float* cw = p.in[12] + (size_t)l * 3 * 768;
    constexpr int NTT = TT / 64;
    for (int u = BID(); u < BG * NTT * 12; u += gridDim.x) {
        const int ct = u % 12, tt = (u / 12) % NTT, bl = u / (12 * NTT);
        const int p0 = tt * 64; const bool lat = p0 >= LC; const int seg0 = lat ? LC : 0, segL = lat ? LQ : LC;
        __syncthreads();
        for (int i = tid; i < 66 * 16; i += NTHR) {
            const int rr = i >> 4, c4 = (i & 15) * 4; const int pp = p0 - 1 + rr;
            float v[4] = {0.f, 0.f, 0.f, 0.f};
            if (pp >= seg0 && pp < seg0 + segL) {
                const u32x2 raw = *(const u32x2*)(proj + (size_t)(bl * TT + pp) * NP1 + C_HY + ct * 64 + c4);
                v[0] = bf2f((bf16_t)(raw[0] & 0xffff)); v[1] = bf2f((bf16_t)(raw[0] >> 16)); v[2] = bf2f((bf16_t)(raw[1] & 0xffff)); v[3] = bf2f((bf16_t)(raw[1] >> 16));
            }
            tile[rr * 65 + c4] = v[0]; tile[rr * 65 + c4 + 1] = v[1]; tile[rr * 65 + c4 + 2] = v[2]; tile[rr * 65 + c4 + 3] = v[3];
        }
        __syncthreads();
        const int ch = tid >> 3, t8 = (tid & 7) * 8, cg = ct * 64 + ch;
        const float w0 = cw[cg], w1 = cw[768 + cg], w2 = cw[1536 + cg];
        float o[8];
#pragma unroll
        for (int q = 0; q < 8; ++q) { const int rr = t8 + q + 1; o[q] = tile[(rr - 1) * 65 + ch] * w0 + tile[rr * 65 + ch] * w1 + tile[(rr + 1) * 65 + ch] * w2; }
        float* dst = lat ? hyT + ((size_t)bl * 768 + cg) * LQ + (p0 - LC) + t8 : hyT + (size_t)BG * 768 * LQ + ((size_t)bl * 768 + cg) * LC + p0 + t8;
        *(f32x4*)dst = (f32x4){o[0], o[1], o[2], o[3]}; *(f32x4*)(dst + 4) = (f32x4){o[4], o[5], o[6], o[7]};
    }
}

template <int DK>
__device__ void recur_unit(const P& p, int l, int bl, int h, int br, int dir, char* smem) {
    constexpr int DPL = DK / 8;
    float* qS = (float*)smem;
    float* kS = qS + 64 * DK;
    float* gS = kS + 64 * DK;
    float* vS = gS + 64 * DK;
    float* oS = vS + 64 * 64;
    const int tid = TID(), lane = tid & 63, wid = tid >> 6;
    const bf16_t* proj = wsp<const bf16_t>(p, OFF_BIG);
    float* obuf = wsp<float>(p, OFF_OBUF) + ((size_t)dir * 2 + br) * R * 256;
    const int e = wid * 8 + (lane & 7), d0 = (lane >> 3) * DPL;
    float S[DPL];
#pragma unroll
    for (int j = 0; j < DPL; ++j) S[j] = 0.f;
    const float* wa2 = p.in[9] + ((size_t)l * 2 + dir) * 16 * 128; const float* ba = p.in[10] + ((size_t)l * 2 + dir) * 128;
    const float* hl = p.in[21];
    for (int ch = 0; ch < TT / 64; ++ch) {
        __syncthreads();
        for (int i = tid; i < 64 * DK; i += NTHR) {
            const int tk = i / DK, d = i % DK, n = ch * 64 + tk;
            const int pp = dir == 0 ? n : (n < LC ? LC - 1 - n : LC + (LQ - 1 - (n - LC)));
            const bf16_t* row = proj + (size_t)(bl * TT + pp) * NP1;
            float q, k, g;
            if (br == 0) {
                q = bf2f(row[C_GQ + h * 32 + d]) * 0.17677669529663687f; k = bf2f(row[C_GK + h * 32 + d]);
                float z = ba[h * 32 + d];
#pragma unroll
                for (int rr = 0; rr < 16; ++rr) z += bf2f(row[(dir ? C_GAB : C_GAF) + rr]) * wa2[rr * 128 + h * 32 + d];
                const float ls = fminf(z, 0.f) - log1pf(__expf(-fabsf(z)));
                g = __expf(ls * (1.0f / 16.0f));
            } else {
                q = siluf_(bf2f(row[C_HQ + h * 64 + d]));
                const float z = bf2f(row[(dir ? C_HFB : C_HFF) + h * 64 + d]);
                float lb = 0.f;
                if (l == 1) { const float a0 = hl[(0 * 2 + dir) * 256 + h * 64 + d], a1 = hl[(1 * 2 + dir) * 256 + h * 64 + d]; lb = 1.0f / (1.0f + __expf(a0 - a1)); }
                g = fmaxf(lb + (1.0f - lb) * sigmoidf_(z), 1e-20f);
                k = (1.0f - lb) * sigmoidf_(-z);
            }
            qS[i] = q; kS[i] = k; gS[i] = g;
        }
        for (int i = tid; i < 64 * 64; i += NTHR) {
            const int tk = i >> 6, ee = i & 63, n = ch * 64 + tk;
            const int pp = dir == 0 ? n : (n < LC ? LC - 1 - n : LC + (LQ - 1 - (n - LC)));
            vS[i] = bf2f(proj[(size_t)(bl * TT + pp) * NP1 + (br == 0 ? C_GV : C_HI) + h * 64 + ee]);
        }
        __syncthreads();
        for (int tk = 0; tk < 64; ++tk) {
            const float v = vS[tk * 64 + e]; float o = 0.f;
#pragma unroll
            for (int j = 0; j < DPL; ++j) {
                S[j] = gS[tk * DK + d0 + j] * S[j] + kS[tk * DK + d0 + j] * v;
                o += S[j] * qS[tk * DK + d0 + j];
            }
            o += __shfl_xor(o, 8); o += __shfl_xor(o, 16); o += __shfl_xor(o, 32);
            if ((lane >> 3) == 0) oS[tk * 64 + e] = o;
        }
        __syncthreads();
        {
            const int tk = tid >> 3, e8 = (tid & 7) * 8, n = ch * 64 + tk;
            const int pp = dir == 0 ? n : (n < LC ? LC - 1 - n : LC + (LQ - 1 - (n - LC)));
            float* dst = obuf + (size_t)(bl * TT + pp) * 256 + h * 64 + e8;
            *(f32x4*)dst = *(const f32x4*)(oS + tk * 64 + e8); *(f32x4*)(dst + 4) = *(const f32x4*)(oS + tk * 64 + e8 + 4);
        }
    }
}

template <int L>
__device__ void hyena_unit(const P& p, int l, int bl, int c, char* smem) {
    constexpr int W = L == LQ ? 0 : 1, NU = L / 64;
    float* upad = (float*)smem;
    float* hS = upad + 2 * L;
    const int tid = TID();
    const float* hyT = wsp<const float>(p, OFF_HYT) + (W ? (size_t)BG * 768 * LQ : 0) + (size_t)bl * 768 * L;
    const float* hraw = wsp<const float>(p, OFF_HRAW) + (size_t)l * HRAW_L + (W ? (size_t)512 * LQ : 0);
    const float* psum = wsp<const float>(p, OFF_PSUM) + (size_t)l * 68 * 512 + (W ? 64 * 512 : 0);
    bf16_t* outs = wsp<bf16_t>(p, OFF_OUTS);
    const bool act = tid * 8 < L; const int t0 = tid * 8;
    float z[8];
    __syncthreads();
    for (int i = tid; i < 2 * L; i += NTHR) { const int s = i - L / 2; upad[i] = (s >= 0 && s < L) ? hyT[(size_t)c * L + s] : 0.f; }
    if (act) {
#pragma unroll
        for (int i = 0; i < 8; ++i) z[i] = hyT[(size_t)c * L + t0 + i];
    }
    for (int o = 0; o < 2; ++o) {
        const int n = o * 256 + c;
        float sc = 0.f;
        for (int q = 0; q < NU; ++q) sc += psum[q * 512 + n];
        const float inv = 1.0f / sc;
        for (int i = tid; i < L; i += NTHR) hS[i] = hraw[(size_t)n * L + i];
        __syncthreads();
        float acc[8];
#pragma unroll
        for (int i = 0; i < 8; ++i) acc[i] = 0.f;
        if (act) {
            float hi[8], lo[8];
            const float* wp = upad + t0 + L - 8;
#pragma unroll
            for (int m = 0; m < 8; ++m) hi[m] = wp[8 + m];
            for (int J = 0; J < L / 8; ++J) {
                const f32x4 l0 = *(const f32x4*)(wp - 8 * J), l1 = *(const f32x4*)(wp - 8 * J + 4);
                lo[0] = l0[0]; lo[1] = l0[1]; lo[2] = l0[2]; lo[3] = l0[3]; lo[4] = l1[0]; lo[5] = l1[1]; lo[6] = l1[2]; lo[7] = l1[3];
                const f32x4 h0 = *(const f32x4*)(hS + 8 * J), h1 = *(const f32x4*)(hS + 8 * J + 4);
                const float hv[8] = {h0[0], h0[1], h0[2], h0[3], h1[0], h1[1], h1[2], h1[3]};
#pragma unroll
                for (int jj = 0; jj < 8; ++jj)
#pragma unroll
                    for (int i = 0; i < 8; ++i) { const int m = i - jj + 8; acc[i] += hv[jj] * (m >= 8 ? hi[m - 8] : lo[m]); }
#pragma unroll
                for (int m = 0; m < 8; ++m) hi[m] = lo[m];
            }
        }
        const float bias = p.in[20][((size_t)l * 2 + o) * 256 + c];
        if (act) {
#pragma unroll
            for (int i = 0; i < 8; ++i) { const float gate = hyT[(size_t)((o + 1) * 256 + c) * L + t0 + i]; z[i] = gate * (acc[i] * inv + bias * z[i]); }
        }
        __syncthreads();
        if (o == 0) {
            if (act) {
#pragma unroll
                for (int i = 0; i < 8; ++i) upad[L / 2 + t0 + i] = z[i];
            }
        } else if (act) {
#pragma unroll
            for (int i = 0; i < 8; ++i) outs[(size_t)(bl * TT + (W ? 0 : LC) + t0 + i) * D + 256 + c] = f2bf(z[i]);
        }
        __syncthreads();
    }
}

__device__ void attn_unit(const P& p, int l, int bl, int h, int q0, int nkeys, char* smem) {
    float* Ks = (float*)smem;
    float* Vs = Ks + 64 * 64;
    const int tid = TID(), which = tid & 1;
    const bf16_t* Qa = wsp<const bf16_t>(p, OFF_QA) + ((size_t)bl * 4 + h) * TT * 64;
    const bf16_t* Ka = wsp<const bf16_t>(p, OFF_KA) + ((size_t)bl * 4 + h) * TT * 64;
    const bf16_t* Va = wsp<const bf16_t>(p, OFF_VA) + ((size_t)bl * 4 + h) * TT * 64;
    const int ln32 = tid & 31;
    float gqm = fabsf(p.in[23][l * 32 + ln32]), gkm = fabsf(p.in[24][l * 32 + ln32]);
#pragma unroll
    for (int o = 16; o > 0; o >>= 1) { gqm = fmaxf(gqm, __shfl_xor(gqm, o)); gkm = fmaxf(gkm, __shfl_xor(gkm, o)); }
    const float scale = 0.17677669529663687f, Mx = 32.0f * scale * gqm * gkm;
    const float* lp = p.in[25] + (size_t)l * 128;
    float s01 = lp[ln32] * lp[32 + ln32], s23 = lp[64 + ln32] * lp[96 + ln32];
#pragma unroll
    for (int o = 16; o > 0; o >>= 1) { s01 += __shfl_xor(s01, o); s23 += __shfl_xor(s23, o); }
    const float lam_init = 0.8f - 0.6f * expf(-0.3f * (float)l);
    const float lam = expf(s01) - expf(s23) + lam_init;
    const int qp = q0 + (tid >> 1);
    float q[32], O[64], ls = 0.f;
#pragma unroll
    for (int i = 0; i < 32; ++i) q[i] = bf2f(Qa[(size_t)qp * 64 + which * 32 + i]) * scale;
#pragma unroll
    for (int i = 0; i < 64; ++i) O[i] = 0.f;
    for (int k0 = 0; k0 < nkeys; k0 += 64) {
        __syncthreads();
        {
            const int key = tid >> 3, c8 = (tid & 7) * 8;
            const u32x4 kr = *(const u32x4*)(Ka + (size_t)(k0 + key) * 64 + c8), vr = *(const u32x4*)(Va + (size_t)(k0 + key) * 64 + c8);
#pragma unroll
            for (int i = 0; i < 4; ++i) {
                Ks[key * 64 + c8 + 2 * i] = __uint_as_float(kr[i] << 16); Ks[key * 64 + c8 + 2 * i + 1] = __uint_as_float(kr[i] & 0xffff0000u);
                Vs[key * 64 + c8 + 2 * i] = __uint_as_float(vr[i] << 16); Vs[key * 64 + c8 + 2 * i + 1] = __uint_as_float(vr[i] & 0xffff0000u);
            }
        }
        __syncthreads();
#pragma unroll 1
        for (int key = 0; key < 64; ++key) {
            float a = 0.f;
#pragma unroll
            for (int i = 0; i < 32; i += 4) {
                const f32x4 kk = *(const f32x4*)(Ks + key * 64 + which * 32 + i);
                a += q[i] * kk[0] + q[i + 1] * kk[1] + q[i + 2] * kk[2] + q[i + 3] * kk[3];
            }
            const float pr = __expf(a - Mx);
            ls += pr;
#pragma unroll
            for (int i = 0; i < 64; i += 4) {
                const f32x4 v = *(const f32x4*)(Vs + key * 64 + i);
                O[i] += pr * v[0]; O[i + 1] += pr * v[1]; O[i + 2] += pr * v[2]; O[i + 3] += pr * v[3];
            }
        }
    }
    asm volatile("" ::: "memory");
    {
        const float w = (which ? -lam : 1.0f) / ls; float ss = 0.f;
#pragma unroll
        for (int i = 0; i < 64; ++i) { const float t = O[i] * w; O[i] = t + __shfl_xor(t, 1); ss += O[i] * O[i]; }
        const float rs = rsqrtf(ss * (1.0f / 64.0f) + 1e-6f) * (1.0f - lam_init);
        const float* gn = p.in[26] + l * 64;
        bf16_t* dst = wsp<bf16_t>(p, OFF_OUTS) + (size_t)(bl * TT + qp) * D + 768 + h * 64;
#pragma unroll
        for (int i = 0; i < 64; i += 8) {
            if ((i >> 5) == which) {
                u32x4 w4;
#pragma unroll
                for (int j = 0; j < 4; ++j) w4[j] = pack2(O[i + 2 * j] * rs * gn[i + 2 * j], O[i + 2 * j + 1] * rs * gn[i + 2 * j + 1]);
                *(u32x4*)(dst + i) = w4;
            }
        }
    }
}

__device__ void ph_recur(const P& p, int l, char* smem) {
    const int NR = BG * 4 * 2 * 2;
    for (int u = BID(); u < NR; u += gridDim.x) {
        const int dir = u & 1, br = (u >> 1) & 1, h = (u >> 2) & 3, bl = u >> 4;
        if (br == 0) recur_unit<32>(p, l, bl, h, 0, dir, smem); else recur_unit<64>(p, l, bl, h, 1, dir, smem);
    }
}
__device__ void ph_attn(const P& p, int l, char* smem) {
    const bool last = l == NLAYER - 1;
    const int per = 16 + (last ? 0 : 1), NA = BG * 4 * per;
    for (int u = BID(); u < NA; u += gridDim.x) {
        const int qb = u % per, h = (u / per) & 3, bl = u / (per * 4);
        if (qb < 16) attn_unit(p, l, bl, h, LC + qb * 256, TT, smem);
        else attn_unit(p, l, bl, h, 0, LC, smem);
    }
}
__device__ void ph_hyena(const P& p, int l, char* smem) {
    const bool last = l == NLAYER - 1;
    const int NHL = BG * 256, NHC = last ? 0 : BG * 256;
    for (int u = BID(); u < NHL + NHC; u += gridDim.x) {
        if (u < NHL) hyena_unit<LQ>(p, l, u / 256, u % 256, smem);
        else { const int v = u - NHL; hyena_unit<LC>(p, l, v / 256, v % 256, smem); }
    }
}

__device__ void ph_gated(const P& p, int l) {
    const int tid = TID(), lane = tid & 63, wid = tid >> 6;
    const bf16_t* proj = wsp<const bf16_t>(p, OFF_BIG);
    const float* obuf = wsp<const float>(p, OFF_OBUF);
    bf16_t* outs = wsp<bf16_t>(p, OFF_OUTS);
    for (int r = BID() * 8 + wid; r < R; r += gridDim.x * 8) {
#pragma unroll
        for (int br = 0; br < 2; ++br) {
            const f32x4 a = *(const f32x4*)(obuf + ((size_t)(0 * 2 + br) * R + r) * 256 + lane * 4);
            const f32x4 b = *(const f32x4*)(obuf + ((size_t)(1 * 2 + br) * R + r) * 256 + lane * 4);
            float o[4] = {a[0] + b[0], a[1] + b[1], a[2] + b[2], a[3] + b[3]};
            float ss = o[0] * o[0] + o[1] * o[1] + o[2] * o[2] + o[3] * o[3];
            ss += __shfl_xor(ss, 1); ss += __shfl_xor(ss, 2); ss += __shfl_xor(ss, 4); ss += __shfl_xor(ss, 8);
            const float rs = rsqrtf(ss * (1.0f / 64.0f) + 1e-6f);
            const float* gn = p.in[br ? 22 : 11] + l * 64 + (lane & 15) * 4;
            const u32x2 graw = *(const u32x2*)(proj + (size_t)r * NP1 + (br ? C_HGG : C_GG) + lane * 4);
            const float gt[4] = {bf2f((bf16_t)(graw[0] & 0xffff)), bf2f((bf16_t)(graw[0] >> 16)), bf2f((bf16_t)(graw[1] & 0xffff)), bf2f((bf16_t)(graw[1] >> 16))};
#pragma unroll
            for (int c = 0; c < 4; ++c) o[c] = o[c] * rs * gn[c] * siluf_(gt[c]);
            u32x2 w; w[0] = pack2(o[0], o[1]); w[1] = pack2(o[2], o[3]);
            *(u32x2*)(outs + (size_t)r * D + (br ? 512 : 0) + lane * 4) = w;
        }
    }
}

__device__ void ph_merge(const P& p, int l, char* smem) {
    const int tid = TID(), lane = tid & 63, wid = tid >> 6, wr = wid / 4, wc = wid % 4, fr = lane & 15, fq = lane >> 4;
    const bool last = l == NLAYER - 1;
    const bf16_t* hx = wsp<const bf16_t>(p, OFF_HX); const bf16_t* outs = wsp<const bf16_t>(p, OFF_OUTS);
    const bf16_t* btg = wsp<const bf16_t>(p, OFF_BTGATE) + (size_t)l * 4096 * D;
    const bf16_t* btb = wsp<const bf16_t>(p, OFF_BTBR) + (size_t)l * 4 * 1024 * 256;
    bf16_t* merged = wsp<bf16_t>(p, OFF_BIG);
    for (int u = BID(); u < (R / 128) * 8; u += gridDim.x) {
        const int pm = u / 8, pn = u % 8;
        if (last && (pm % 34) < 2) continue;
        f32x4 mg[4][2]; ZERO_ACC(mg, 4, 2);
#pragma unroll 1
        for (int i = 0; i < 4; ++i) {
            f32x4 ag[4][2]; ZERO_ACC(ag, 4, 2);
            GSq::run(smem, [&](int r) { return hx + (size_t)(pm * 128 + r) * D; }, [&](int r) { return btg + (size_t)(i * 1024 + pn * 128 + r) * D; }, D, ag);
#pragma unroll
            for (int m = 0; m < 4; ++m)
#pragma unroll
                for (int n = 0; n < 2; ++n)
#pragma unroll
                    for (int j = 0; j < 4; ++j) ag[m][n][j] = sigmoidf_(ag[m][n][j]);
            f32x4 ab[4][2]; ZERO_ACC(ab, 4, 2);
            GSq::run(smem, [&](int r) { return outs + (size_t)(pm * 128 + r) * D + i * 256; }, [&](int r) { return btb + ((size_t)i * 1024 + pn * 128 + r) * 256; }, 256, ab);
#pragma unroll
            for (int m = 0; m < 4; ++m)
#pragma unroll
                for (int n = 0; n < 2; ++n) mg[m][n] += ag[m][n] * ab[m][n];
        }
#pragma unroll
        for (int m = 0; m < 4; ++m) {
            const int row = pm * 128 + wr * 64 + m * 16 + fr;
#pragma unroll
            for (int n = 0; n < 2; ++n) {
                const int col = pn * 128 + wc * 32 + n * 16 + fq * 4;
                u32x2 w; w[0] = pack2(mg[m][n][0], mg[m][n][1]); w[1] = pack2(mg[m][n][2], mg[m][n][3]);
                *(u32x2*)(merged + (size_t)row * D + col) = w;
            }
        }
    }
}

__device__ void ph_wout(const P& p, int l, int grp, char* smem) {
    const int tid = TID(), lane = tid & 63, wid = tid >> 6, wr = wid / 2, wc = wid % 2, fr = lane & 15, fq = lane >> 4;
    const bool last = l == NLAYER - 1;
    const bf16_t* merged = wsp<const bf16_t>(p, OFF_BIG);
    const bf16_t* bt = wsp<const bf16_t>(p, OFF_BTOUT) + (size_t)l * D * D;
    for (int u = BID(); u < (R / 256) * 8; u += gridDim.x) {
        const int pm = u / 8, pn = u % 8;
        if (last && (pm % 17) == 0) continue;
        f32x4 acc[4][4]; ZERO_ACC(acc, 4, 4);
        GBig::run(smem, [&](int i) { return merged + (size_t)(pm * 256 + i) * D; }, [&](int i) { return bt + (size_t)(pn * 128 + i) * D; }, D, acc);
#pragma unroll
        for (int m = 0; m < 4; ++m) {
            const int r = pm * 256 + wr * 64 + m * 16 + fr, bl = r / TT, pp = r % TT, b = grp * BG + bl;
            const float* src = stream_src(p, l, b, pp); float* dst = stream_dst(p, b, pp);
            const float* mod = (pp < LC ? wsp<const float>(p, OFF_MODC) + (size_t)l * 6144 : wsp<const float>(p, OFF_MODX) + ((size_t)l * NB + b) * 6144) + 2 * D;
#pragma unroll
            for (int n = 0; n < 4; ++n) {
                const int col = pn * 128 + wc * 64 + n * 16 + fq * 4;
                const f32x4 s = *(const f32x4*)(src + col), md = *(const f32x4*)(mod + col);
                *(f32x4*)(dst + col) = s + md * acc[m][n];
            }
        }
    }
}

__device__ void ph_topk(const P& p, int l, char* smem) {
    unsigned* keys = (unsigned*)smem;
    unsigned* red = keys + 4096;
    const int tid = TID(), lane = tid & 63, wid = tid >> 6;
    const bool last = l == NLAYER - 1;
    const int NU = BG * NEXP * (last ? 1 : 2);
    for (int u = BID(); u < NU; u += gridDim.x) {
        const int isctx = u >= BG * NEXP, v = isctx ? u - BG * NEXP : u, bl = v / NEXP, e = v % NEXP;
        const int L = isctx ? LC : LQ, cap = isctx ? CAPC : CAPL;
        const float* aff = wsp<const float>(p, OFF_AFF) + (isctx ? (size_t)BG * NEXP * LQ + (size_t)v * LC : (size_t)v * LQ);
        __syncthreads();
        for (int i = tid; i < 4096; i += NTHR) keys[i] = i < L ? __float_as_uint(aff[i]) : 0u;
        __syncthreads();
        unsigned my[8];
#pragma unroll
        for (int i = 0; i < 8; ++i) my[i] = keys[tid * 8 + i];
        unsigned T = 0u;
        for (int bit = 30; bit >= 0; --bit) {
            const unsigned cand = T | (1u << bit);
            int c = 0;
#pragma unroll
            for (int i = 0; i < 8; ++i) c += (my[i] >= cand) ? 1 : 0;
            c = (int)wave_sum((float)c);
            if (lane == 0) red[wid] = (unsigned)c;
            __syncthreads();
            int tot = 0;
#pragma unroll
            for (int w = 0; w < 8; ++w) tot += (int)red[w];
            __syncthreads();
            if (tot >= cap) T = cand;
        }
        int cg = 0, ce = 0;
#pragma unroll
        for (int i = 0; i < 8; ++i) { cg += (my[i] > T) ? 1 : 0; ce += (my[i] == T) ? 1 : 0; }
        unsigned pk = (unsigned)cg | ((unsigned)ce << 16), inc = pk;
#pragma unroll
        for (int o = 1; o < 64; o <<= 1) { const unsigned t = __shfl_up(inc, o); if (lane >= o) inc += t; }
        if (lane == 63) red[8 + wid] = inc;
        __syncthreads();
        unsigned base = 0u, totpk = 0u;
#pragma unroll
        for (int w = 0; w < 8; ++w) { const unsigned t = red[8 + w]; if (w < wid) base += t; totpk += t; }
        const unsigned ex = base + inc - pk;
        int rg = (int)(ex & 0xffffu), re = (int)(ex >> 16); const int G = (int)(totpk & 0xffffu);
        const int sbase = isctx ? LATS + (e * BG + bl) * CAPC : (bl * NEXP + e) * CAPL;
        int* sidx = wsp<int>(p, OFF_SIDX); float* sgv = wsp<float>(p, OFF_SGV); int* inv = wsp<int>(p, OFF_INV);
#pragma unroll
        for (int i = 0; i < 8; ++i) {
            const int tok = tid * 8 + i; int slot = -1;
            if (my[i] > T) slot = rg++;
            else if (my[i] == T) { if (G + re < cap) slot = G + re; re++; }
            if (slot >= 0 && tok < L) {
                const int r = bl * TT + (isctx ? tok : LC + tok);
                sidx[sbase + slot] = r; sgv[sbase + slot] = __uint_as_float(my[i]); inv[(size_t)r * NEXP + e] = sbase + slot;
            }
        }
    }
}

__device__ __forceinline__ int mtile_expert(int mt) { return mt < LATS / 256 ? (mt >> 1) & 15 : mt - LATS / 256; }

__device__ void ph_moe1(const P& p, int l, char* smem) {
    const int tid = TID(), lane = tid & 63, wid = tid >> 6, wr = wid / 2, wc = wid % 2, fr = lane & 15, fq = lane >> 4;
    const bool last = l == NLAYER - 1;
    const bf16_t* hx = wsp<const bf16_t>(p, OFF_HX); const int* sidx = wsp<const int>(p, OFF_SIDX);
    bf16_t* H = wsp<bf16_t>(p, OFF_BIG) + (size_t)NSLOT * D;
    const int nmt = last ? LATS / 256 : NSLOT / 256;
    for (int u = BID(); u < nmt * 16; u += gridDim.x) {
        const int mt = u / 16, pn = u % 16, e = mtile_expert(mt);
        const bf16_t* bt = wsp<const bf16_t>(p, OFF_BTW13) + ((size_t)l * NEXP + e) * 2048 * D;
        f32x4 acc[4][4]; ZERO_ACC(acc, 4, 4);
        GBig::run(smem, [&](int i) { return hx + (size_t)sidx[mt * 256 + i] * D; }, [&](int i) { return bt + (size_t)(pn * 128 + i) * D; }, D, acc);
#pragma unroll
        for (int m = 0; m < 4; ++m) {
            const int slot = mt * 256 + wr * 64 + m * 16 + fr;
#pragma unroll
            for (int n2 = 0; n2 < 2; ++n2) {
                const int col = (pn * 4 + wc * 2 + n2) * 16 + fq * 4;
                float hv[4];
#pragma unroll
                for (int j = 0; j < 4; ++j) hv[j] = siluf_(acc[m][2 * n2][j]) * acc[m][2 * n2 + 1][j];
                u32x2 w; w[0] = pack2(hv[0], hv[1]); w[1] = pack2(hv[2], hv[3]);
                *(u32x2*)(H + (size_t)slot * D + col) = w;
            }
        }
    }
}

__device__ void ph_moe2(const P& p, int l, char* smem) {
    const int tid = TID(), lane = tid & 63, wid = tid >> 6, wr = wid / 2, wc = wid % 2, fr = lane & 15, fq = lane >> 4;
    const bool last = l == NLAYER - 1;
    const bf16_t* H = wsp<const bf16_t>(p, OFF_BIG) + (size_t)NSLOT * D;
    bf16_t* Y = wsp<bf16_t>(p, OFF_BIG);
    const float* sgv = wsp<const float>(p, OFF_SGV);
    const int nmt = last ? LATS / 256 : NSLOT / 256;
    for (int u = BID(); u < nmt * 8; u += gridDim.x) {
        const int mt = u / 8, pn = u % 8, e = mtile_expert(mt);
        const bf16_t* bt = wsp<const bf16_t>(p, OFF_BTW2) + ((size_t)l * NEXP + e) * D * D;
        f32x4 acc[4][4]; ZERO_ACC(acc, 4, 4);
        GBig::run(smem, [&](int i) { return H + (size_t)(mt * 256 + i) * D; }, [&](int i) { return bt + (size_t)(pn * 128 + i) * D; }, D, acc);
#pragma unroll
        for (int m = 0; m < 4; ++m) {
            const int slot = mt * 256 + wr * 64 + m * 16 + fr; const float g = sgv[slot];
#pragma unroll
            for (int n = 0; n < 4; ++n) {
                const int col = pn * 128 + wc * 64 + n * 16 + fq * 4;
                u32x2 w; w[0] = pack2(acc[m][n][0] * g, acc[m][n][1] * g); w[1] = pack2(acc[m][n][2] * g, acc[m][n][3] * g);
                *(u32x2*)(Y + (size_t)slot * D + col) = w;
            }
        }
    }
}

__device__ void ph_combine(const P& p, int l, int grp) {
    const int tid = TID(), lane = tid & 63, wid = tid >> 6;
    const bool last = l == NLAYER - 1;
    const bf16_t* Y = wsp<const bf16_t>(p, OFF_BIG); const int* inv = wsp<const int>(p, OFF_INV);
    for (int r = BID() * 8 + wid; r < R; r += gridDim.x * 8) {
        const int bl = r / TT, pp = r % TT, b = grp * BG + bl;
        if (last && pp < LC) continue;
        float* dst = stream_dst(p, b, pp);
        const float* mod = (pp < LC ? wsp<const float>(p, OFF_MODC) + (size_t)l * 6144 : wsp<const float>(p, OFF_MODX) + ((size_t)l * NB + b) * 6144) + 5 * D;
        const int myinv = lane < NEXP ? inv[(size_t)r * NEXP + lane] : -1;
        float acc[16];
#pragma unroll
        for (int i = 0; i < 16; ++i) acc[i] = 0.f;
        for (int e = 0; e < NEXP; ++e) {
            const int s = __shfl(myinv, e);
            if (s >= 0) {
#pragma unroll
                for (int i = 0; i < 2; ++i) {
                    const u32x4 w = *(const u32x4*)(Y + (size_t)s * D + i * 512 + lane * 8);
#pragma unroll
                    for (int j = 0; j < 4; ++j) { acc[i * 8 + 2 * j] += __uint_as_float(w[j] << 16); acc[i * 8 + 2 * j + 1] += __uint_as_float(w[j] & 0xffff0000u); }
                }
            }
        }
#pragma unroll
        for (int i = 0; i < 2; ++i)
#pragma unroll
            for (int j = 0; j < 2; ++j) {
                const int c = i * 512 + lane * 8 + j * 4;
                f32x4 x = *(const f32x4*)(dst + c); const f32x4 md = *(const f32x4*)(mod + c);
#pragma unroll
                for (int q = 0; q < 4; ++q) x[q] += md[q] * acc[i * 8 + j * 4 + q];
                *(f32x4*)(dst + c) = x;
            }
    }
}

#define XB_TMO      128
#define XB_XCNT(j)  (256  + 64 * (j))
#define XB_XSUB(j)  (1280 + 64 * (j))
#define XB_XGEN(j)  (2304 + 64 * (j))
#define XB_TOP      3328
#define XB_TOPGEN   3392
#define XCD_BAR_WORDS 3456
#define XB_SPIN_CAP (1u << 18)
#define LAS __attribute__((address_space(3)))

__device__ __forceinline__ unsigned xb_ld(unsigned* p)              { return __hip_atomic_load(p, __ATOMIC_RELAXED, __HIP_MEMORY_SCOPE_AGENT); }
__device__ __forceinline__ unsigned xb_add(unsigned* p, unsigned v) { return __hip_atomic_fetch_add(p, v, __ATOMIC_RELAXED, __HIP_MEMORY_SCOPE_AGENT); }
__device__ __forceinline__ unsigned xb_xcc_id() { return (unsigned)__builtin_amdgcn_s_getreg((3 << 11) | 20) & 0xFu; }
#define XB_SPIN(cond, bar) do { unsigned _sp = 0; while (cond) { __builtin_amdgcn_s_sleep(1); \
    if ((++_sp & 255u) == 0u) { if (xb_ld(&(bar)[XB_TMO])) break; if (_sp > XB_SPIN_CAP) { atomicAdd(&(bar)[XB_TMO], 1u); break; } } } } while (0)

struct XcdBarrier {
    unsigned* bar; unsigned x;
    volatile LAS unsigned* st;
};

__device__ __forceinline__ XcdBarrier xcd_barrier_post(unsigned* bar, volatile LAS unsigned* st) {
    XcdBarrier b; b.bar = bar; b.x = xb_xcc_id(); b.st = st;
    if (threadIdx.x == 0) (void)xb_add(&bar[XB_XCNT(b.x)], 1u);
    return b;
}
__device__ __forceinline__ void xcd_barrier_complete(unsigned* bar, unsigned x, unsigned& nloc, unsigned& nx) {
    const unsigned G = gridDim.x * gridDim.y * gridDim.z;
    unsigned sum, cnt, mine, sp = 0u;
    for (;;) {
        sum = 0u; cnt = 0u; mine = 0u;
#pragma unroll
        for (unsigned j = 0; j < 16; ++j) { const unsigned c = xb_ld(&bar[XB_XCNT(j)]); sum += c; cnt += (c > 0u) ? 1u : 0u; mine = (j == x) ? c : mine; }
        if (sum == G) break;
        __builtin_amdgcn_s_sleep(1);
        if ((++sp & 255u) == 0u) { if (xb_ld(&bar[XB_TMO])) break; if (sp > XB_SPIN_CAP) { atomicAdd(&bar[XB_TMO], 1u); break; } }
    }
    nloc = mine > 0u ? mine : 1u; nx = cnt > 0u ? cnt : 1u;
}

__device__ __forceinline__ void xcd_barrier(const XcdBarrier& b) {
    asm volatile("s_waitcnt vmcnt(0)" ::: "memory");
    __syncthreads();
    if (threadIdx.x == 0) {
        unsigned* bar = b.bar;
        __builtin_amdgcn_s_waitcnt(0);
        unsigned nloc = b.st[0], nx = b.st[1];
        if (nloc == 0u) { xcd_barrier_complete(bar, b.x, nloc, nx); b.st[0] = nloc; b.st[1] = nx; }
        const unsigned old = xb_add(&bar[XB_XSUB(b.x)], 1u);
        const unsigned gen = old / nloc;
        if (old + 1u == (gen + 1u) * nloc) {
            __builtin_amdgcn_fence(__ATOMIC_RELEASE, "agent");
            asm volatile("s_waitcnt vmcnt(0)" ::: "memory");
            const unsigned og = xb_add(&bar[XB_TOP], 1u);
            const unsigned tg = og / nx;
            if (og + 1u == (tg + 1u) * nx) xb_add(&bar[XB_TOPGEN], 1u);
            else XB_SPIN(xb_ld(&bar[XB_TOPGEN]) == tg, bar);
            __builtin_amdgcn_fence(__ATOMIC_ACQUIRE, "agent");
            xb_add(&bar[XB_XGEN(b.x)], 1u);
            asm volatile("s_waitcnt vmcnt(0)" ::: "memory");
        } else {
            XB_SPIN(xb_ld(&bar[XB_XGEN(b.x)]) == gen, bar);
            __builtin_amdgcn_fence(__ATOMIC_ACQUIRE, "agent");
            asm volatile("s_waitcnt vmcnt(0)" ::: "memory");
        }
    }
    __syncthreads();
}


enum { PH_WEIGHTS, PH_MOD, PH_HFILT, PH_NORM1, PH_G1, PH_PREP, PH_RECUR, PH_ATTN, PH_HYENA, PH_GATED, PH_MERGE, PH_WOUT, PH_NORM2, PH_TOPK, PH_MOE1, PH_MOE2, PH_COMBINE };

template <int PH>
__device__ __forceinline__ void run_phase(const P& p, int l, int grp, char* smem) {
    if (PH == PH_WEIGHTS) ph_weights(p, smem);
    if (PH == PH_MOD) ph_mod(p, smem);
    if (PH == PH_HFILT) ph_hfilt(p, smem);
    if (PH == PH_NORM1) ph_norm<0>(p, l, grp, smem);
    if (PH == PH_G1) ph_g1(p, l, smem);
    if (PH == PH_PREP) { ph_attn_prep(p, l); ph_hy_prep(p, l, smem); }
    if (PH == PH_RECUR) ph_recur(p, l, smem);
    if (PH == PH_ATTN) ph_attn(p, l, smem);
    if (PH == PH_HYENA) ph_hyena(p, l, smem);
    if (PH == PH_GATED) ph_gated(p, l);
    if (PH == PH_MERGE) ph_merge(p, l, smem);
    if (PH == PH_WOUT) ph_wout(p, l, grp, smem);
    if (PH == PH_NORM2) ph_norm<1>(p, l, grp, smem);
    if (PH == PH_TOPK) ph_topk(p, l, smem);
    if (PH == PH_MOE1) ph_moe1(p, l, smem);
    if (PH == PH_MOE2) ph_moe2(p, l, smem);
    if (PH == PH_COMBINE) ph_combine(p, l, grp);
}

#if !FUSED
template <int PH>
__global__ void __launch_bounds__(NTHR, 2) k_phase(P p, int l, int grp) {
    extern __shared__ __attribute__((aligned(16))) char smem[];
    run_phase<PH>(p, l, grp, smem);
}

template <int PH>
static void launch_phase(const P& p, int l, int grp, int grid, hipStream_t stream) {
    static bool attr = false;
    if (!attr) { (void)hipFuncSetAttribute((const void*)k_phase<PH>, hipFuncAttributeMaxDynamicSharedMemorySize, SMEM_BYTES); attr = true; }
    k_phase<PH><<<grid, NTHR, SMEM_BYTES, stream>>>(p, l, grp);
}
#endif


#define GRID_SYNC() xcd_barrier(bar)
__global__ void __launch_bounds__(NTHR, 2) k_fused(P p) {
    extern __shared__ __attribute__((aligned(16))) char smem[];
    volatile LAS unsigned* xbw = (volatile LAS unsigned*)(smem + SMEM_BYTES);
    if (threadIdx.x == 0) { xbw[0] = 0u; xbw[1] = 0u; xbw[2] = 0u; xbw[3] = 0u; }
    __syncthreads();
    XcdBarrier bar = xcd_barrier_post(wsp<unsigned>(p, OFF_BAR), xbw);
    ph_weights(p, smem);
    ph_mod(p, smem);
    ph_hfilt(p, smem);
    GRID_SYNC();
#pragma unroll 1
    for (int grp = 0; grp < NGRP; ++grp) {
#pragma unroll 1
        for (int l = 0; l < NLAYER; ++l) {
            ph_norm<0>(p, l, grp, smem); GRID_SYNC();
            ph_g1(p, l, smem); GRID_SYNC();
            ph_attn_prep(p, l); ph_hy_prep(p, l, smem); GRID_SYNC();
            ph_recur(p, l, smem); ph_attn(p, l, smem); ph_hyena(p, l, smem); GRID_SYNC();
            ph_gated(p, l); GRID_SYNC();
            ph_merge(p, l, smem); GRID_SYNC();
            ph_wout(p, l, grp, smem); GRID_SYNC();
            ph_norm<1>(p, l, grp, smem); GRID_SYNC();
            ph_topk(p, l, smem); GRID_SYNC();
            ph_moe1(p, l, smem); GRID_SYNC();
            ph_moe2(p, l, smem); GRID_SYNC();
            ph_combine(p, l, grp); GRID_SYNC();
        }
    }
}

extern "C" void kernel_launch(void* const* d_in, const int* in_sizes, int n_in, void* d_out, int out_size, void* d_ws, size_t ws_size, hipStream_t stream) {
    P p{};
    for (int i = 0; i < 33; ++i) p.in[i] = (const float*)d_in[i];
    p.out = (float*)d_out; p.ws = (char*)d_ws;
#if FUSED
    static int grid = 0;
    if (!grid) {
        int dev = 0, cus = 0, per_cu = 0;
        (void)hipGetDevice(&dev);
        (void)hipDeviceGetAttribute(&cus, hipDeviceAttributeMultiprocessorCount, dev);
        (void)hipFuncSetAttribute((const void*)k_fused, hipFuncAttributeMaxDynamicSharedMemorySize, SMEM_BYTES + 16);
        (void)hipOccupancyMaxActiveBlocksPerMultiprocessor(&per_cu, k_fused, NTHR, SMEM_BYTES + 16);
        grid = cus * (per_cu < 1 ? per_cu : 1);
        if (grid <= 0) grid = 256;
    }
    (void)hipMemsetAsync(d_ws, 0, XCD_BAR_WORDS * sizeof(unsigned), stream);
    k_fused<<<grid, NTHR, SMEM_BYTES + 16, stream>>>(p);
#else
    const int grid = 256;
    launch_phase<PH_WEIGHTS>(p, 0, 0, grid, stream);
    launch_phase<PH_MOD>(p, 0, 0, grid, stream);
    launch_phase<PH_HFILT>(p, 0, 0, grid, stream);
    for (int grp = 0; grp < NGRP; ++grp)
        for (int l = 0; l < NLAYER; ++l) {
            launch_phase<PH_NORM1>(p, l, grp, grid, stream);
            launch_phase<PH_G1>(p, l, grp, grid, stream);
            launch_phase<PH_PREP>(p, l, grp, grid, stream);
            launch_phase<PH_RECUR>(p, l, grp, grid, stream);
            launch_phase<PH_ATTN>(p, l, grp, grid, stream);
            launch_phase<PH_HYENA>(p, l, grp, grid, stream);
            launch_phase<PH_GATED>(p, l, grp, grid, stream);
            launch_phase<PH_MERGE>(p, l, grp, grid, stream);
            launch_phase<PH_WOUT>(p, l, grp, grid, stream);
            launch_phase<PH_NORM2>(p, l, grp, grid, stream);
            launch_phase<PH_TOPK>(p, l, grp, grid, stream);
            launch_phase<PH_MOE1>(p, l, grp, grid, stream);
            launch_phase<PH_MOE2>(p, l, grp, grid, stream);
            launch_phase<PH_COMBINE>(p, l, grp, grid, stream);
        }
#endif
}
```

```cpp
#include <hip/hip_runtime.h>
#include <stdint.h>

#ifndef FUSED
#define FUSED 1
#endif

typedef unsigned short bf16_t;
typedef short bf16x8 __attribute__((ext_vector_type(8)));
typedef float f32x4 __attribute__((ext_vector_type(4)));
typedef unsigned u32x4 __attribute__((ext_vector_type(4)));
typedef unsigned u32x2 __attribute__((ext_vector_type(2)));

#define NTHR 512
constexpr int D = 1024, NB = 16, LQ = 4096, LC = 256, TT = 4352, NLAYER = 2;
constexpr int BG = 8, NGRP = NB / BG, R = BG * TT;
constexpr int NP1 = 3840;
constexpr int C_GQ = 0, C_GK = 128, C_GV = 256, C_GAF = 512, C_GAB = 528, C_GG = 544, C_HY = 800, C_HQ = 1568, C_HFF = 1824, C_HFB = 2080,
              C_HI = 2336, C_HGG = 2592, C_DQ = 2848, C_DK = 3104, C_DV = 3360, C_MG = 3616, N_IN = 7712;
constexpr int NEXP = 16, CAPL = 512, CAPC = 32, LATS = BG * NEXP * CAPL, NSLOT = LATS + BG * NEXP * CAPC;
constexpr int SMEM_BYTES = 114688;

constexpr size_t al256(size_t x) { return (x + 255) & ~(size_t)255; }
constexpr size_t OFF_BAR = 0;
constexpr size_t OFF_BTIN1 = 65536;
constexpr size_t OFF_BTGATE = OFF_BTIN1 + (size_t)NLAYER * NP1 * D * 2;
constexpr size_t OFF_BTBR = OFF_BTGATE + (size_t)NLAYER * 4096 * D * 2;
constexpr size_t OFF_BTOUT = OFF_BTBR + (size_t)NLAYER * 4 * 1024 * 256 * 2;
constexpr size_t OFF_BTW13 = OFF_BTOUT + (size_t)NLAYER * D * D * 2;
constexpr size_t OFF_BTW2 = OFF_BTW13 + (size_t)NLAYER * NEXP * 2048 * D * 2;
constexpr size_t OFF_MODX = OFF_BTW2 + (size_t)NLAYER * NEXP * D * D * 2;
constexpr size_t OFF_MODC = OFF_MODX + (size_t)NLAYER * NB * 6144 * 4;
constexpr size_t OFF_HRAW = OFF_MODC + (size_t)NLAYER * 6144 * 4;
constexpr size_t HRAW_L = (size_t)512 * (LQ + LC);
constexpr size_t OFF_PSUM = OFF_HRAW + (size_t)NLAYER * HRAW_L * 4;
constexpr size_t OFF_XC = OFF_PSUM + (size_t)NLAYER * 68 * 512 * 4;
constexpr size_t OFF_HX = OFF_XC + (size_t)NB * LC * D * 4;
constexpr size_t OFF_BIG = OFF_HX + (size_t)R * D * 2;
constexpr size_t BIG_BYTES = (size_t)2 * NSLOT * D * 2;
constexpr size_t OFF_OUTS = OFF_BIG + BIG_BYTES;
constexpr size_t OFF_QA = OFF_OUTS + (size_t)R * D * 2;
constexpr size_t OFF_KA = OFF_QA + (size_t)BG * 4 * TT * 64 * 2;
constexpr size_t OFF_VA = OFF_KA + (size_t)BG * 4 * TT * 64 * 2;
constexpr size_t OFF_OBUF = OFF_VA + (size_t)BG * 4 * TT * 64 * 2;
constexpr size_t OFF_HYT = OFF_OBUF + (size_t)4 * R * 256 * 4;
constexpr size_t OFF_AFF = OFF_HYT + (size_t)BG * 768 * TT * 4;
constexpr size_t OFF_INV = OFF_AFF + (size_t)BG * NEXP * TT * 4;
constexpr size_t OFF_SIDX = OFF_INV + (size_t)R * NEXP * 4;
constexpr size_t OFF_SGV = OFF_SIDX + (size_t)NSLOT * 4;
constexpr size_t WS_END = OFF_SGV + (size_t)NSLOT * 4;
static_assert(WS_END < (size_t)1000 * 1024 * 1024, "workspace too big");
static_assert(BIG_BYTES >= (size_t)R * NP1 * 2, "big region");

struct P {
    const float* in[33];
    float* out;
    char* ws;
};

__device__ __forceinline__ bf16_t f2bf(float f) { unsigned u = __float_as_uint(f); u += 0x7fffu + ((u >> 16) & 1u); return (bf16_t)(u >> 16); }
__device__ __forceinline__ float bf2f(bf16_t h) { return __uint_as_float((unsigned)h << 16); }
typedef float f32x2 __attribute__((ext_vector_type(2)));
typedef __bf16 bf16x2_t __attribute__((ext_vector_type(2)));
__device__ __forceinline__ unsigned cvt_pk_bf16(float lo, float hi) { const f32x2 v = {lo, hi}; return __builtin_bit_cast(unsigned, __builtin_convertvector(v, bf16x2_t)); }
__device__ __forceinline__ unsigned pack2(float a, float b) { return cvt_pk_bf16(a, b); }
__device__ __forceinline__ float sigmoidf_(float x) { return 1.0f / (1.0f + __expf(-x)); }
__device__ __forceinline__ float siluf_(float x) { return x / (1.0f + __expf(-x)); }
__device__ __forceinline__ float wave_sum(float v) {
#pragma unroll
    for (int o = 32; o > 0; o >>= 1) v += __shfl_xor(v, o);
    return v;
}

template <class T> __device__ __forceinline__ T* wsp(const P& p, size_t off) { return (T*)(p.ws + off); }

__device__ __forceinline__ const float* stream_src(const P& p, int l, int b, int pp) {
    if (pp < LC) return (l == 0 ? p.in[2] : wsp<const float>(p, OFF_XC)) + ((size_t)b * LC + pp) * D;
    return (l == 0 ? p.in[0] : (const float*)p.out) + ((size_t)b * LQ + (pp - LC)) * D;
}
__device__ __forceinline__ float* stream_dst(const P& p, int b, int pp) {
    if (pp < LC) return wsp<float>(p, OFF_XC) + ((size_t)b * LC + pp) * D;
    return p.out + ((size_t)b * LQ + (pp - LC)) * D;
}

__device__ __forceinline__ int TID() { int t = threadIdx.x; asm volatile("" : "+v"(t)); return t; }
__device__ __forceinline__ int BID() { int t = blockIdx.x; asm volatile("" : "+s"(t)); return t; }

__device__ void xpose_job(const float* __restrict__ src, int ldS, int K, int N, bf16_t* __restrict__ dst, int mode, int which, float* tile) {
    const int tid = TID();
    const int tk = K / 64, tn = (N + 63) / 64, nt = tk * tn;
    for (int t = BID(); t < nt; t += gridDim.x) {
        const int k0 = (t % tk) * 64, n0 = (t / tk) * 64;
        __syncthreads();
#pragma unroll
        for (int ps = 0; ps < 2; ++ps) {
            const int i = (tid >> 4) + 32 * ps, j4 = (tid & 15) * 4;
            f32x4 v = {0.f, 0.f, 0.f, 0.f};
            if (n0 + j4 < N) v = *(const f32x4*)(src + (size_t)(k0 + i) * ldS + n0 + j4);
            tile[i * 65 + j4 + 0] = v[0]; tile[i * 65 + j4 + 1] = v[1]; tile[i * 65 + j4 + 2] = v[2]; tile[i * 65 + j4 + 3] = v[3];
        }
        __syncthreads();
        const int n = tid >> 3, kc = (tid & 7) * 8;
        if (n0 + n < N) {
            const int ng = n0 + n;
            const int drow = mode == 0 ? ng : ((ng >> 4) * 32 + which * 16 + (ng & 15));
            u32x4 w;
            w[0] = pack2(tile[(kc + 0) * 65 + n], tile[(kc + 1) * 65 + n]);
            w[1] = pack2(tile[(kc + 2) * 65 + n], tile[(kc + 3) * 65 + n]);
            w[2] = pack2(tile[(kc + 4) * 65 + n], tile[(kc + 5) * 65 + n]);
            w[3] = pack2(tile[(kc + 6) * 65 + n], tile[(kc + 7) * 65 + n]);
            *(u32x4*)(dst + (size_t)drow * K + k0 + kc) = w;
        }
    }
}

__device__ void ph_weights(const P& p, char* smem) {
    float* tile = (float*)smem;
    for (int l = 0; l < NLAYER; ++l) {
        const float* win = p.in[8] + (size_t)l * D * N_IN;
        bf16_t* bt1 = wsp<bf16_t>(p, OFF_BTIN1) + (size_t)l * NP1 * D;
        xpose_job(win, N_IN, D, C_MG, bt1, 0, 0, tile);
        for (size_t i = (size_t)BID() * NTHR + TID(); i < (size_t)(NP1 - C_MG) * D / 8; i += (size_t)gridDim.x * NTHR)
            *(u32x4*)(bt1 + (size_t)C_MG * D + i * 8) = (u32x4){0u, 0u, 0u, 0u};
        xpose_job(win + C_MG, N_IN, D, 4096, wsp<bf16_t>(p, OFF_BTGATE) + (size_t)l * 4096 * D, 0, 0, tile);
        for (int i = 0; i < 4; ++i)
            xpose_job(p.in[27] + ((size_t)l * 4 + i) * 256 * D, D, 256, D, wsp<bf16_t>(p, OFF_BTBR) + ((size_t)l * 4 + i) * 1024 * 256, 0, 0, tile);
        xpose_job(p.in[28] + (size_t)l * D * D, D, D, D, wsp<bf16_t>(p, OFF_BTOUT) + (size_t)l * D * D, 0, 0, tile);
        for (int e = 0; e < NEXP; ++e) {
            const size_t le = (size_t)l * NEXP + e;
            xpose_job(p.in[30] + le * D * D, D, D, D, wsp<bf16_t>(p, OFF_BTW13) + le * 2048 * D, 1, 0, tile);
            xpose_job(p.in[31] + le * D * D, D, D, D, wsp<bf16_t>(p, OFF_BTW13) + le * 2048 * D, 1, 1, tile);
            xpose_job(p.in[32] + le * D * D, D, D, D, wsp<bf16_t>(p, OFF_BTW2) + le * D * D, 0, 0, tile);
        }
    }
}

__device__ void ph_mod(const P& p, char* smem) {
    float* s = (float*)smem;
    float* red = s + 17 * 1024;
    const int tid = TID();
    for (int i = tid; i < 17 * 1024; i += NTHR) { const float v = i < 16384 ? p.in[1][i] : p.in[3][i - 16384]; s[i] = siluf_(v); }
    __syncthreads();
    for (int u = BID(); u < NLAYER * 96; u += gridDim.x) {
        const int l = u / 96, col = (u % 96) * 64 + (tid & 63), ks = tid >> 6;
        const float* w = p.in[4] + (size_t)l * D * 6144 + col;
        float acc[17];
#pragma unroll
        for (int r = 0; r < 17; ++r) acc[r] = 0.f;
        for (int k = ks * 128; k < ks * 128 + 128; ++k) {
            const float wv = w[(size_t)k * 6144];
#pragma unroll
            for (int r = 0; r < 17; ++r) acc[r] += s[r * 1024 + k] * wv;
        }
#pragma unroll
        for (int r = 0; r < 17; ++r) red[(ks * 17 + r) * 64 + (tid & 63)] = acc[r];
        __syncthreads();
        for (int i = tid; i < 17 * 64; i += NTHR) {
            const int r = i / 64, c = i % 64, cg = (u % 96) * 64 + c;
            float v = p.in[5][(size_t)l * 6144 + cg];
#pragma unroll
            for (int q = 0; q < 8; ++q) v += red[(q * 17 + r) * 64 + c];
            if (r < 16) wsp<float>(p, OFF_MODX)[((size_t)l * NB + r) * 6144 + cg] = v;
            else wsp<float>(p, OFF_MODC)[(size_t)l * 6144 + cg] = v;
        }
        __syncthreads();
    }
}

__device__ void ph_hfilt(const P& p, char* smem) {
    float* feats = (float*)smem;
    float* h1 = feats + 64 * 33;
    float* h2 = h1 + 64 * 64;
    const int tid = TID();
    for (int u = BID(); u < NLAYER * 68; u += gridDim.x) {
        const int l = u / 68, ub = u % 68, w = ub >= 64 ? 1 : 0, jb = w ? ub - 64 : ub, L = w ? LC : LQ;
        __syncthreads();
        for (int i = tid; i < 64 * 33; i += NTHR) {
            const int pos = i / 33, fi = i % 33; const float j = (float)(jb * 64 + pos);
            float v;
            if (fi == 0) v = j / (float)(L - 1);
            else {
                const int k = (fi - 1) & 15; const float f = 1e-4f + (float)k * ((15.0f - 1e-4f) / 15.0f);
                const float wv = 6.283185307179586f * j / (float)L;
                v = fi <= 16 ? cosf(wv * f) : -sinf(wv * f);
            }
            feats[i] = v;
        }
        __syncthreads();
        const float* w1 = p.in[13] + (size_t)l * 33 * 64; const float* b1 = p.in[14] + l * 64;
        const float* w2 = p.in[15] + (size_t)l * 64 * 64; const float* b2 = p.in[16] + l * 64;
        const float* w3 = p.in[17] + (size_t)l * 64 * 512; const float* fr = p.in[18] + l * 128;
        for (int i = tid; i < 64 * 64; i += NTHR) {
            const int pos = i >> 6, k = i & 63; float a = b1[k];
            for (int f = 0; f < 33; ++f) a += feats[pos * 33 + f] * w1[f * 64 + k];
            h1[i] = sinf(fr[k] * a);
        }
        __syncthreads();
        for (int i = tid; i < 64 * 64; i += NTHR) {
            const int pos = i >> 6, k = i & 63; float a = b2[k];
            for (int f = 0; f < 64; ++f) a += h1[pos * 64 + f] * w2[f * 64 + k];
            h2[i] = sinf(fr[64 + k] * a);
        }
        __syncthreads();
        {
            const int n = tid; float asum = 0.f;
            const float dec = fabsf(p.in[19][(size_t)l * 512 + n]);
            float* hr = wsp<float>(p, OFF_HRAW) + (size_t)l * HRAW_L + (w ? (size_t)512 * LQ : 0) + (size_t)n * L + jb * 64;
            for (int pos = 0; pos < 64; ++pos) {
                float a = 0.f;
                for (int k = 0; k < 64; ++k) a += h2[pos * 64 + k] * w3[k * 512 + n];
                const int j = jb * 64 + pos; const float dist = fabsf((float)(j - L / 2)) / (float)(L / 2);
                a *= __expf(-dist * dec) + 0.05f;
                hr[pos] = a; asum += fabsf(a);
            }
            wsp<float>(p, OFF_PSUM)[((size_t)l * 68 + ub) * 512 + n] = asum;
        }
    }
}

template <int WHICH>
__device__ void ph_norm(const P& p, int l, int grp, char* smem) {
    const int tid = TID(), lane = tid & 63, wid = tid >> 6;
    float* rt = (float*)smem;
    if (WHICH == 1) {
        const float* rsrc = p.in[29] + (size_t)l * D * NEXP;
        for (int i = tid; i < D * NEXP / 4; i += NTHR) ((f32x4*)rt)[i] = ((const f32x4*)rsrc)[i];
        __syncthreads();
    }
    const float* gain = p.in[WHICH ? 7 : 6] + (size_t)l * D;
    bf16_t* hx = wsp<bf16_t>(p, OFF_HX);
    for (int r = BID() * 8 + wid; r < R; r += gridDim.x * 8) {
        const int bl = r / TT, pp = r % TT, b = grp * BG + bl; const bool isctx = pp < LC;
        if (WHICH == 1 && l == NLAYER - 1 && isctx) continue;
        const float* src = WHICH == 0 ? stream_src(p, l, b, pp) : (const float*)stream_dst(p, b, pp);
        const float* mod = isctx ? wsp<const float>(p, OFF_MODC) + (size_t)l * 6144 : wsp<const float>(p, OFF_MODX) + ((size_t)l * NB + b) * 6144;
        const float* shp = mod + (WHICH ? 3 : 0) * D; const float* scp = mod + (WHICH ? 4 : 1) * D;
        f32x4 x[4]; float ss = 0.f;
#pragma unroll
        for (int i = 0; i < 4; ++i) { x[i] = *(const f32x4*)(src + i * 256 + lane * 4); ss += x[i][0] * x[i][0] + x[i][1] * x[i][1] + x[i][2] * x[i][2] + x[i][3] * x[i][3]; }
        ss = wave_sum(ss);
        const float rs = rsqrtf(ss * (1.0f / D) + 1e-6f);
        float lg[NEXP];
#pragma unroll
        for (int e = 0; e < NEXP; ++e) lg[e] = 0.f;
#pragma unroll
        for (int i = 0; i < 4; ++i) {
            const int c = i * 256 + lane * 4;
            const f32x4 g = *(const f32x4*)(gain + c), sh = *(const f32x4*)(shp + c), sc = *(const f32x4*)(scp + c);
            f32x4 y;
#pragma unroll
            for (int j = 0; j < 4; ++j) y[j] = x[i][j] * rs * g[j] * (1.0f + sc[j]) + sh[j];
            u32x2 w; w[0] = pack2(y[0], y[1]); w[1] = pack2(y[2], y[3]);
            *(u32x2*)(hx + (size_t)r * D + c) = w;
            if (WHICH == 1) {
#pragma unroll
                for (int j = 0; j < 4; ++j) {
#pragma unroll
                    for (int e4 = 0; e4 < 4; ++e4) { const f32x4 rv = *(const f32x4*)(rt + (c + j) * NEXP + e4 * 4);
                        lg[e4 * 4 + 0] += y[j] * rv[0]; lg[e4 * 4 + 1] += y[j] * rv[1]; lg[e4 * 4 + 2] += y[j] * rv[2]; lg[e4 * 4 + 3] += y[j] * rv[3]; }
                }
            }
        }
        if (WHICH == 1) {
            float mx = -1e30f;
#pragma unroll
            for (int e = 0; e < NEXP; ++e) { lg[e] = wave_sum(lg[e]); mx = fmaxf(mx, lg[e]); }
            float sum = 0.f, mine = 0.f;
#pragma unroll
            for (int e = 0; e < NEXP; ++e) { const float ev = __expf(lg[e] - mx); sum += ev; mine = (lane == e) ? ev : mine; }
            if (lane < NEXP) {
                float* aff = wsp<float>(p, OFF_AFF);
                if (isctx) aff[(size_t)BG * NEXP * LQ + ((size_t)bl * NEXP + lane) * LC + pp] = mine / sum;
                else aff[((size_t)bl * NEXP + lane) * LQ + (pp - LC)] = mine / sum;
                wsp<int>(p, OFF_INV)[(size_t)r * NEXP + lane] = -1;
            }
        }
    }
}

template <int WR, int WC, int MT, int NT>
struct GC {
    static constexpr int BM = WR * MT * 16, BN = WC * NT * 16, ROWB = 144;
    static constexpr int A_BYTES = BM * ROWB, B_BYTES = BN * ROWB, STAGE = A_BYTES + B_BYTES;
    static constexpr int A_CH = BM * 8 / NTHR, B_CH = BN * 8 / NTHR;
    static_assert(2 * STAGE <= SMEM_BYTES, "lds");
    template <class AR, class BR>
    static __device__ __forceinline__ void run(char* smem, AR arow, BR brow, int K, f32x4 (&acc)[MT][NT]) {
        const int tid = TID(), lane = tid & 63, wid = tid >> 6, wr = wid / WC, wc = wid % WC, fr = lane & 15, fq = lane >> 4;
        const bf16_t* ap[A_CH]; const bf16_t* bp[B_CH]; int aoff[A_CH], boff[B_CH];
#pragma unroll
        for (int i = 0; i < A_CH; ++i) { const int c = tid + NTHR * i, row = c >> 3, kc = c & 7; ap[i] = arow(row) + kc * 8; aoff[i] = row * ROWB + kc * 16; }
#pragma unroll
        for (int i = 0; i < B_CH; ++i) { const int c = tid + NTHR * i, row = c >> 3, kc = c & 7; bp[i] = brow(row) + kc * 8; boff[i] = A_BYTES + row * ROWB + kc * 16; }
        u32x4 ra[A_CH], rb[B_CH];
        const int nk = K / 64;
#pragma unroll
        for (int i = 0; i < A_CH; ++i) ra[i] = *(const u32x4*)(ap[i]);
#pragma unroll
        for (int i = 0; i < B_CH; ++i) rb[i] = *(const u32x4*)(bp[i]);
        __syncthreads();
#pragma unroll
        for (int i = 0; i < A_CH; ++i) *(u32x4*)(smem + aoff[i]) = ra[i];
#pragma unroll
        for (int i = 0; i < B_CH; ++i) *(u32x4*)(smem + boff[i]) = rb[i];
        __syncthreads();
        for (int kt = 0; kt < nk; ++kt) {
            const char* cur = smem + (kt & 1) * STAGE; char* nxt = smem + ((kt + 1) & 1) * STAGE;
            if (kt + 1 < nk) {
#pragma unroll
                for (int i = 0; i < A_CH; ++i) ra[i] = *(const u32x4*)(ap[i] + (kt + 1) * 64);
#pragma unroll
                for (int i = 0; i < B_CH; ++i) rb[i] = *(const u32x4*)(bp[i] + (kt + 1) * 64);
            }
#pragma unroll
            for (int kk = 0; kk < 2; ++kk) {
                bf16x8 af[MT], bfr[NT];
#pragma unroll
                for (int m = 0; m < MT; ++m) af[m] = *(const bf16x8*)(cur + (wr * MT * 16 + m * 16 + fr) * ROWB + kk * 64 + fq * 16);
#pragma unroll
                for (int n = 0; n < NT; ++n) bfr[n] = *(const bf16x8*)(cur + A_BYTES + (wc * NT * 16 + n * 16 + fr) * ROWB + kk * 64 + fq * 16);
#pragma unroll
                for (int m = 0; m < MT; ++m)
#pragma unroll
                    for (int n = 0; n < NT; ++n) acc[m][n] = __builtin_amdgcn_mfma_f32_16x16x32_bf16(bfr[n], af[m], acc[m][n], 0, 0, 0);
            }
            if (kt + 1 < nk) {
#pragma unroll
                for (int i = 0; i < A_CH; ++i) *(u32x4*)(nxt + aoff[i]) = ra[i];
#pragma unroll
                for (int i = 0; i < B_CH; ++i) *(u32x4*)(nxt + boff[i]) = rb[i];
            }
            __syncthreads();
        }
    }
};
typedef GC<4, 2, 4, 4> GBig;
typedef GC<2, 4, 4, 2> GSq;

#define ZERO_ACC(acc, MT, NT) _Pragma("unroll") for (int _m = 0; _m < MT; ++_m) _Pragma("unroll") for (int _n = 0; _n < NT; ++_n) acc[_m][_n] = (f32x4){0.f, 0.f, 0.f, 0.f}

__device__ void ph_g1(const P& p, int l, char* smem) {
    const int tid = TID(), lane = tid & 63, wid = tid >> 6, wr = wid / 2, wc = wid % 2, fr = lane & 15, fq = lane >> 4;
    const bf16_t* hx = wsp<const bf16_t>(p, OFF_HX);
    const bf16_t* bt = wsp<const bf16_t>(p, OFF_BTIN1) + (size_t)l * NP1 * D;
    bf16_t* proj = wsp<bf16_t>(p, OFF_BIG);
    constexpr int NPN = NP1 / 128;
    for (int u = BID(); u < (R / 256) * NPN; u += gridDim.x) {
        const int pm = u / NPN, pn = u % NPN;
        f32x4 acc[4][4]; ZERO_ACC(acc, 4, 4);
        GBig::run(smem, [&](int i) { return hx + (size_t)(pm * 256 + i) * D; }, [&](int i) { return bt + (size_t)(pn * 128 + i) * D; }, D, acc);
#pragma unroll
        for (int m = 0; m < 4; ++m) {
            const int row = pm * 256 + wr * 64 + m * 16 + fr;
#pragma unroll
            for (int n = 0; n < 4; ++n) {
                const int col = pn * 128 + wc * 64 + n * 16 + fq * 4;
                u32x2 w; w[0] = pack2(acc[m][n][0], acc[m][n][1]); w[1] = pack2(acc[m][n][2], acc[m][n][3]);
                *(u32x2*)(proj + (size_t)row * NP1 + col) = w;
            }
        }
    }
}

__device__ void ph_attn_prep(const P& p, int l) {
    const int tid = TID(), lane = tid & 63, wid = tid >> 6;
    const bf16_t* proj = wsp<const bf16_t>(p, OFF_BIG);
    bf16_t* Qa = wsp<bf16_t>(p, OFF_QA); bf16_t* Ka = wsp<bf16_t>(p, OFF_KA);
    const int j = lane & 7, d0 = j * 4;
    const float* gq = p.in[23] + l * 32; const float* gk = p.in[24] + l * 32;
    for (int r = BID() * 8 + wid; r < R; r += gridDim.x * 8) {
        const int bl = r / TT, pp = r % TT; const bool lat = pp >= LC; const int t = pp - LC;
        const int h = lane >> 4;
        float cs[4], sn[4];
        if (lat) {
            const float pos = (float)((j < 4) ? (t >> 6) : (t & 63));
#pragma unroll
            for (int c = 0; c < 4; ++c) { const int i = (j & 1) * 4 + c; const float fq_ = exp2f(-(float)i * (13.287712379549449f / 8.0f)); sincosf(pos * fq_, &sn[c], &cs[c]); }
        }
#pragma unroll
        for (int which = 0; which < 2; ++which) {
            const u32x2 raw = *(const u32x2*)(proj + (size_t)r * NP1 + (which ? C_DK : C_DQ) + lane * 4);
            float v[4] = {bf2f((bf16_t)(raw[0] & 0xffff)), bf2f((bf16_t)(raw[0] >> 16)), bf2f((bf16_t)(raw[1] & 0xffff)), bf2f((bf16_t)(raw[1] >> 16))};
            float ss = v[0] * v[0] + v[1] * v[1] + v[2] * v[2] + v[3] * v[3];
            ss += __shfl_xor(ss, 1); ss += __shfl_xor(ss, 2); ss += __shfl_xor(ss, 4);
            const float rs = rsqrtf(ss * (1.0f / 32.0f) + 1e-6f);
            const float* g = which ? gk : gq;
#pragma unroll
            for (int c = 0; c < 4; ++c) v[c] = v[c] * rs * g[d0 + c];
            if (lat) {
#pragma unroll
                for (int c = 0; c < 4; ++c) {
                    const float o = __shfl_xor(v[c], 2);
                    v[c] = (j & 2) ? (o * sn[c] + v[c] * cs[c]) : (v[c] * cs[c] - o * sn[c]);
                }
            }
            if (!which) {
#pragma unroll
                for (int c = 0; c < 4; ++c) v[c] *= 0.17677669529663687f * 1.4426950408889634f;
            }
            u32x2 w; w[0] = pack2(v[0], v[1]); w[1] = pack2(v[2], v[3]);
            *(u32x2*)((which ? Ka : Qa) + (((size_t)bl * 4 + h) * TT + pp) * 64 + (lane & 15) * 4) = w;
        }
    }
}

__device__ void ph_v_prep(const P& p, char* smem) {
    bf16_t* tile = (bf16_t*)smem;
    const int tid = TID();
    const bf16_t* proj = wsp<const bf16_t>(p, OFF_BIG);
    bf16_t* Vt = wsp<bf16_t>(p, OFF_VA);
    constexpr int NTT = TT / 64;
    for (int u = BID(); u < BG * NTT * 4; u += gridDim.x) {
        const int h = u & 3, tt = (u >> 2) % NTT, bl = u / (4 * NTT);
        __syncthreads();
        {
            const int tok = tid >> 3, c8 = (tid & 7) * 8;
            *(u32x4*)(tile + tok * 72 + c8) = *(const u32x4*)(proj + (size_t)(bl * TT + tt * 64 + tok) * NP1 + C_DV + h * 64 + c8);
        }
        __syncthreads();
        const int dv = tid >> 3, t8 = (tid & 7) * 8;
        u32x4 w;
#pragma unroll
        for (int j = 0; j < 4; ++j) w[j] = (unsigned)tile[(t8 + 2 * j) * 72 + dv] | ((unsigned)tile[(t8 + 2 * j + 1) * 72 + dv] << 16);
        *(u32x4*)(Vt + (((size_t)bl * 4 + h) * 64 + dv) * TT + tt * 64 + t8) = w;
    }
}

__device__ void ph_hy_prep(const P& p, int l, char* smem) {
    float* tile = (float*)smem;
    const int tid = TID();
    const bf16_t* proj = wsp<const bf16_t>(p, OFF_BIG);
    float* hyT = wsp<float>(p, OFF_HYT);
    const float* cw = p.in[12] + (size_t)l * 3 * 768;
    constexpr int NTT = TT / 64;
    for (int u = BID(); u < BG * NTT * 12; u += gridDim.x) {
        const int ct = u % 12, tt = (u / 12) % NTT, bl = u / (12 * NTT);
        const int p0 = tt * 64; const bool lat = p0 >= LC; const int seg0 = lat ? LC : 0, segL = lat ? LQ : LC;
        __syncthreads();
        for (int i = tid; i < 66 * 16; i += NTHR) {
            const int rr = i >> 4, c4 = (i & 15) * 4; const int pp = p0 - 1 + rr;
            float v[4] = {0.f, 0.f, 0.f, 0.f};
            if (pp >= seg0 && pp < seg0 + segL) {
                const u32x2 raw = *(const u32x2*)(proj + (size_t)(bl * TT + pp) * NP1 + C_HY + ct * 64 + c4);
                v[0] = bf2f((bf16_t)(raw[0] & 0xffff)); v[1] = bf2f((bf16_t)(raw[0] >> 16)); v[2] = bf2f((bf16_t)(raw[1] & 0xffff)); v[3] = bf2f((bf16_t)(raw[1] >> 16));
            }
            tile[rr * 65 + c4] = v[0]; tile[rr * 65 + c4 + 1] = v[1]; tile[rr * 65 + c4 + 2] = v[2]; tile[rr * 65 + c4 + 3] = v[3];
        }
        __syncthreads();
        const int ch = tid >> 3, t8 = (tid & 7) * 8, cg = ct * 64 + ch;
        const float w0 = cw[cg], w1 = cw[768 + cg], w2 = cw[1536 + cg];
        float o[8];
#pragma unroll
        for (int q = 0; q < 8; ++q) { const int rr = t8 + q + 1; o[q] = tile[(rr - 1) * 65 + ch] * w0 + tile[rr * 65 + ch] * w1 + tile[(rr + 1) * 65 + ch] * w2; }
        float* dst = lat ? hyT + ((size_t)bl * 768 + cg) * LQ + (p0 - LC) + t8 : hyT + (size_t)BG * 768 * LQ + ((size_t)bl * 768 + cg) * LC + p0 + t8;
        *(f32x4*)dst = (f32x4){o[0], o[1], o[2], o[3]}; *(f32x4*)(dst + 4) = (f32x4){o[4], o[5], o[6], o[7]};
    }
}

template <int DK>
__device__ void recur_unit(const P& p, int l, int bl, int h, int br, int dir, char* smem) {
    constexpr int DPL = DK / 8;
    float* qS = (float*)smem;
    float* kS = qS + 64 * DK;
    float* gS = kS + 64 * DK;
    float* vS = gS + 64 * DK;
    float* oS = vS + 64 * 64;
    const int tid = TID(), lane = tid & 63, wid = tid >> 6;
    const bf16_t* proj = wsp<const bf16_t>(p, OFF_BIG);
    float* obuf = wsp<float>(p, OFF_OBUF) + ((size_t)dir * 2 + br) * R * 256;
    const int e = wid * 8 + (lane & 7), d0 = (lane >> 3) * DPL;
    float S[DPL];
#pragma unroll
    for (int j = 0; j < DPL; ++j) S[j] = 0.f;
    const float* wa2 = p.in[9] + ((size_t)l * 2 + dir) * 16 * 128; const float* ba = p.in[10] + ((size_t)l * 2 + dir) * 128;
    const float* hl = p.in[21];
    for (int ch = 0; ch < TT / 64; ++ch) {
        __syncthreads();
        for (int i = tid; i < 64 * DK; i += NTHR) {
            const int tk = i / DK, d = i % DK, n = ch * 64 + tk;
            const int pp = dir == 0 ? n : (n < LC ? LC - 1 - n : LC + (LQ - 1 - (n - LC)));
            const bf16_t* row = proj + (size_t)(bl * TT + pp) * NP1;
            float q, k, g;
            if (br == 0) {
                q = bf2f(row[C_GQ + h * 32 + d]) * 0.17677669529663687f; k = bf2f(row[C_GK + h * 32 + d]);
                float z = ba[h * 32 + d];
#pragma unroll
                for (int rr = 0; rr < 16; ++rr) z += bf2f(row[(dir ? C_GAB : C_GAF) + rr]) * wa2[rr * 128 + h * 32 + d];
                const float ls = fminf(z, 0.f) - log1pf(__expf(-fabsf(z)));
                g = __expf(ls * (1.0f / 16.0f));
            } else {
                q = siluf_(bf2f(row[C_HQ + h * 64 + d]));
                const float z = bf2f(row[(dir ? C_HFB : C_HFF) + h * 64 + d]);
                float lb = 0.f;
                if (l == 1) { const float a0 = hl[(0 * 2 + dir) * 256 + h * 64 + d], a1 = hl[(1 * 2 + dir) * 256 + h * 64 + d]; lb = 1.0f / (1.0f + __expf(a0 - a1)); }
                g = fmaxf(lb + (1.0f - lb) * sigmoidf_(z), 1e-20f);
                k = (1.0f - lb) * sigmoidf_(-z);
            }
            qS[i] = q; kS[i] = k; gS[i] = g;
        }
        for (int i = tid; i < 64 * 64; i += NTHR) {
            const int tk = i >> 6, ee = i & 63, n = ch * 64 + tk;
            const int pp = dir == 0 ? n : (n < LC ? LC - 1 - n : LC + (LQ - 1 - (n - LC)));
            vS[i] = bf2f(proj[(size_t)(bl * TT + pp) * NP1 + (br == 0 ? C_GV : C_HI) + h * 64 + ee]);
        }
        __syncthreads();
        for (int tk = 0; tk < 64; ++tk) {
            const float v = vS[tk * 64 + e]; float o = 0.f;
#pragma unroll
            for (int j = 0; j < DPL; ++j) {
                S[j] = gS[tk * DK + d0 + j] * S[j] + kS[tk * DK + d0 + j] * v;
                o += S[j] * qS[tk * DK + d0 + j];
            }
            o += __shfl_xor(o, 8); o += __shfl_xor(o, 16); o += __shfl_xor(o, 32);
            if ((lane >> 3) == 0) oS[tk * 64 + e] = o;
        }
        __syncthreads();
        {
            const int tk = tid >> 3, e8 = (tid & 7) * 8, n = ch * 64 + tk;
            const int pp = dir == 0 ? n : (n < LC ? LC - 1 - n : LC + (LQ - 1 - (n - LC)));
            float* dst = obuf + (size_t)(bl * TT + pp) * 256 + h * 64 + e8;
            *(f32x4*)dst = *(const f32x4*)(oS + tk * 64 + e8); *(f32x4*)(dst + 4) = *(const f32x4*)(oS + tk * 64 + e8 + 4);
        }
    }
}

template <int L>
__device__ void hyena_unit(const P& p, int l, int bl, int c, char* smem) {
    constexpr int W = L == LQ ? 0 : 1, NU = L / 64;
    float* upad = (float*)smem;
    float* hS = upad + 2 * L;
    const int tid = TID();
    const float* hyT = wsp<const float>(p, OFF_HYT) + (W ? (size_t)BG * 768 * LQ : 0) + (size_t)bl * 768 * L;
    const float* hraw = wsp<const float>(p, OFF_HRAW) + (size_t)l * HRAW_L + (W ? (size_t)512 * LQ : 0);
    const float* psum = wsp<const float>(p, OFF_PSUM) + (size_t)l * 68 * 512 + (W ? 64 * 512 : 0);
    bf16_t* outs = wsp<bf16_t>(p, OFF_OUTS);
    const bool act = tid * 8 < L; const int t0 = tid * 8;
    float z[8];
    __syncthreads();
    for (int i = tid; i < 2 * L; i += NTHR) { const int s = i - L / 2; upad[i] = (s >= 0 && s < L) ? hyT[(size_t)c * L + s] : 0.f; }
    if (act) {
#pragma unroll
        for (int i = 0; i < 8; ++i) z[i] = hyT[(size_t)c * L + t0 + i];
    }
    for (int o = 0; o < 2; ++o) {
        const int n = o * 256 + c;
        float sc = 0.f;
        for (int q = 0; q < NU; ++q) sc += psum[q * 512 + n];
        const float inv = 1.0f / sc;
        for (int i = tid; i < L; i += NTHR) hS[i] = hraw[(size_t)n * L + i];
        __syncthreads();
        float acc[8];
#pragma unroll
        for (int i = 0; i < 8; ++i) acc[i] = 0.f;
        if (act) {
            float hi[8], lo[8];
            const float* wp = upad + t0 + L - 8;
#pragma unroll
            for (int m = 0; m < 8; ++m) hi[m] = wp[8 + m];
            for (int J = 0; J < L / 8; ++J) {
                const f32x4 l0 = *(const f32x4*)(wp - 8 * J), l1 = *(const f32x4*)(wp - 8 * J + 4);
                lo[0] = l0[0]; lo[1] = l0[1]; lo[2] = l0[2]; lo[3] = l0[3]; lo[4] = l1[0]; lo[5] = l1[1]; lo[6] = l1[2]; lo[7] = l1[3];
                const f32x4 h0 = *(const f32x4*)(hS + 8 * J), h1 = *(const f32x4*)(hS + 8 * J + 4);
                const float hv[8] = {h0[0], h0[1], h0[2], h0[3], h1[0], h1[1], h1[2], h1[3]};
#pragma unroll
                for (int jj = 0; jj < 8; ++jj)
#pragma unroll
                    for (int i = 0; i < 8; ++i) { const int m = i - jj + 8; acc[i] += hv[jj] * (m >= 8 ? hi[m - 8] : lo[m]); }
#pragma unroll
                for (int m = 0; m < 8; ++m) hi[m] = lo[m];
            }
        }
        const float bias = p.in[20][((size_t)l * 2 + o) * 256 + c];
        if (act) {
#pragma unroll
            for (int i = 0; i < 8; ++i) { const float gate = hyT[(size_t)((o + 1) * 256 + c) * L + t0 + i]; z[i] = gate * (acc[i] * inv + bias * z[i]); }
        }
        __syncthreads();
        if (o == 0) {
            if (act) {
#pragma unroll
                for (int i = 0; i < 8; ++i) upad[L / 2 + t0 + i] = z[i];
            }
        } else if (act) {
#pragma unroll
            for (int i = 0; i < 8; ++i) outs[(size_t)(bl * TT + (W ? 0 : LC) + t0 + i) * D + 256 + c] = f2bf(z[i]);
        }
        __syncthreads();
    }
}

__device__ void attn_unit(const P& p, int l, int bl, int h, int q0, int nkeys, char* smem) {
    constexpr int KROW = 160, VROW = 144, KT_BYTES = 64 * KROW, STG = KT_BYTES + 64 * VROW;
    const int tid = TID(), lane = tid & 63, wid = tid >> 6, fr = lane & 15, fq = lane >> 4;
    const bf16_t* Qa = wsp<const bf16_t>(p, OFF_QA) + ((size_t)bl * 4 + h) * TT * 64;
    const bf16_t* Ka = wsp<const bf16_t>(p, OFF_KA) + ((size_t)bl * 4 + h) * TT * 64;
    const bf16_t* Vt = wsp<const bf16_t>(p, OFF_VA) + ((size_t)bl * 4 + h) * 64 * TT;
    const int ln32 = tid & 31;
    float gqm = fabsf(p.in[23][l * 32 + ln32]), gkm = fabsf(p.in[24][l * 32 + ln32]);
#pragma unroll
    for (int o = 16; o > 0; o >>= 1) { gqm = fmaxf(gqm, __shfl_xor(gqm, o)); gkm = fmaxf(gkm, __shfl_xor(gkm, o)); }
    const float Mx2 = 32.0f * 0.17677669529663687f * 1.4426950408889634f * gqm * gkm;
    const float* lp = p.in[25] + (size_t)l * 128;
    float s01 = lp[ln32] * lp[32 + ln32], s23 = lp[64 + ln32] * lp[96 + ln32];
#pragma unroll
    for (int o = 16; o > 0; o >>= 1) { s01 += __shfl_xor(s01, o); s23 += __shfl_xor(s23, o); }
    const float lam_init = 0.8f - 0.6f * expf(-0.3f * (float)l);
    const float lam = expf(s01) - expf(s23) + lam_init;
    const f32x4 cinit = {-Mx2, -Mx2, -Mx2, -Mx2};
    const int qw = q0 + wid * 32;
    bf16x8 qf[2][2];
#pragma unroll
    for (int br = 0; br < 2; ++br)
#pragma unroll
        for (int qt = 0; qt < 2; ++qt) qf[br][qt] = *(const bf16x8*)(Qa + (size_t)(qw + qt * 16 + fr) * 64 + br * 32 + fq * 8);
    f32x4 O[2][2][4], Ls[2][2];
#pragma unroll
    for (int br = 0; br < 2; ++br)
#pragma unroll
        for (int qt = 0; qt < 2; ++qt) { Ls[br][qt] = (f32x4){0.f, 0.f, 0.f, 0.f};
#pragma unroll
            for (int dt = 0; dt < 4; ++dt) O[br][qt][dt] = (f32x4){0.f, 0.f, 0.f, 0.f}; }
    bf16x8 ones;
#pragma unroll
    for (int j = 0; j < 8; ++j) ones[j] = (short)0x3F80;
    const int srow = tid >> 3, sc = tid & 7;
    const bf16_t* kg = Ka + (size_t)srow * 64 + sc * 8;
    const bf16_t* vg = Vt + (size_t)srow * TT + sc * 8;
    const int kso = srow * KROW + sc * 16, vso = KT_BYTES + srow * VROW + sc * 16;
    u32x4 rk = *(const u32x4*)kg, rv = *(const u32x4*)vg;
    __syncthreads();
    *(u32x4*)(smem + kso) = rk; *(u32x4*)(smem + vso) = rv;
    __syncthreads();
    const int nt = nkeys / 64;
    for (int kt = 0; kt < nt; ++kt) {
        const char* cur = smem + (kt & 1) * STG; char* nxt = smem + ((kt + 1) & 1) * STG;
        if (kt + 1 < nt) { rk = *(const u32x4*)(kg + (size_t)(kt + 1) * 64 * 64); rv = *(const u32x4*)(vg + (kt + 1) * 64); }
#pragma unroll
        for (int kp = 0; kp < 2; ++kp) {
            bf16x8 kf[2][2], vf[4];
#pragma unroll
            for (int br = 0; br < 2; ++br)
#pragma unroll
                for (int t = 0; t < 2; ++t) kf[br][t] = *(const bf16x8*)(cur + (kp * 32 + t * 16 + fr) * KROW + br * 64 + fq * 16);
#pragma unroll
            for (int dt = 0; dt < 4; ++dt) {
                const u32x2 a = *(const u32x2*)(cur + KT_BYTES + (dt * 16 + fr) * VROW + kp * 64 + fq * 8);
                const u32x2 b = *(const u32x2*)(cur + KT_BYTES + (dt * 16 + fr) * VROW + kp * 64 + 32 + fq * 8);
                u32x4 c; c[0] = a[0]; c[1] = a[1]; c[2] = b[0]; c[3] = b[1];
                vf[dt] = __builtin_bit_cast(bf16x8, c);
            }
#pragma unroll
            for (int qt = 0; qt < 2; ++qt)
#pragma unroll
                for (int br = 0; br < 2; ++br) {
                    const f32x4 s0 = __builtin_amdgcn_mfma_f32_16x16x32_bf16(kf[br][0], qf[br][qt], cinit, 0, 0, 0);
                    const f32x4 s1 = __builtin_amdgcn_mfma_f32_16x16x32_bf16(kf[br][1], qf[br][qt], cinit, 0, 0, 0);
                    u32x4 pk;
                    pk[0] = cvt_pk_bf16(__builtin_amdgcn_exp2f(s0[0]), __builtin_amdgcn_exp2f(s0[1]));
                    pk[1] = cvt_pk_bf16(__builtin_amdgcn_exp2f(s0[2]), __builtin_amdgcn_exp2f(s0[3]));
                    pk[2] = cvt_pk_bf16(__builtin_amdgcn_exp2f(s1[0]), __builtin_amdgcn_exp2f(s1[1]));
                    pk[3] = cvt_pk_bf16(__builtin_amdgcn_exp2f(s1[2]), __builtin_amdgcn_exp2f(s1[3]));
                    const bf16x8 pb = __builtin_bit_cast(bf16x8, pk);
#pragma unroll
                    for (int dt = 0; dt < 4; ++dt) O[br][qt][dt] = __builtin_amdgcn_mfma_f32_16x16x32_bf16(vf[dt], pb, O[br][qt][dt], 0, 0, 0);
                    Ls[br][qt] = __builtin_amdgcn_mfma_f32_16x16x32_bf16(ones, pb, Ls[br][qt], 0, 0, 0);
                }
        }
        if (kt + 1 < nt) { *(u32x4*)(nxt + kso) = rk; *(u32x4*)(nxt + vso) = rv; }
        __syncthreads();
    }
    asm volatile("" ::: "memory");
    const float* gn = p.in[26] + l * 64;
#pragma unroll
    for (int qt = 0; qt < 2; ++qt) {
        const float i1 = 1.0f / Ls[0][qt][0], i2 = lam / Ls[1][qt][0];
        float o[4][4], ss = 0.f;
#pragma unroll
        for (int dt = 0; dt < 4; ++dt)
#pragma unroll
            for (int j = 0; j < 4; ++j) { o[dt][j] = O[0][qt][dt][j] * i1 - O[1][qt][dt][j] * i2; ss += o[dt][j] * o[dt][j]; }
        ss += __shfl_xor(ss, 16); ss += __shfl_xor(ss, 32);
        const float rs = rsqrtf(ss * (1.0f / 64.0f) + 1e-6f) * (1.0f - lam_init);
        bf16_t* dst = wsp<bf16_t>(p, OFF_OUTS) + (size_t)(bl * TT + qw + qt * 16 + fr) * D + 768 + h * 64;
#pragma unroll
        for (int dt = 0; dt < 4; ++dt) {
            const f32x4 g = *(const f32x4*)(gn + dt * 16 + fq * 4);
            u32x2 w; w[0] = pack2(o[dt][0] * rs * g[0], o[dt][1] * rs * g[1]); w[1] = pack2(o[dt][2] * rs * g[2], o[dt][3] * rs * g[3]);
            *(u32x2*)(dst + dt * 16 + fq * 4) = w;
        }
    }
}

__device__ void ph_recur(const P& p, int l, char* smem) {
    const int NR = BG * 4 * 2 * 2;
    for (int u = BID(); u < NR; u += gridDim.x) {
        const int dir = u & 1, br = (u >> 1) & 1, h = (u >> 2) & 3, bl = u >> 4;
        if (br == 0) recur_unit<32>(p, l, bl, h, 0, dir, smem); else recur_unit<64>(p, l, bl, h, 1, dir, smem);
    }
}
__device__ void ph_attn(const P& p, int l, char* smem) {
    const bool last = l == NLAYER - 1;
    const int per = 16 + (last ? 0 : 1), NA = BG * 4 * per;
    for (int u = BID(); u < NA; u += gridDim.x) {
        const int qb = u % per, h = (u / per) & 3, bl = u / (per * 4);
        if (qb < 16) attn_unit(p, l, bl, h, LC + qb * 256, TT, smem);
        else attn_unit(p, l, bl, h, 0, LC, smem);
    }
}
__device__ void ph_hyena(const P& p, int l, char* smem) {
    const bool last = l == NLAYER - 1;
    const int NHL = BG * 256, NHC = last ? 0 : BG * 256;
    for (int u = BID(); u < NHL + NHC; u += gridDim.x) {
        if (u < NHL) hyena_unit<LQ>(p, l, u / 256, u % 256, smem);
        else { const int v = u - NHL; hyena_unit<LC>(p, l, v / 256, v % 256, smem); }
    }
}

__device__ void ph_gated(const P& p, int l) {
    const int tid = TID(), lane = tid & 63, wid = tid >> 6;
    const bf16_t* proj = wsp<const bf16_t>(p, OFF_BIG);
    const float* obuf = wsp<const float>(p, OFF_OBUF);
    bf16_t* outs = wsp<bf16_t>(p, OFF_OUTS);
    for (int r = BID() * 8 + wid; r < R; r += gridDim.x * 8) {
#pragma unroll
        for (int br = 0; br < 2; ++br) {
            const f32x4 a = *(const f32x4*)(obuf + ((size_t)(0 * 2 + br) * R + r) * 256 + lane * 4);
            const f32x4 b = *(const f32x4*)(obuf + ((size_t)(1 * 2 + br) * R + r) * 256 + lane * 4);
            float o[4] = {a[0] + b[0], a[1] + b[1], a[2] + b[2], a[3] + b[3]};
            float ss = o[0] * o[0] + o[1] * o[1] + o[2] * o[2] + o[3] * o[3];
            ss += __shfl_xor(ss, 1); ss += __shfl_xor(ss, 2); ss += __shfl_xor(ss, 4); ss += __shfl_xor(ss, 8);
            const float rs = rsqrtf(ss * (1.0f / 64.0f) + 1e-6f);
            const float* gn = p.in[br ? 22 : 11] + l * 64 + (lane & 15) * 4;
            const u32x2 graw = *(const u32x2*)(proj + (size_t)r * NP1 + (br ? C_HGG : C_GG) + lane * 4);
            const float gt[4] = {bf2f((bf16_t)(graw[0] & 0xffff)), bf2f((bf16_t)(graw[0] >> 16)), bf2f((bf16_t)(graw[1] & 0xffff)), bf2f((bf16_t)(graw[1] >> 16))};
#pragma unroll
            for (int c = 0; c < 4; ++c) o[c] = o[c] * rs * gn[c] * siluf_(gt[c]);
            u32x2 w; w[0] = pack2(o[0], o[1]); w[1] = pack2(o[2], o[3]);
            *(u32x2*)(outs + (size_t)r * D + (br ? 512 : 0) + lane * 4) = w;
        }
    }
}

__device__ void ph_merge(const P& p, int l, char* smem) {
    const int tid = TID(), lane = tid & 63, wid = tid >> 6, wr = wid / 4, wc = wid % 4, fr = lane & 15, fq = lane >> 4;
    const bool last = l == NLAYER - 1;
    const bf16_t* hx = wsp<const bf16_t>(p, OFF_HX); const bf16_t* outs = wsp<const bf16_t>(p, OFF_OUTS);
    const bf16_t* btg = wsp<const bf16_t>(p, OFF_BTGATE) + (size_t)l * 4096 * D;
    const bf16_t* btb = wsp<const bf16_t>(p, OFF_BTBR) + (size_t)l * 4 * 1024 * 256;
    bf16_t* merged = wsp<bf16_t>(p, OFF_BIG);
    for (int u = BID(); u < (R / 128) * 8; u += gridDim.x) {
        const int pm = u / 8, pn = u % 8;
        if (last && (pm % 34) < 2) continue;
        f32x4 mg[4][2]; ZERO_ACC(mg, 4, 2);
#pragma unroll 1
        for (int i = 0; i < 4; ++i) {
            f32x4 ag[4][2]; ZERO_ACC(ag, 4, 2);
            GSq::run(smem, [&](int r) { return hx + (size_t)(pm * 128 + r) * D; }, [&](int r) { return btg + (size_t)(i * 1024 + pn * 128 + r) * D; }, D, ag);
#pragma unroll
            for (int m = 0; m < 4; ++m)
#pragma unroll
                for (int n = 0; n < 2; ++n)
#pragma unroll
                    for (int j = 0; j < 4; ++j) ag[m][n][j] = sigmoidf_(ag[m][n][j]);
            f32x4 ab[4][2]; ZERO_ACC(ab, 4, 2);
            GSq::run(smem, [&](int r) { return outs + (size_t)(pm * 128 + r) * D + i * 256; }, [&](int r) { return btb + ((size_t)i * 1024 + pn * 128 + r) * 256; }, 256, ab);
#pragma unroll
            for (int m = 0; m < 4; ++m)
#pragma unroll
                for (int n = 0; n < 2; ++n) mg[m][n] += ag[m][n] * ab[m][n];
        }
#pragma unroll
        for (int m = 0; m < 4; ++m) {
            const int row = pm * 128 + wr * 64 + m * 16 + fr;
#pragma unroll
            for (int n = 0; n < 2; ++n) {
                const int col = pn * 128 + wc * 32 + n * 16 + fq * 4;
                u32x2 w; w[0] = pack2(mg[m][n][0], mg[m][n][1]); w[1] = pack2(mg[m][n][2], mg[m][n][3]);
                *(u32x2*)(merged + (size_t)row * D + col) = w;
            }
        }
    }
}

__device__ void ph_wout(const P& p, int l, int grp, char* smem) {
    const int tid = TID(), lane = tid & 63, wid = tid >> 6, wr = wid / 2, wc = wid % 2, fr = lane & 15, fq = lane >> 4;
    const bool last = l == NLAYER - 1;
    const bf16_t* merged = wsp<const bf16_t>(p, OFF_BIG);
    const bf16_t* bt = wsp<const bf16_t>(p, OFF_BTOUT) + (size_t)l * D * D;
    for (int u = BID(); u < (R / 256) * 8; u += gridDim.x) {
        const int pm = u / 8, pn = u % 8;
        if (last && (pm % 17) == 0) continue;
        f32x4 acc[4][4]; ZERO_ACC(acc, 4, 4);
        GBig::run(smem, [&](int i) { return merged + (size_t)(pm * 256 + i) * D; }, [&](int i) { return bt + (size_t)(pn * 128 + i) * D; }, D, acc);
#pragma unroll
        for (int m = 0; m < 4; ++m) {
            const int r = pm * 256 + wr * 64 + m * 16 + fr, bl = r / TT, pp = r % TT, b = grp * BG + bl;
            const float* src = stream_src(p, l, b, pp); float* dst = stream_dst(p, b, pp);
            const float* mod = (pp < LC ? wsp<const float>(p, OFF_MODC) + (size_t)l * 6144 : wsp<const float>(p, OFF_MODX) + ((size_t)l * NB + b) * 6144) + 2 * D;
#pragma unroll
            for (int n = 0; n < 4; ++n) {
                const int col = pn * 128 + wc * 64 + n * 16 + fq * 4;
                const f32x4 s = *(const f32x4*)(src + col), md = *(const f32x4*)(mod + col);
                *(f32x4*)(dst + col) = s + md * acc[m][n];
            }
        }
    }
}

__device__ void ph_topk(const P& p, int l, char* smem) {
    unsigned* keys = (unsigned*)smem;
    unsigned* red = keys + 4096;
    const int tid = TID(), lane = tid & 63, wid = tid >> 6;
    const bool last = l == NLAYER - 1;
    const int NU = BG * NEXP * (last ? 1 : 2);
    for (int u = BID(); u < NU; u += gridDim.x) {
        const int isctx = u >= BG * NEXP, v = isctx ? u - BG * NEXP : u, bl = v / NEXP, e = v % NEXP;
        const int L = isctx ? LC : LQ, cap = isctx ? CAPC : CAPL;
        const float* aff = wsp<const float>(p, OFF_AFF) + (isctx ? (size_t)BG * NEXP * LQ + (size_t)v * LC : (size_t)v * LQ);
        __syncthreads();
        for (int i = tid; i < 4096; i += NTHR) keys[i] = i < L ? __float_as_uint(aff[i]) : 0u;
        __syncthreads();
        unsigned my[8];
#pragma unroll
        for (int i = 0; i < 8; ++i) my[i] = keys[tid * 8 + i];
        unsigned T = 0u;
        for (int bit = 30; bit >= 0; --bit) {
            const unsigned cand = T | (1u << bit);
            int c = 0;
#pragma unroll
            for (int i = 0; i < 8; ++i) c += (my[i] >= cand) ? 1 : 0;
            c = (int)wave_sum((float)c);
            if (lane == 0) red[wid] = (unsigned)c;
            __syncthreads();
            int tot = 0;
#pragma unroll
            for (int w = 0; w < 8; ++w) tot += (int)red[w];
            __syncthreads();
            if (tot >= cap) T = cand;
        }
        int cg = 0, ce = 0;
#pragma unroll
        for (int i = 0; i < 8; ++i) { cg += (my[i] > T) ? 1 : 0; ce += (my[i] == T) ? 1 : 0; }
        unsigned pk = (unsigned)cg | ((unsigned)ce << 16), inc = pk;
#pragma unroll
        for (int o = 1; o < 64; o <<= 1) { const unsigned t = __shfl_up(inc, o); if (lane >= o) inc += t; }
        if (lane == 63) red[8 + wid] = inc;
        __syncthreads();
        unsigned base = 0u, totpk = 0u;
#pragma unroll
        for (int w = 0; w < 8; ++w) { const unsigned t = red[8 + w]; if (w < wid) base += t; totpk += t; }
        const unsigned ex = base + inc - pk;
        int rg = (int)(ex & 0xffffu), re = (int)(ex >> 16); const int G = (int)(totpk & 0xffffu);
        const int sbase = isctx ? LATS + (e * BG + bl) * CAPC : (bl * NEXP + e) * CAPL;
        int* sidx = wsp<int>(p, OFF_SIDX); float* sgv = wsp<float>(p, OFF_SGV); int* inv = wsp<int>(p, OFF_INV);
#pragma unroll
        for (int i = 0; i < 8; ++i) {
            const int tok = tid * 8 + i; int slot = -1;
            if (my[i] > T) slot = rg++;
            else if (my[i] == T) { if (G + re < cap) slot = G + re; re++; }
            if (slot >= 0 && tok < L) {
                const int r = bl * TT + (isctx ? tok : LC + tok);
                sidx[sbase + slot] = r; sgv[sbase + slot] = __uint_as_float(my[i]); inv[(size_t)r * NEXP + e] = sbase + slot;
            }
        }
    }
}

__device__ __forceinline__ int mtile_expert(int mt) { return mt < LATS / 256 ? (mt >> 1) & 15 : mt - LATS / 256; }

__device__ void ph_moe1(const P& p, int l, char* smem) {
    const int tid = TID(), lane = tid & 63, wid = tid >> 6, wr = wid / 2, wc = wid % 2, fr = lane & 15, fq = lane >> 4;
    const bool last = l == NLAYER - 1;
    const bf16_t* hx = wsp<const bf16_t>(p, OFF_HX); const int* sidx = wsp<const int>(p, OFF_SIDX);
    bf16_t* H = wsp<bf16_t>(p, OFF_BIG) + (size_t)NSLOT * D;
    const int nmt = last ? LATS / 256 : NSLOT / 256;
    for (int u = BID(); u < nmt * 16; u += gridDim.x) {
        const int mt = u / 16, pn = u % 16, e = mtile_expert(mt);
        const bf16_t* bt = wsp<const bf16_t>(p, OFF_BTW13) + ((size_t)l * NEXP + e) * 2048 * D;
        f32x4 acc[4][4]; ZERO_ACC(acc, 4, 4);
        GBig::run(smem, [&](int i) { return hx + (size_t)sidx[mt * 256 + i] * D; }, [&](int i) { return bt + (size_t)(pn * 128 + i) * D; }, D, acc);
#pragma unroll
        for (int m = 0; m < 4; ++m) {
            const int slot = mt * 256 + wr * 64 + m * 16 + fr;
#pragma unroll
            for (int n2 = 0; n2 < 2; ++n2) {
                const int col = (pn * 4 + wc * 2 + n2) * 16 + fq * 4;
                float hv[4];
#pragma unroll
                for (int j = 0; j < 4; ++j) hv[j] = siluf_(acc[m][2 * n2][j]) * acc[m][2 * n2 + 1][j];
                u32x2 w; w[0] = pack2(hv[0], hv[1]); w[1] = pack2(hv[2], hv[3]);
                *(u32x2*)(H + (size_t)slot * D + col) = w;
            }
        }
    }
}

__device__ void ph_moe2(const P& p, int l, char* smem) {
    const int tid = TID(), lane = tid & 63, wid = tid >> 6, wr = wid / 2, wc = wid % 2, fr = lane & 15, fq = lane >> 4;
    const bool last = l == NLAYER - 1;
    const bf16_t* H = wsp<const bf16_t>(p, OFF_BIG) + (size_t)NSLOT * D;
    bf16_t* Y = wsp<bf16_t>(p, OFF_BIG);
    const float* sgv = wsp<const float>(p, OFF_SGV);
    const int nmt = last ? LATS / 256 : NSLOT / 256;
    for (int u = BID(); u < nmt * 8; u += gridDim.x) {
        const int mt = u / 8, pn = u % 8, e = mtile_expert(mt);
        const bf16_t* bt = wsp<const bf16_t>(p, OFF_BTW2) + ((size_t)l * NEXP + e) * D * D;
        f32x4 acc[4][4]; ZERO_ACC(acc, 4, 4);
        GBig::run(smem, [&](int i) { return H + (size_t)(mt * 256 + i) * D; }, [&](int i) { return bt + (size_t)(pn * 128 + i) * D; }, D, acc);
#pragma unroll
        for (int m = 0; m < 4; ++m) {
            const int slot = mt * 256 + wr * 64 + m * 16 + fr; const float g = sgv[slot];
#pragma unroll
            for (int n = 0; n < 4; ++n) {
                const int col = pn * 128 + wc * 64 + n * 16 + fq * 4;
                u32x2 w; w[0] = pack2(acc[m][n][0] * g, acc[m][n][1] * g); w[1] = pack2(acc[m][n][2] * g, acc[m][n][3] * g);
                *(u32x2*)(Y + (size_t)slot * D + col) = w;
            }
        }
    }
}

__device__ void ph_combine(const P& p, int l, int grp) {
    const int tid = TID(), lane = tid & 63, wid = tid >> 6;
    const bool last = l == NLAYER - 1;
    const bf16_t* Y = wsp<const bf16_t>(p, OFF_BIG); const int* inv = wsp<const int>(p, OFF_INV);
    for (int r = BID() * 8 + wid; r < R; r += gridDim.x * 8) {
        const int bl = r / TT, pp = r % TT, b = grp * BG + bl;
        if (last && pp < LC) continue;
        float* dst = stream_dst(p, b, pp);
        const float* mod = (pp < LC ? wsp<const float>(p, OFF_MODC) + (size_t)l * 6144 : wsp<const float>(p, OFF_MODX) + ((size_t)l * NB + b) * 6144) + 5 * D;
        const int myinv = lane < NEXP ? inv[(size_t)r * NEXP + lane] : -1;
        float acc[16];
#pragma unroll
        for (int i = 0; i < 16; ++i) acc[i] = 0.f;
        for (int e = 0; e < NEXP; ++e) {
            const int s = __shfl(myinv, e);
            if (s >= 0) {
#pragma unroll
                for (int i = 0; i < 2; ++i) {
                    const u32x4 w = *(const u32x4*)(Y + (size_t)s * D + i * 512 + lane * 8);
#pragma unroll
                    for (int j = 0; j < 4; ++j) { acc[i * 8 + 2 * j] += __uint_as_float(w[j] << 16); acc[i * 8 + 2 * j + 1] += __uint_as_float(w[j] & 0xffff0000u); }
                }
            }
        }
#pragma unroll
        for (int i = 0; i < 2; ++i)
#pragma unroll
            for (int j = 0; j < 2; ++j) {
                const int c = i * 512 + lane * 8 + j * 4;
                f32x4 x = *(const f32x4*)(dst + c); const f32x4 md = *(const f32x4*)(mod + c);
#pragma unroll
                for (int q = 0; q < 4; ++q) x[q] += md[q] * acc[i * 8 + j * 4 + q];
                *(f32x4*)(dst + c) = x;
            }
    }
}

#define XB_TMO      128
#define XB_XCNT(j)  (256  + 64 * (j))
#define XB_XSUB(j)  (1280 + 64 * (j))
#define XB_XGEN(j)  (2304 + 64 * (j))
#define XB_TOP      3328
#define XB_TOPGEN   3392
#define XCD_BAR_WORDS 3456
#define XB_SPIN_CAP (1u << 18)
#define LAS __attribute__((address_space(3)))

__device__ __forceinline__ unsigned xb_ld(unsigned* p)              { return __hip_atomic_load(p, __ATOMIC_RELAXED, __HIP_MEMORY_SCOPE_AGENT); }
__device__ __forceinline__ unsigned xb_add(unsigned* p, unsigned v) { return __hip_atomic_fetch_add(p, v, __ATOMIC_RELAXED, __HIP_MEMORY_SCOPE_AGENT); }
__device__ __forceinline__ unsigned xb_xcc_id() { return (unsigned)__builtin_amdgcn_s_getreg((3 << 11) | 20) & 0xFu; }
#define XB_SPIN(cond, bar) do { unsigned _sp = 0; while (cond) { __builtin_amdgcn_s_sleep(1); \
    if ((++_sp & 255u) == 0u) { if (xb_ld(&(bar)[XB_TMO])) break; if (_sp > XB_SPIN_CAP) { atomicAdd(&(bar)[XB_TMO], 1u); break; } } } } while (0)

struct XcdBarrier {
    unsigned* bar; unsigned x;
    volatile LAS unsigned* st;
};

__device__ __forceinline__ XcdBarrier xcd_barrier_post(unsigned* bar, volatile LAS unsigned* st) {
    XcdBarrier b; b.bar = bar; b.x = xb_xcc_id(); b.st = st;
    if (threadIdx.x == 0) (void)xb_add(&bar[XB_XCNT(b.x)], 1u);
    return b;
}
__device__ __forceinline__ void xcd_barrier_complete(unsigned* bar, unsigned x, unsigned& nloc, unsigned& nx) {
    const unsigned G = gridDim.x * gridDim.y * gridDim.z;
    unsigned sum, cnt, mine, sp = 0u;
    for (;;) {
        sum = 0u; cnt = 0u; mine = 0u;
#pragma unroll
        for (unsigned j = 0; j < 16; ++j) { const unsigned c = xb_ld(&bar[XB_XCNT(j)]); sum += c; cnt += (c > 0u) ? 1u : 0u; mine = (j == x) ? c : mine; }
        if (sum == G) break;
        __builtin_amdgcn_s_sleep(1);
        if ((++sp & 255u) == 0u) { if (xb_ld(&bar[XB_TMO])) break; if (sp > XB_SPIN_CAP) { atomicAdd(&bar[XB_TMO], 1u); break; } }
    }
    nloc = mine > 0u ? mine : 1u; nx = cnt > 0u ? cnt : 1u;
}

__device__ __forceinline__ void xcd_barrier(const XcdBarrier& b) {
    asm volatile("s_waitcnt vmcnt(0)" ::: "memory");
    __syncthreads();
    if (threadIdx.x == 0) {
        unsigned* bar = b.bar;
        __builtin_amdgcn_s_waitcnt(0);
        unsigned nloc = b.st[0], nx = b.st[1];
        if (nloc == 0u) { xcd_barrier_complete(bar, b.x, nloc, nx); b.st[0] = nloc; b.st[1] = nx; }
        const unsigned old = xb_add(&bar[XB_XSUB(b.x)], 1u);
        const unsigned gen = old / nloc;
        if (old + 1u == (gen + 1u) * nloc) {
            __builtin_amdgcn_fence(__ATOMIC_RELEASE, "agent");
            asm volatile("s_waitcnt vmcnt(0)" ::: "memory");
            const unsigned og = xb_add(&bar[XB_TOP], 1u);
            const unsigned tg = og / nx;
            if (og + 1u == (tg + 1u) * nx) xb_add(&bar[XB_TOPGEN], 1u);
            else XB_SPIN(xb_ld(&bar[XB_TOPGEN]) == tg, bar);
            __builtin_amdgcn_fence(__ATOMIC_ACQUIRE, "agent");
            xb_add(&bar[XB_XGEN(b.x)], 1u);
            asm volatile("s_waitcnt vmcnt(0)" ::: "memory");
        } else {
            XB_SPIN(xb_ld(&bar[XB_XGEN(b.x)]) == gen, bar);
            __builtin_amdgcn_fence(__ATOMIC_ACQUIRE, "agent");
            asm volatile("s_waitcnt vmcnt(0)" ::: "memory");
        }
    }
    __syncthreads();
}


enum { PH_WEIGHTS, PH_MOD, PH_HFILT, PH_NORM1, PH_G1, PH_PREP, PH_RECUR, PH_ATTN, PH_HYENA, PH_GATED, PH_MERGE, PH_WOUT, PH_NORM2, PH_TOPK, PH_MOE1, PH_MOE2, PH_COMBINE };

template <int PH>
__device__ __forceinline__ void run_phase(const P& p, int l, int grp, char* smem) {
    if (PH == PH_WEIGHTS) ph_weights(p, smem);
    if (PH == PH_MOD) ph_mod(p, smem);
    if (PH == PH_HFILT) ph_hfilt(p, smem);
    if (PH == PH_NORM1) ph_norm<0>(p, l, grp, smem);
    if (PH == PH_G1) ph_g1(p, l, smem);
    if (PH == PH_PREP) { ph_attn_prep(p, l); ph_v_prep(p, smem); ph_hy_prep(p, l, smem); }
    if (PH == PH_RECUR) ph_recur(p, l, smem);
    if (PH == PH_ATTN) ph_attn(p, l, smem);
    if (PH == PH_HYENA) ph_hyena(p, l, smem);
    if (PH == PH_GATED) ph_gated(p, l);
    if (PH == PH_MERGE) ph_merge(p, l, smem);
    if (PH == PH_WOUT) ph_wout(p, l, grp, smem);
    if (PH == PH_NORM2) ph_norm<1>(p, l, grp, smem);
    if (PH == PH_TOPK) ph_topk(p, l, smem);
    if (PH == PH_MOE1) ph_moe1(p, l, smem);
    if (PH == PH_MOE2) ph_moe2(p, l, smem);
    if (PH == PH_COMBINE) ph_combine(p, l, grp);
}

#if !FUSED
template <int PH>
__global__ void __launch_bounds__(NTHR, 2) k_phase(P p, int l, int grp) {
    extern __shared__ __attribute__((aligned(16))) char smem[];
    run_phase<PH>(p, l, grp, smem);
}

template <int PH>
static void launch_phase(const P& p, int l, int grp, int grid, hipStream_t stream) {
    static bool attr = false;
    if (!attr) { (void)hipFuncSetAttribute((const void*)k_phase<PH>, hipFuncAttributeMaxDynamicSharedMemorySize, SMEM_BYTES); attr = true; }
    k_phase<PH><<<grid, NTHR, SMEM_BYTES, stream>>>(p, l, grp);
}
#endif


#define GRID_SYNC() xcd_barrier(bar)
__global__ void __launch_bounds__(NTHR, 2) k_fused(P p) {
    extern __shared__ __attribute__((aligned(16))) char smem[];
    volatile LAS unsigned* xbw = (volatile LAS unsigned*)(smem + SMEM_BYTES);
    if (threadIdx.x == 0) { xbw[0] = 0u; xbw[1] = 0u; xbw[2] = 0u; xbw[3] = 0u; }
    __syncthreads();
    XcdBarrier bar = xcd_barrier_post(wsp<unsigned>(p, OFF_BAR), xbw);
    ph_weights(p, smem);
    ph_mod(p, smem);
    ph_hfilt(p, smem);
    GRID_SYNC();
#pragma unroll 1
    for (int grp = 0; grp < NGRP; ++grp) {
#pragma unroll 1
        for (int l = 0; l < NLAYER; ++l) {
            ph_norm<0>(p, l, grp, smem); GRID_SYNC();
            ph_g1(p, l, smem); GRID_SYNC();
            ph_attn_prep(p, l); ph_v_prep(p, smem); ph_hy_prep(p, l, smem); GRID_SYNC();
            ph_recur(p, l, smem); ph_attn(p, l, smem); ph_hyena(p, l, smem); GRID_SYNC();
            ph_gated(p, l); GRID_SYNC();
            ph_merge(p, l, smem); GRID_SYNC();
            ph_wout(p, l, grp, smem); GRID_SYNC();
            ph_norm<1>(p, l, grp, smem); GRID_SYNC();
            ph_topk(p, l, smem); GRID_SYNC();
            ph_moe1(p, l, smem); GRID_SYNC();
            ph_moe2(p, l, smem); GRID_SYNC();
            ph_combine(p, l, grp); GRID_SYNC();
        }
    }
}

extern "C" void kernel_launch(void* const* d_in, const int* in_sizes, int n_in, void* d_out, int out_size, void* d_ws, size_t ws_size, hipStream_t stream) {
    P p{};
    for (int i = 0; i < 33; ++i) p.in[i] = (const float*)d_in[i];
    p.out = (float*)d_out; p.ws = (char*)d_ws;
#if FUSED
    static int grid = 0;
    if (!grid) {
        int dev = 0, cus = 0, per_cu = 0;
        (void)hipGetDevice(&dev);
        (void)hipDeviceGetAttribute(&cus, hipDeviceAttributeMultiprocessorCount, dev);
        (void)hipFuncSetAttribute((const void*)k_fused, hipFuncAttributeMaxDynamicSharedMemorySize, SMEM_BYTES + 16);
        (void)hipOccupancyMaxActiveBlocksPerMultiprocessor(&per_cu, k_fused, NTHR, SMEM_BYTES + 16);
        grid = cus * (per_cu < 1 ? per_cu : 1);
        if (grid <= 0) grid = 256;
    }
    (void)hipMemsetAsync(d_ws, 0, XCD_BAR_WORDS * sizeof(unsigned), stream);
    k_fused<<<grid, NTHR, SMEM_BYTES + 16, stream>>>(p);
#else
    const int grid = 256;
    launch_phase<PH_WEIGHTS>(p, 0, 0, grid, stream);
    launch_phase<PH_MOD>(p, 0, 0, grid, stream);
    launch_phase<PH_HFILT>(p, 0, 0, grid, stream);
    for (int grp = 0; grp < NGRP; ++grp)
        for (int l = 0; l < NLAYER; ++l) {
            launch_phase<PH_NORM1>(p, l, grp, grid, stream);
            launch_phase<PH_G1>(p, l, grp, grid, stream);
            launch_phase<PH_PREP>(p, l, grp, grid, stream);
            launch_phase<PH_RECUR>(p, l, grp, grid, stream);
            launch_phase<PH_ATTN>(p, l, grp, grid, stream);
            launch_phase<PH_HYENA>(p, l, grp, grid, stream);
            launch_phase<PH_GATED>(p, l, grp, grid, stream);
            launch_phase<PH_MERGE>(p, l, grp, grid, stream);
            launch_phase<PH_WOUT>(p, l, grp, grid, stream);
            launch_phase<PH_NORM2>(p, l, grp, grid, stream);
            launch_phase<PH_TOPK>(p, l, grp, grid, stream);
            launch_phase<PH_MOE1>(p, l, grp, grid, stream);
            launch_phase<PH_MOE2>(p, l, grp, grid, stream);
            launch_phase<PH_COMBINE>(p, l, grp, grid, stream);
        }
#endif
}
```

```cpp
#include <hip/hip_runtime.h>
#include <stdint.h>

#ifndef FUSED
#define FUSED 1
#endif

typedef unsigned short bf16_t;
typedef short bf16x8 __attribute__((ext_vector_type(8)));
typedef float f32x4 __attribute__((ext_vector_type(4)));
typedef unsigned u32x4 __attribute__((ext_vector_type(4)));
typedef unsigned u32x2 __attribute__((ext_vector_type(2)));

#define NTHR 512
constexpr int D = 1024, NB = 16, LQ = 4096, LC = 256, TT = 4352, NLAYER = 2;
constexpr int BG = 8, NGRP = NB / BG, R = BG * TT;
constexpr int NP1 = 3840;
constexpr int C_GQ = 0, C_GK = 128, C_GV = 256, C_GAF = 512, C_GAB = 528, C_GG = 544, C_HY = 800, C_HQ = 1568, C_HFF = 1824, C_HFB = 2080,
              C_HI = 2336, C_HGG = 2592, C_DQ = 2848, C_DK = 3104, C_DV = 3360, C_MG = 3616, N_IN = 7712;
constexpr int NEXP = 16, CAPL = 512, CAPC = 32, LATS = BG * NEXP * CAPL, NSLOT = LATS + BG * NEXP * CAPC;
constexpr int SMEM_BYTES = 132096;
constexpr int HY_UB = 8224, HY_HSTR = 8256, HY_NS = 515, HY_U_BYTES = 8 * HY_UB, HY_Z_OFF = HY_U_BYTES + 8 * HY_HSTR;
static_assert(HY_Z_OFF + 64 <= SMEM_BYTES, "hyena lds");

constexpr size_t al256(size_t x) { return (x + 255) & ~(size_t)255; }
constexpr size_t OFF_BAR = 0;
constexpr size_t OFF_BTIN1 = 65536;
constexpr size_t OFF_BTGATE = OFF_BTIN1 + (size_t)NLAYER * NP1 * D * 2;
constexpr size_t OFF_BTBR = OFF_BTGATE + (size_t)NLAYER * 4096 * D * 2;
constexpr size_t OFF_BTOUT = OFF_BTBR + (size_t)NLAYER * 4 * 1024 * 256 * 2;
constexpr size_t OFF_BTW13 = OFF_BTOUT + (size_t)NLAYER * D * D * 2;
constexpr size_t OFF_BTW2 = OFF_BTW13 + (size_t)NLAYER * NEXP * 2048 * D * 2;
constexpr size_t OFF_MODX = OFF_BTW2 + (size_t)NLAYER * NEXP * D * D * 2;
constexpr size_t OFF_MODC = OFF_MODX + (size_t)NLAYER * NB * 6144 * 4;
constexpr size_t OFF_HRAW = OFF_MODC + (size_t)NLAYER * 6144 * 4;
constexpr size_t HRAW_L = (size_t)512 * (LQ + LC);
constexpr size_t OFF_PSUM = OFF_HRAW + (size_t)NLAYER * HRAW_L * 4;
constexpr size_t OFF_XC = OFF_PSUM + (size_t)NLAYER * 68 * 512 * 4;
constexpr size_t OFF_HX = OFF_XC + (size_t)NB * LC * D * 4;
constexpr size_t OFF_BIG = OFF_HX + (size_t)R * D * 2;
constexpr size_t BIG_BYTES = (size_t)2 * NSLOT * D * 2;
constexpr size_t OFF_OUTS = OFF_BIG + BIG_BYTES;
constexpr size_t OFF_QA = OFF_OUTS + (size_t)R * D * 2;
constexpr size_t OFF_KA = OFF_QA + (size_t)BG * 4 * TT * 64 * 2;
constexpr size_t OFF_VA = OFF_KA + (size_t)BG * 4 * TT * 64 * 2;
constexpr size_t OFF_OBUF = OFF_VA + (size_t)BG * 4 * TT * 64 * 2;
constexpr size_t OFF_HYT = OFF_OBUF + (size_t)4 * R * 256 * 4;
constexpr size_t OFF_AFF = OFF_HYT + (size_t)BG * 768 * TT * 2;
constexpr size_t OFF_INV = OFF_AFF + (size_t)BG * NEXP * TT * 4;
constexpr size_t OFF_SIDX = OFF_INV + (size_t)R * NEXP * 4;
constexpr size_t OFF_SGV = OFF_SIDX + (size_t)NSLOT * 4;
constexpr size_t OFF_HCOP = OFF_SGV + (size_t)NSLOT * 4;
constexpr size_t WS_END = OFF_HCOP + (size_t)NLAYER * 512 * 8 * HY_HSTR;
static_assert(WS_END < (size_t)1020 * 1024 * 1024, "workspace too big");
static_assert(BIG_BYTES >= (size_t)R * NP1 * 2, "big region");

struct P {
    const float* in[33];
    float* out;
    char* ws;
};

__device__ __forceinline__ bf16_t f2bf(float f) { unsigned u = __float_as_uint(f); u += 0x7fffu + ((u >> 16) & 1u); return (bf16_t)(u >> 16); }
__device__ __forceinline__ float bf2f(bf16_t h) { return __uint_as_float((unsigned)h << 16); }
typedef float f32x2 __attribute__((ext_vector_type(2)));
typedef __bf16 bf16x2_t __attribute__((ext_vector_type(2)));
__device__ __forceinline__ unsigned cvt_pk_bf16(float lo, float hi) { const f32x2 v = {lo, hi}; return __builtin_bit_cast(unsigned, __builtin_convertvector(v, bf16x2_t)); }
__device__ __forceinline__ unsigned pack2(float a, float b) { return cvt_pk_bf16(a, b); }
__device__ __forceinline__ float sigmoidf_(float x) { return 1.0f / (1.0f + __expf(-x)); }
__device__ __forceinline__ float siluf_(float x) { return x / (1.0f + __expf(-x)); }
__device__ __forceinline__ float wave_sum(float v) {
#pragma unroll
    for (int o = 32; o > 0; o >>= 1) v += __shfl_xor(v, o);
    return v;
}

template <class T> __device__ __forceinline__ T* wsp(const P& p, size_t off) { return (T*)(p.ws + off); }

__device__ __forceinline__ const float* stream_src(const P& p, int l, int b, int pp) {
    if (pp < LC) return (l == 0 ? p.in[2] : wsp<const float>(p, OFF_XC)) + ((size_t)b * LC + pp) * D;
    return (l == 0 ? p.in[0] : (const float*)p.out) + ((size_t)b * LQ + (pp - LC)) * D;
}
__device__ __forceinline__ float* stream_dst(const P& p, int b, int pp) {
    if (pp < LC) return wsp<float>(p, OFF_XC) + ((size_t)b * LC + pp) * D;
    return p.out + ((size_t)b * LQ + (pp - LC)) * D;
}

__device__ __forceinline__ int TID() { int t = threadIdx.x; asm volatile("" : "+v"(t)); return t; }
__device__ __forceinline__ int BID() { int t = blockIdx.x; asm volatile("" : "+s"(t)); return t; }

__device__ void xpose_job(const float* __restrict__ src, int ldS, int K, int N, bf16_t* __restrict__ dst, int mode, int which, float* tile) {
    const int tid = TID();
    const int tk = K / 64, tn = (N + 63) / 64, nt = tk * tn;
    for (int t = BID(); t < nt; t += gridDim.x) {
        const int k0 = (t % tk) * 64, n0 = (t / tk) * 64;
        __syncthreads();
#pragma unroll
        for (int ps = 0; ps < 2; ++ps) {
            const int i = (tid >> 4) + 32 * ps, j4 = (tid & 15) * 4;
            f32x4 v = {0.f, 0.f, 0.f, 0.f};
            if (n0 + j4 < N) v = *(const f32x4*)(src + (size_t)(k0 + i) * ldS + n0 + j4);
            tile[i * 65 + j4 + 0] = v[0]; tile[i * 65 + j4 + 1] = v[1]; tile[i * 65 + j4 + 2] = v[2]; tile[i * 65 + j4 + 3] = v[3];
        }
        __syncthreads();
        const int n = tid >> 3, kc = (tid & 7) * 8;
        if (n0 + n < N) {
            const int ng = n0 + n;
            const int drow = mode == 0 ? ng : ((ng >> 4) * 32 + which * 16 + (ng & 15));
            u32x4 w;
            w[0] = pack2(tile[(kc + 0) * 65 + n], tile[(kc + 1) * 65 + n]);
            w[1] = pack2(tile[(kc + 2) * 65 + n], tile[(kc + 3) * 65 + n]);
            w[2] = pack2(tile[(kc + 4) * 65 + n], tile[(kc + 5) * 65 + n]);
            w[3] = pack2(tile[(kc + 6) * 65 + n], tile[(kc + 7) * 65 + n]);
            *(u32x4*)(dst + (size_t)drow * K + k0 + kc) = w;
        }
    }
}

__device__ void ph_weights(const P& p, char* smem) {
    float* tile = (float*)smem;
    for (int l = 0; l < NLAYER; ++l) {
        const float* win = p.in[8] + (size_t)l * D * N_IN;
        bf16_t* bt1 = wsp<bf16_t>(p, OFF_BTIN1) + (size_t)l * NP1 * D;
        xpose_job(win, N_IN, D, C_MG, bt1, 0, 0, tile);
        for (size_t i = (size_t)BID() * NTHR + TID(); i < (size_t)(NP1 - C_MG) * D / 8; i += (size_t)gridDim.x * NTHR)
            *(u32x4*)(bt1 + (size_t)C_MG * D + i * 8) = (u32x4){0u, 0u, 0u, 0u};
        xpose_job(win + C_MG, N_IN, D, 4096, wsp<bf16_t>(p, OFF_BTGATE) + (size_t)l * 4096 * D, 0, 0, tile);
        for (int i = 0; i < 4; ++i)
            xpose_job(p.in[27] + ((size_t)l * 4 + i) * 256 * D, D, 256, D, wsp<bf16_t>(p, OFF_BTBR) + ((size_t)l * 4 + i) * 1024 * 256, 0, 0, tile);
        xpose_job(p.in[28] + (size_t)l * D * D, D, D, D, wsp<bf16_t>(p, OFF_BTOUT) + (size_t)l * D * D, 0, 0, tile);
        for (int e = 0; e < NEXP; ++e) {
            const size_t le = (size_t)l * NEXP + e;
            xpose_job(p.in[30] + le * D * D, D, D, D, wsp<bf16_t>(p, OFF_BTW13) + le * 2048 * D, 1, 0, tile);
            xpose_job(p.in[31] + le * D * D, D, D, D, wsp<bf16_t>(p, OFF_BTW13) + le * 2048 * D, 1, 1, tile);
            xpose_job(p.in[32] + le * D * D, D, D, D, wsp<bf16_t>(p, OFF_BTW2) + le * D * D, 0, 0, tile);
        }
    }
}

__device__ void ph_mod(const P& p, char* smem) {
    float* s = (float*)smem;
    float* red = s + 17 * 1024;
    const int tid = TID();
    for (int i = tid; i < 17 * 1024; i += NTHR) { const float v = i < 16384 ? p.in[1][i] : p.in[3][i - 16384]; s[i] = siluf_(v); }
    __syncthreads();
    for (int u = BID(); u < NLAYER * 96; u += gridDim.x) {
        const int l = u / 96, col = (u % 96) * 64 + (tid & 63), ks = tid >> 6;
        const float* w = p.in[4] + (size_t)l * D * 6144 + col;
        float acc[17];
#pragma unroll
        for (int r = 0; r < 17; ++r) acc[r] = 0.f;
        for (int k = ks * 128; k < ks * 128 + 128; ++k) {
            const float wv = w[(size_t)k * 6144];
#pragma unroll
            for (int r = 0; r < 17; ++r) acc[r] += s[r * 1024 + k] * wv;
        }
#pragma unroll
        for (int r = 0; r < 17; ++r) red[(ks * 17 + r) * 64 + (tid & 63)] = acc[r];
        __syncthreads();
        for (int i = tid; i < 17 * 64; i += NTHR) {
            const int r = i / 64, c = i % 64, cg = (u % 96) * 64 + c;
            float v = p.in[5][(size_t)l * 6144 + cg];
#pragma unroll
            for (int q = 0; q < 8; ++q) v += red[(q * 17 + r) * 64 + c];
            if (r < 16) wsp<float>(p, OFF_MODX)[((size_t)l * NB + r) * 6144 + cg] = v;
            else wsp<float>(p, OFF_MODC)[(size_t)l * 6144 + cg] = v;
        }
        __syncthreads();
    }
}

__device__ void ph_hfilt(const P& p, char* smem) {
    float* feats = (float*)smem;
    float* h1 = feats + 64 * 33;
    float* h2 = h1 + 64 * 64;
    const int tid = TID();
    for (int u = BID(); u < NLAYER * 68; u += gridDim.x) {
        const int l = u / 68, ub = u % 68, w = ub >= 64 ? 1 : 0, jb = w ? ub - 64 : ub, L = w ? LC : LQ;
        __syncthreads();
        for (int i = tid; i < 64 * 33; i += NTHR) {
            const int pos = i / 33, fi = i % 33; const float j = (float)(jb * 64 + pos);
            float v;
            if (fi == 0) v = j / (float)(L - 1);
            else {
                const int k = (fi - 1) & 15; const float f = 1e-4f + (float)k * ((15.0f - 1e-4f) / 15.0f);
                const float wv = 6.283185307179586f * j / (float)L;
                v = fi <= 16 ? cosf(wv * f) : -sinf(wv * f);
            }
            feats[i] = v;
        }
        __syncthreads();
        const float* w1 = p.in[13] + (size_t)l * 33 * 64; const float* b1 = p.in[14] + l * 64;
        const float* w2 = p.in[15] + (size_t)l * 64 * 64; const float* b2 = p.in[16] + l * 64;
        const float* w3 = p.in[17] + (size_t)l * 64 * 512; const float* fr = p.in[18] + l * 128;
        for (int i = tid; i < 64 * 64; i += NTHR) {
            const int pos = i >> 6, k = i & 63; float a = b1[k];
            for (int f = 0; f < 33; ++f) a += feats[pos * 33 + f] * w1[f * 64 + k];
            h1[i] = sinf(fr[k] * a);
        }
        __syncthreads();
        for (int i = tid; i < 64 * 64; i += NTHR) {
            const int pos = i >> 6, k = i & 63; float a = b2[k];
            for (int f = 0; f < 64; ++f) a += h1[pos * 64 + f] * w2[f * 64 + k];
            h2[i] = sinf(fr[64 + k] * a);
        }
        __syncthreads();
        {
            const int n = tid; float asum = 0.f;
            const float dec = fabsf(p.in[19][(size_t)l * 512 + n]);
            float* hr = wsp<float>(p, OFF_HRAW) + (size_t)l * HRAW_L + (w ? (size_t)512 * LQ : 0) + (size_t)n * L + jb * 64;
            for (int pos = 0; pos < 64; ++pos) {
                float a = 0.f;
                for (int k = 0; k < 64; ++k) a += h2[pos * 64 + k] * w3[k * 512 + n];
                const int j = jb * 64 + pos; const float dist = fabsf((float)(j - L / 2)) / (float)(L / 2);
                a *= __expf(-dist * dec) + 0.05f;
                hr[pos] = a; asum += fabsf(a);
            }
            wsp<float>(p, OFF_PSUM)[((size_t)l * 68 + ub) * 512 + n] = asum;
        }
    }
}

template <int WHICH>
__device__ void ph_norm(const P& p, int l, int grp, char* smem) {
    const int tid = TID(), lane = tid & 63, wid = tid >> 6;
    float* rt = (float*)smem;
    if (WHICH == 1) {
        const float* rsrc = p.in[29] + (size_t)l * D * NEXP;
        for (int i = tid; i < D * NEXP / 4; i += NTHR) ((f32x4*)rt)[i] = ((const f32x4*)rsrc)[i];
        __syncthreads();
    }
    const float* gain = p.in[WHICH ? 7 : 6] + (size_t)l * D;
    bf16_t* hx = wsp<bf16_t>(p, OFF_HX);
    for (int r = BID() * 8 + wid; r < R; r += gridDim.x * 8) {
        const int bl = r / TT, pp = r % TT, b = grp * BG + bl; const bool isctx = pp < LC;
        if (WHICH == 1 && l == NLAYER - 1 && isctx) continue;
        const float* src = WHICH == 0 ? stream_src(p, l, b, pp) : (const float*)stream_dst(p, b, pp);
        const float* mod = isctx ? wsp<const float>(p, OFF_MODC) + (size_t)l * 6144 : wsp<const float>(p, OFF_MODX) + ((size_t)l * NB + b) * 6144;
        const float* shp = mod + (WHICH ? 3 : 0) * D; const float* scp = mod + (WHICH ? 4 : 1) * D;
        f32x4 x[4]; float ss = 0.f;
#pragma unroll
        for (int i = 0; i < 4; ++i) { x[i] = *(const f32x4*)(src + i * 256 + lane * 4); ss += x[i][0] * x[i][0] + x[i][1] * x[i][1] + x[i][2] * x[i][2] + x[i][3] * x[i][3]; }
        ss = wave_sum(ss);
        const float rs = rsqrtf(ss * (1.0f / D) + 1e-6f);
        float lg[NEXP];
#pragma unroll
        for (int e = 0; e < NEXP; ++e) lg[e] = 0.f;
#pragma unroll
        for (int i = 0; i < 4; ++i) {
            const int c = i * 256 + lane * 4;
            const f32x4 g = *(const f32x4*)(gain + c), sh = *(const f32x4*)(shp + c), sc = *(const f32x4*)(scp + c);
            f32x4 y;
#pragma unroll
            for (int j = 0; j < 4; ++j) y[j] = x[i][j] * rs * g[j] * (1.0f + sc[j]) + sh[j];
            u32x2 w; w[0] = pack2(y[0], y[1]); w[1] = pack2(y[2], y[3]);
            *(u32x2*)(hx + (size_t)r * D + c) = w;
            if (WHICH == 1) {
#pragma unroll
                for (int j = 0; j < 4; ++j) {
#pragma unroll
                    for (int e4 = 0; e4 < 4; ++e4) { const f32x4 rv = *(const f32x4*)(rt + (c + j) * NEXP + e4 * 4);
                        lg[e4 * 4 + 0] += y[j] * rv[0]; lg[e4 * 4 + 1] += y[j] * rv[1]; lg[e4 * 4 + 2] += y[j] * rv[2]; lg[e4 * 4 + 3] += y[j] * rv[3]; }
                }
            }
        }
        if (WHICH == 1) {
            float mx = -1e30f;
#pragma unroll
            for (int e = 0; e < NEXP; ++e) { lg[e] = wave_sum(lg[e]); mx = fmaxf(mx, lg[e]); }
            float sum = 0.f, mine = 0.f;
#pragma unroll
            for (int e = 0; e < NEXP; ++e) { const float ev = __expf(lg[e] - mx); sum += ev; mine = (lane == e) ? ev : mine; }
            if (lane < NEXP) {
                float* aff = wsp<float>(p, OFF_AFF);
                if (isctx) aff[(size_t)BG * NEXP * LQ + ((size_t)bl * NEXP + lane) * LC + pp] = mine / sum;
                else aff[((size_t)bl * NEXP + lane) * LQ + (pp - LC)] = mine / sum;
                wsp<int>(p, OFF_INV)[(size_t)r * NEXP + lane] = -1;
            }
        }
    }
}

template <int WR, int WC, int MT, int NT>
struct GC {
    static constexpr int BM = WR * MT * 16, BN = WC * NT * 16, ROWB = 160;
    static constexpr int A_BYTES = BM * ROWB, B_BYTES = BN * ROWB, STAGE = A_BYTES + B_BYTES;
    static constexpr int A_CH = BM * 8 / NTHR, B_CH = BN * 8 / NTHR;
    static_assert(2 * STAGE <= SMEM_BYTES, "lds");
    template <class AR, class BR>
    static __device__ __forceinline__ void run(char* smem, AR arow, BR brow, int K, f32x4 (&acc)[MT][NT]) {
        const int tid = TID(), lane = tid & 63, wid = tid >> 6, wr = wid / WC, wc = wid % WC, fr = lane & 15, fq = lane >> 4;
        const bf16_t* ap[A_CH]; const bf16_t* bp[B_CH]; int aoff[A_CH], boff[B_CH];
#pragma unroll
        for (int i = 0; i < A_CH; ++i) { const int c = tid + NTHR * i, row = c >> 3, kc = c & 7; ap[i] = arow(row) + kc * 8; aoff[i] = row * ROWB + kc * 16; }
#pragma unroll
        for (int i = 0; i < B_CH; ++i) { const int c = tid + NTHR * i, row = c >> 3, kc = c & 7; bp[i] = brow(row) + kc * 8; boff[i] = A_BYTES + row * ROWB + kc * 16; }
        u32x4 ra[A_CH], rb[B_CH];
        const int nk = K / 64;
#pragma unroll
        for (int i = 0; i < A_CH; ++i) ra[i] = *(const u32x4*)(ap[i]);
#pragma unroll
        for (int i = 0; i < B_CH; ++i) rb[i] = *(const u32x4*)(bp[i]);
        __syncthreads();
#pragma unroll
        for (int i = 0; i < A_CH; ++i) *(u32x4*)(smem + aoff[i]) = ra[i];
#pragma unroll
        for (int i = 0; i < B_CH; ++i) *(u32x4*)(smem + boff[i]) = rb[i];
        __syncthreads();
        for (int kt = 0; kt < nk; ++kt) {
            const char* cur = smem + (kt & 1) * STAGE; char* nxt = smem + ((kt + 1) & 1) * STAGE;
            if (kt + 1 < nk) {
#pragma unroll
                for (int i = 0; i < A_CH; ++i) ra[i] = *(const u32x4*)(ap[i] + (kt + 1) * 64);
#pragma unroll
                for (int i = 0; i < B_CH; ++i) rb[i] = *(const u32x4*)(bp[i] + (kt + 1) * 64);
            }
#pragma unroll
            for (int kk = 0; kk < 2; ++kk) {
                bf16x8 af[MT], bfr[NT];
#pragma unroll
                for (int m = 0; m < MT; ++m) af[m] = *(const bf16x8*)(cur + (wr * MT * 16 + m * 16 + fr) * ROWB + kk * 64 + fq * 16);
#pragma unroll
                for (int n = 0; n < NT; ++n) bfr[n] = *(const bf16x8*)(cur + A_BYTES + (wc * NT * 16 + n * 16 + fr) * ROWB + kk * 64 + fq * 16);
#pragma unroll
                for (int m = 0; m < MT; ++m)
#pragma unroll
                    for (int n = 0; n < NT; ++n) acc[m][n] = __builtin_amdgcn_mfma_f32_16x16x32_bf16(bfr[n], af[m], acc[m][n], 0, 0, 0);
            }
            if (kt + 1 < nk) {
#pragma unroll
                for (int i = 0; i < A_CH; ++i) *(u32x4*)(nxt + aoff[i]) = ra[i];
#pragma unroll
                for (int i = 0; i < B_CH; ++i) *(u32x4*)(nxt + boff[i]) = rb[i];
            }
            __syncthreads();
        }
    }
};
typedef GC<4, 2, 4, 4> GBig;
typedef GC<2, 4, 4, 2> GSq;

#define ZERO_ACC(acc, MT, NT) _Pragma("unroll") for (int _m = 0; _m < MT; ++_m) _Pragma("unroll") for (int _n = 0; _n < NT; ++_n) acc[_m][_n] = (f32x4){0.f, 0.f, 0.f, 0.f}

__device__ void ph_g1(const P& p, int l, char* smem) {
    const int tid = TID(), lane = tid & 63, wid = tid >> 6, wr = wid / 2, wc = wid % 2, fr = lane & 15, fq = lane >> 4;
    const bf16_t* hx = wsp<const bf16_t>(p, OFF_HX);
    const bf16_t* bt = wsp<const bf16_t>(p, OFF_BTIN1) + (size_t)l * NP1 * D;
    bf16_t* proj = wsp<bf16_t>(p, OFF_BIG);
    constexpr int NPN = NP1 / 128;
    for (int u = BID(); u < (R / 256) * NPN; u += gridDim.x) {
        const int pm = u / NPN, pn = u % NPN;
        f32x4 acc[4][4]; ZERO_ACC(acc, 4, 4);
        GBig::run(smem, [&](int i) { return hx + (size_t)(pm * 256 + i) * D; }, [&](int i) { return bt + (size_t)(pn * 128 + i) * D; }, D, acc);
#pragma unroll
        for (int m = 0; m < 4; ++m) {
            const int row = pm * 256 + wr * 64 + m * 16 + fr;
#pragma unroll
            for (int n = 0; n < 4; ++n) {
                const int col = pn * 128 + wc * 64 + n * 16 + fq * 4;
                u32x2 w; w[0] = pack2(acc[m][n][0], acc[m][n][1]); w[1] = pack2(acc[m][n][2], acc[m][n][3]);
                *(u32x2*)(proj + (size_t)row * NP1 + col) = w;
            }
        }
    }
}

__device__ void ph_attn_prep(const P& p, int l) {
    const int tid = TID(), lane = tid & 63, wid = tid >> 6;
    const bf16_t* proj = wsp<const bf16_t>(p, OFF_BIG);
    bf16_t* Qa = wsp<bf16_t>(p, OFF_QA); bf16_t* Ka = wsp<bf16_t>(p, OFF_KA);
    const int j = lane & 7, d0 = j * 4;
    const float* gq = p.in[23] + l * 32; const float* gk = p.in[24] + l * 32;
    for (int r = BID() * 8 + wid; r < R; r += gridDim.x * 8) {
        const int bl = r / TT, pp = r % TT; const bool lat = pp >= LC; const int t = pp - LC;
        const int h = lane >> 4;
        float cs[4], sn[4];
        if (lat) {
            const float pos = (float)((j < 4) ? (t >> 6) : (t & 63));
#pragma unroll
            for (int c = 0; c < 4; ++c) { const int i = (j & 1) * 4 + c; const float fq_ = exp2f(-(float)i * (13.287712379549449f / 8.0f)); sincosf(pos * fq_, &sn[c], &cs[c]); }
        }
#pragma unroll
        for (int which = 0; which < 2; ++which) {
            const u32x2 raw = *(const u32x2*)(proj + (size_t)r * NP1 + (which ? C_DK : C_DQ) + lane * 4);
            float v[4] = {bf2f((bf16_t)(raw[0] & 0xffff)), bf2f((bf16_t)(raw[0] >> 16)), bf2f((bf16_t)(raw[1] & 0xffff)), bf2f((bf16_t)(raw[1] >> 16))};
            float ss = v[0] * v[0] + v[1] * v[1] + v[2] * v[2] + v[3] * v[3];
            ss += __shfl_xor(ss, 1); ss += __shfl_xor(ss, 2); ss += __shfl_xor(ss, 4);
            const float rs = rsqrtf(ss * (1.0f / 32.0f) + 1e-6f);
            const float* g = which ? gk : gq;
#pragma unroll
            for (int c = 0; c < 4; ++c) v[c] = v[c] * rs * g[d0 + c];
            if (lat) {
#pragma unroll
                for (int c = 0; c < 4; ++c) {
                    const float o = __shfl_xor(v[c], 2);
                    v[c] = (j & 2) ? (o * sn[c] + v[c] * cs[c]) : (v[c] * cs[c] - o * sn[c]);
                }
            }
            if (!which) {
#pragma unroll
                for (int c = 0; c < 4; ++c) v[c] *= 0.17677669529663687f * 1.4426950408889634f;
            }
            u32x2 w; w[0] = pack2(v[0], v[1]); w[1] = pack2(v[2], v[3]);
            *(u32x2*)((which ? Ka : Qa) + (((size_t)bl * 4 + h) * TT + pp) * 64 + (lane & 15) * 4) = w;
        }
    }
}

__device__ void ph_v_prep(const P& p, char* smem) {
    bf16_t* tile = (bf16_t*)smem;
    const int tid = TID();
    const bf16_t* proj = wsp<const bf16_t>(p, OFF_BIG);
    bf16_t* Vt = wsp<bf16_t>(p, OFF_VA);
    constexpr int NTT = TT / 64;
    for (int u = BID(); u < BG * NTT * 4; u += gridDim.x) {
        const int h = u & 3, tt = (u >> 2) % NTT, bl = u / (4 * NTT);
        __syncthreads();
        {
            const int tok = tid >> 3, c8 = (tid & 7) * 8;
            *(u32x4*)(tile + tok * 72 + c8) = *(const u32x4*)(proj + (size_t)(bl * TT + tt * 64 + tok) * NP1 + C_DV + h * 64 + c8);
        }
        __syncthreads();
        const int dv = tid >> 3, t8 = (tid & 7) * 8;
        u32x4 w;
#pragma unroll
        for (int j = 0; j < 4; ++j) w[j] = (unsigned)tile[(t8 + 2 * j) * 72 + dv] | ((unsigned)tile[(t8 + 2 * j + 1) * 72 + dv] << 16);
        *(u32x4*)(Vt + (((size_t)bl * 4 + h) * 64 + dv) * TT + tt * 64 + t8) = w;
    }
}

__device__ void ph_hy_prep(const P& p, int l, char* smem) {
    float* tile = (float*)smem;
    const int tid = TID();
    const bf16_t* proj = wsp<const bf16_t>(p, OFF_BIG);
    bf16_t* hyT = wsp<bf16_t>(p, OFF_HYT);
    const float* cw = p.in[12] + (size_t)l * 3 * 768;
    constexpr int NTT = TT / 64;
    for (int u = BID(); u < BG * NTT * 12; u += gridDim.x) {
        const int ct = u % 12, tt = (u / 12) % NTT, bl = u / (12 * NTT);
        const int p0 = tt * 64; const bool lat = p0 >= LC; const int seg0 = lat ? LC : 0, segL = lat ? LQ : LC;
        __syncthreads();
        for (int i = tid; i < 66 * 16; i += NTHR) {
            const int rr = i >> 4, c4 = (i & 15) * 4; const int pp = p0 - 1 + rr;
            float v[4] = {0.f, 0.f, 0.f, 0.f};
            if (pp >= seg0 && pp < seg0 + segL) {
                const u32x2 raw = *(const u32x2*)(proj + (size_t)(bl * TT + pp) * NP1 + C_HY + ct * 64 + c4);
                v[0] = bf2f((bf16_t)(raw[0] & 0xffff)); v[1] = bf2f((bf16_t)(raw[0] >> 16)); v[2] = bf2f((bf16_t)(raw[1] & 0xffff)); v[3] = bf2f((bf16_t)(raw[1] >> 16));
            }
            tile[rr * 65 + c4] = v[0]; tile[rr * 65 + c4 + 1] = v[1]; tile[rr * 65 + c4 + 2] = v[2]; tile[rr * 65 + c4 + 3] = v[3];
        }
        __syncthreads();
        const int ch = tid >> 3, t8 = (tid & 7) * 8, cg = ct * 64 + ch;
        const float w0 = cw[cg], w1 = cw[768 + cg], w2 = cw[1536 + cg];
        float o[8];
#pragma unroll
        for (int q = 0; q < 8; ++q) { const int rr = t8 + q + 1; o[q] = tile[(rr - 1) * 65 + ch] * w0 + tile[rr * 65 + ch] * w1 + tile[(rr + 1) * 65 + ch] * w2; }
        bf16_t* dst = lat ? hyT + ((size_t)bl * 768 + cg) * LQ + (p0 - LC) + t8 : hyT + (size_t)BG * 768 * LQ + ((size_t)bl * 768 + cg) * LC + p0 + t8;
        u32x4 w; w[0] = pack2(o[0], o[1]); w[1] = pack2(o[2], o[3]); w[2] = pack2(o[4], o[5]); w[3] = pack2(o[6], o[7]);
        *(u32x4*)dst = w;
    }
}

template <int DK>
__device__ void recur_unit(const P& p, int l, int bl, int h, int br, int dir, char* smem) {
    constexpr int DPL = DK / 8;
    float* qS = (float*)smem;
    float* kS = qS + 64 * DK;
    float* gS = kS + 64 * DK;
    float* vS = gS + 64 * DK;
    float* oS = vS + 64 * 64;
    const int tid = TID(), lane = tid & 63, wid = tid >> 6;
    const bf16_t* proj = wsp<const bf16_t>(p, OFF_BIG);
    float* obuf = wsp<float>(p, OFF_OBUF) + ((size_t)dir * 2 + br) * R * 256;
    const int e = wid * 8 + (lane & 7), d0 = (lane >> 3) * DPL;
    float S[DPL];
#pragma unroll
    for (int j = 0; j < DPL; ++j) S[j] = 0.f;
    const float* wa2 = p.in[9] + ((size_t)l * 2 + dir) * 16 * 128; const float* ba = p.in[10] + ((size_t)l * 2 + dir) * 128;
    const float* hl = p.in[21];
    for (int ch = 0; ch < TT / 64; ++ch) {
        __syncthreads();
        for (int i = tid; i < 64 * DK; i += NTHR) {
            const int tk = i / DK, d = i % DK, n = ch * 64 + tk;
            const int pp = dir == 0 ? n : (n < LC ? LC - 1 - n : LC + (LQ - 1 - (n - LC)));
            const bf16_t* row = proj + (size_t)(bl * TT + pp) * NP1;
            float q, k, g;
            if (br == 0) {
                q = bf2f(row[C_GQ + h * 32 + d]) * 0.17677669529663687f; k = bf2f(row[C_GK + h * 32 + d]);
                float z = ba[h * 32 + d];
#pragma unroll
                for (int rr = 0; rr < 16; ++rr) z += bf2f(row[(dir ? C_GAB : C_GAF) + rr]) * wa2[rr * 128 + h * 32 + d];
                const float ls = fminf(z, 0.f) - log1pf(__expf(-fabsf(z)));
                g = __expf(ls * (1.0f / 16.0f));
            } else {
                q = siluf_(bf2f(row[C_HQ + h * 64 + d]));
                const float z = bf2f(row[(dir ? C_HFB : C_HFF) + h * 64 + d]);
                float lb = 0.f;
                if (l == 1) { const float a0 = hl[(0 * 2 + dir) * 256 + h * 64 + d], a1 = hl[(1 * 2 + dir) * 256 + h * 64 + d]; lb = 1.0f / (1.0f + __expf(a0 - a1)); }
                g = fmaxf(lb + (1.0f - lb) * sigmoidf_(z), 1e-20f);
                k = (1.0f - lb) * sigmoidf_(-z);
            }
            qS[i] = q; kS[i] = k; gS[i] = g;
        }
        for (int i = tid; i < 64 * 64; i += NTHR) {
            const int tk = i >> 6, ee = i & 63, n = ch * 64 + tk;
            const int pp = dir == 0 ? n : (n < LC ? LC - 1 - n : LC + (LQ - 1 - (n - LC)));
            vS[i] = bf2f(proj[(size_t)(bl * TT + pp) * NP1 + (br == 0 ? C_GV : C_HI) + h * 64 + ee]);
        }
        __syncthreads();
        for (int tk = 0; tk < 64; ++tk) {
            const float v = vS[tk * 64 + e]; float o = 0.f;
#pragma unroll
            for (int j = 0; j < DPL; ++j) {
                S[j] = gS[tk * DK + d0 + j] * S[j] + kS[tk * DK + d0 + j] * v;
                o += S[j] * qS[tk * DK + d0 + j];
            }
            o += __shfl_xor(o, 8); o += __shfl_xor(o, 16); o += __shfl_xor(o, 32);
            if ((lane >> 3) == 0) oS[tk * 64 + e] = o;
        }
        __syncthreads();
        {
            const int tk = tid >> 3, e8 = (tid & 7) * 8, n = ch * 64 + tk;
            const int pp = dir == 0 ? n : (n < LC ? LC - 1 - n : LC + (LQ - 1 - (n - LC)));
            float* dst = obuf + (size_t)(bl * TT + pp) * 256 + h * 64 + e8;
            *(f32x4*)dst = *(const f32x4*)(oS + tk * 64 + e8); *(f32x4*)(dst + 4) = *(const f32x4*)(oS + tk * 64 + e8 + 4);
        }
    }
}

__device__ void ph_hcopies(const P& p) {
    const int tid = TID();
    for (int u = BID(); u < NLAYER * 512; u += gridDim.x) {
        const int l = u / 512, n = u % 512;
        const float* hr = wsp<const float>(p, OFF_HRAW) + (size_t)l * HRAW_L + (size_t)n * LQ;
        const float* psum = wsp<const float>(p, OFF_PSUM) + (size_t)l * 68 * 512;
        float sc = 0.f;
        for (int q = 0; q < 64; ++q) sc += psum[q * 512 + n];
        const float inv = 1.0f / sc;
        char* dst = wsp<char>(p, OFF_HCOP) + (size_t)u * (8 * HY_HSTR);
        for (int i = tid; i < 8 * HY_NS; i += NTHR) {
            const int kap = i / HY_NS, s = i % HY_NS; const int y0 = 8 * s + kap - 16;
            float v[8];
#pragma unroll
            for (int e = 0; e < 8; ++e) { const int y = y0 + e; v[e] = (y >= 0 && y < LQ) ? hr[LQ - 1 - y] * inv : 0.f; }
            u32x4 w; w[0] = pack2(v[0], v[1]); w[1] = pack2(v[2], v[3]); w[2] = pack2(v[4], v[5]); w[3] = pack2(v[6], v[7]);
            *(u32x4*)(dst + kap * HY_HSTR + s * 16) = w;
        }
    }
}

__device__ void hyena_mfma_unit(const P& p, int l, int c, char* smem) {
    const int tid = TID(), lane = tid & 63, wid = tid >> 6, fr = lane & 15, fq = lane >> 4;
    const int sg = fr >> 3;
    char* Us = smem; char* Hs = smem + HY_U_BYTES; const char* zero16 = smem + HY_Z_OFF;
    const bf16_t* hyT = wsp<const bf16_t>(p, OFF_HYT);
    bf16_t* outs = wsp<bf16_t>(p, OFF_OUTS);
    __syncthreads();
    for (int i = tid; i < 8 * 512; i += NTHR) {
        const int bb = i >> 9, s8 = (i & 511) * 8;
        *(u32x4*)(Us + bb * HY_UB + s8 * 2) = *(const u32x4*)(hyT + ((size_t)bb * 768 + c) * LQ + s8);
    }
    if (tid < 4) ((unsigned*)(smem + HY_Z_OFF))[tid] = 0u;
    const int tw = wid * 256;
    const int c0 = fq + (fr < 8 ? 1 : 0);
    const char* hl = Hs + ((7 - fr) & 7) * HY_HSTR;
#pragma unroll 1
    for (int o = 0; o < 2; ++o) {
        const char* hc = wsp<const char>(p, OFF_HCOP) + ((size_t)l * 512 + o * 256 + c) * (8 * HY_HSTR);
        for (int i = tid; i < 8 * HY_HSTR / 16; i += NTHR) *(u32x4*)(Hs + i * 16) = *(const u32x4*)(hc + i * 16);
        __syncthreads();
        f32x4 acc[16];
#pragma unroll
        for (int m = 0; m < 16; ++m) acc[m] = (f32x4){0.f, 0.f, 0.f, 0.f};
        bf16x8 F[16];
#pragma unroll
        for (int q = 2; q < 16; ++q) { int s = -2 * q + c0; s = s < 0 ? 0 : s; F[q] = *(const bf16x8*)(hl + s * 16); }
#pragma unroll 1
        for (int jo = 0; jo < 17; ++jo) {
#pragma unroll
            for (int ji = 0; ji < 8; ++ji) {
                const int j = jo * 8 + ji;
                {
                    int s0 = 4 * j + c0, s1 = 4 * j - 2 + c0;
                    s0 = s0 > HY_NS - 1 ? HY_NS - 1 : s0; s1 = s1 < 0 ? 0 : (s1 > HY_NS - 1 ? HY_NS - 1 : s1);
                    F[(16 - 2 * ji) & 15] = *(const bf16x8*)(hl + s0 * 16);
                    F[(17 - 2 * ji) & 15] = *(const bf16x8*)(hl + s1 * 16);
                }
                const int sidx = tw - 2048 + 32 * j + sg * 2048;
                const char* ba = ((unsigned)sidx < 4096u) ? (Us + (fr & 7) * HY_UB + (sidx + 8 * fq) * 2) : zero16;
                const bf16x8 B = *(const bf16x8*)ba;
#pragma unroll
                for (int m = 0; m < 16; ++m) acc[m] = __builtin_amdgcn_mfma_f32_16x16x32_bf16(F[(m - 2 * ji) & 15], B, acc[m], 0, 0, 0);
            }
        }
        __syncthreads();
        const float bias = p.in[20][((size_t)l * 2 + o) * 256 + c];
        const int tid2 = TID(), fr2 = tid2 & 15, fq2 = (tid2 >> 4) & 3, b = fr2 & 7, sg2 = fr2 >> 3, tw2 = (tid2 >> 6) * 256;
        const bf16_t* gp = hyT + ((size_t)b * 768 + (o + 1) * 256 + c) * LQ;
#pragma unroll
        for (int m = 0; m < 16; ++m) {
            const int t = tw2 + 16 * m + sg2 * 2048 + 4 * fq2;
            const u32x2 gr = *(const u32x2*)(gp + t);
            const float g[4] = {__uint_as_float(gr[0] << 16), __uint_as_float(gr[0] & 0xffff0000u), __uint_as_float(gr[1] << 16), __uint_as_float(gr[1] & 0xffff0000u)};
            const u32x2 zr = *(const u32x2*)(Us + b * HY_UB + t * 2);
            const float z0 = __uint_as_float(zr[0] << 16), z1 = __uint_as_float(zr[0] & 0xffff0000u), z2 = __uint_as_float(zr[1] << 16), z3 = __uint_as_float(zr[1] & 0xffff0000u);
            const float r0 = g[0] * (acc[m][0] + bias * z0), r1 = g[1] * (acc[m][1] + bias * z1), r2 = g[2] * (acc[m][2] + bias * z2), r3 = g[3] * (acc[m][3] + bias * z3);
            if (o == 0) { u32x2 w; w[0] = pack2(r0, r1); w[1] = pack2(r2, r3); *(u32x2*)(Us + b * HY_UB + t * 2) = w; }
            else {
                bf16_t* dp = outs + (size_t)(b * TT + LC + t) * D + 256 + c;
                dp[0] = f2bf(r0); dp[D] = f2bf(r1); dp[2 * D] = f2bf(r2); dp[3 * D] = f2bf(r3);
            }
            if (m & 1) asm volatile("" ::: "memory");
        }
        __syncthreads();
    }
}

template <int L>
__device__ void hyena_unit(const P& p, int l, int bl, int c, char* smem) {
    constexpr int W = L == LQ ? 0 : 1, NU = L / 64;
    float* upad = (float*)smem;
    float* hS = upad + 2 * L;
    const int tid = TID();
    const bf16_t* hyT = wsp<const bf16_t>(p, OFF_HYT) + (W ? (size_t)BG * 768 * LQ : 0) + (size_t)bl * 768 * L;
    const float* hraw = wsp<const float>(p, OFF_HRAW) + (size_t)l * HRAW_L + (W ? (size_t)512 * LQ : 0);
    const float* psum = wsp<const float>(p, OFF_PSUM) + (size_t)l * 68 * 512 + (W ? 64 * 512 : 0);
    bf16_t* outs = wsp<bf16_t>(p, OFF_OUTS);
    const bool act = tid * 8 < L; const int t0 = tid * 8;
    float z[8];
    __syncthreads();
    for (int i = tid; i < 2 * L; i += NTHR) { const int s = i - L / 2; upad[i] = (s >= 0 && s < L) ? bf2f(hyT[(size_t)c * L + s]) : 0.f; }
    if (act) {
#pragma unroll
        for (int i = 0; i < 8; ++i) z[i] = bf2f(hyT[(size_t)c * L + t0 + i]);
    }
    for (int o = 0; o < 2; ++o) {
        const int n = o * 256 + c;
        float sc = 0.f;
        for (int q = 0; q < NU; ++q) sc += psum[q * 512 + n];
        const float inv = 1.0f / sc;
        for (int i = tid; i < L; i += NTHR) hS[i] = hraw[(size_t)n * L + i];
        __syncthreads();
        float acc[8];
#pragma unroll
        for (int i = 0; i < 8; ++i) acc[i] = 0.f;
        if (act) {
            float hi[8], lo[8];
            const float* wp = upad + t0 + L - 8;
#pragma unroll
            for (int m = 0; m < 8; ++m) hi[m] = wp[8 + m];
            for (int J = 0; J < L / 8; ++J) {
                const f32x4 l0 = *(const f32x4*)(wp - 8 * J), l1 = *(const f32x4*)(wp - 8 * J + 4);
                lo[0] = l0[0]; lo[1] = l0[1]; lo[2] = l0[2]; lo[3] = l0[3]; lo[4] = l1[0]; lo[5] = l1[1]; lo[6] = l1[2]; lo[7] = l1[3];
                const f32x4 h0 = *(const f32x4*)(hS + 8 * J), h1 = *(const f32x4*)(hS + 8 * J + 4);
                const float hv[8] = {h0[0], h0[1], h0[2], h0[3], h1[0], h1[1], h1[2], h1[3]};
#pragma unroll
                for (int jj = 0; jj < 8; ++jj)
#pragma unroll
                    for (int i = 0; i < 8; ++i) { const int m = i - jj + 8; acc[i] += hv[jj] * (m >= 8 ? hi[m - 8] : lo[m]); }
#pragma unroll
                for (int m = 0; m < 8; ++m) hi[m] = lo[m];
            }
        }
        const float bias = p.in[20][((size_t)l * 2 + o) * 256 + c];
        if (act) {
#pragma unroll
            for (int i = 0; i < 8; ++i) { const float gate = bf2f(hyT[(size_t)((o + 1) * 256 + c) * L + t0 + i]); z[i] = gate * (acc[i] * inv + bias * z[i]); }
        }
        __syncthreads();
        if (o == 0) {
            if (act) {
#pragma unroll
                for (int i = 0; i < 8; ++i) upad[L / 2 + t0 + i] = z[i];
            }
        } else if (act) {
#pragma unroll
            for (int i = 0; i < 8; ++i) outs[(size_t)(bl * TT + (W ? 0 : LC) + t0 + i) * D + 256 + c] = f2bf(z[i]);
        }
        __syncthreads();
    }
}

__device__ void attn_unit(const P& p, int l, int bl, int h, int q0, int nkeys, char* smem) {
    constexpr int KROW = 160, VROW = 144, KT_BYTES = 64 * KROW, STG = KT_BYTES + 64 * VROW;
    const int tid = TID(), lane = tid & 63, wid = tid >> 6, fr = lane & 15, fq = lane >> 4;
    const bf16_t* Qa = wsp<const bf16_t>(p, OFF_QA) + ((size_t)bl * 4 + h) * TT * 64;
    const bf16_t* Ka = wsp<const bf16_t>(p, OFF_KA) + ((size_t)bl * 4 + h) * TT * 64;
    const bf16_t* Vt = wsp<const bf16_t>(p, OFF_VA) + ((size_t)bl * 4 + h) * 64 * TT;
    const int ln32 = tid & 31;
    float gqm = fabsf(p.in[23][l * 32 + ln32]), gkm = fabsf(p.in[24][l * 32 + ln32]);
#pragma unroll
    for (int o = 16; o > 0; o >>= 1) { gqm = fmaxf(gqm, __shfl_xor(gqm, o)); gkm = fmaxf(gkm, __shfl_xor(gkm, o)); }
    const float Mx2 = 32.0f * 0.17677669529663687f * 1.4426950408889634f * gqm * gkm;
    const float* lp = p.in[25] + (size_t)l * 128;
    float s01 = lp[ln32] * lp[32 + ln32], s23 = lp[64 + ln32] * lp[96 + ln32];
#pragma unroll
    for (int o = 16; o > 0; o >>= 1) { s01 += __shfl_xor(s01, o); s23 += __shfl_xor(s23, o); }
    const float lam_init = 0.8f - 0.6f * expf(-0.3f * (float)l);
    const float lam = expf(s01) - expf(s23) + lam_init;
    const f32x4 cinit = {-Mx2, -Mx2, -Mx2, -Mx2};
    const int qw = q0 + wid * 32;
    bf16x8 qf[2][2];
#pragma unroll
    for (int br = 0; br < 2; ++br)
#pragma unroll
        for (int qt = 0; qt < 2; ++qt) qf[br][qt] = *(const bf16x8*)(Qa + (size_t)(qw + qt * 16 + fr) * 64 + br * 32 + fq * 8);
    f32x4 O[2][2][4], Ls[2][2];
#pragma unroll
    for (int br = 0; br < 2; ++br)
#pragma unroll
        for (int qt = 0; qt < 2; ++qt) { Ls[br][qt] = (f32x4){0.f, 0.f, 0.f, 0.f};
#pragma unroll
            for (int dt = 0; dt < 4; ++dt) O[br][qt][dt] = (f32x4){0.f, 0.f, 0.f, 0.f}; }
    bf16x8 ones;
#pragma unroll
    for (int j = 0; j < 8; ++j) ones[j] = (short)0x3F80;
    const int srow = tid >> 3, sc = tid & 7;
    const bf16_t* kg = Ka + (size_t)srow * 64 + sc * 8;
    const bf16_t* vg = Vt + (size_t)srow * TT + sc * 8;
    const int kso = srow * KROW + sc * 16, vso = KT_BYTES + srow * VROW + sc * 16;
    u32x4 rk = *(const u32x4*)kg, rv = *(const u32x4*)vg;
    __syncthreads();
    *(u32x4*)(smem + kso) = rk; *(u32x4*)(smem + vso) = rv;
    __syncthreads();
    const int nt = nkeys / 64;
    for (int kt = 0; kt < nt; ++kt) {
        const char* cur = smem + (kt & 1) * STG; char* nxt = smem + ((kt + 1) & 1) * STG;
        if (kt + 1 < nt) { rk = *(const u32x4*)(kg + (size_t)(kt + 1) * 64 * 64); rv = *(const u32x4*)(vg + (kt + 1) * 64); }
#pragma unroll
        for (int kp = 0; kp < 2; ++kp) {
            bf16x8 kf[2][2], vf[4];
#pragma unroll
            for (int br = 0; br < 2; ++br)
#pragma unroll
                for (int t = 0; t < 2; ++t) kf[br][t] = *(const bf16x8*)(cur + (kp * 32 + t * 16 + fr) * KROW + br * 64 + fq * 16);
#pragma unroll
            for (int dt = 0; dt < 4; ++dt) {
                const u32x2 a = *(const u32x2*)(cur + KT_BYTES + (dt * 16 + fr) * VROW + kp * 64 + fq * 8);
                const u32x2 b = *(const u32x2*)(cur + KT_BYTES + (dt * 16 + fr) * VROW + kp * 64 + 32 + fq * 8);
                u32x4 c; c[0] = a[0]; c[1] = a[1]; c[2] = b[0]; c[3] = b[1];
                vf[dt] = __builtin_bit_cast(bf16x8, c);
            }
#pragma unroll
            for (int qt = 0; qt < 2; ++qt)
#pragma unroll
                for (int br = 0; br < 2; ++br) {
                    const f32x4 s0 = __builtin_amdgcn_mfma_f32_16x16x32_bf16(kf[br][0], qf[br][qt], cinit, 0, 0, 0);
                    const f32x4 s1 = __builtin_amdgcn_mfma_f32_16x16x32_bf16(kf[br][1], qf[br][qt], cinit, 0, 0, 0);
                    u32x4 pk;
                    pk[0] = cvt_pk_bf16(__builtin_amdgcn_exp2f(s0[0]), __builtin_amdgcn_exp2f(s0[1]));
                    pk[1] = cvt_pk_bf16(__builtin_amdgcn_exp2f(s0[2]), __builtin_amdgcn_exp2f(s0[3]));
                    pk[2] = cvt_pk_bf16(__builtin_amdgcn_exp2f(s1[0]), __builtin_amdgcn_exp2f(s1[1]));
                    pk[3] = cvt_pk_bf16(__builtin_amdgcn_exp2f(s1[2]), __builtin_amdgcn_exp2f(s1[3]));
                    const bf16x8 pb = __builtin_bit_cast(bf16x8, pk);
#pragma unroll
                    for (int dt = 0; dt < 4; ++dt) O[br][qt][dt] = __builtin_amdgcn_mfma_f32_16x16x32_bf16(vf[dt], pb, O[br][qt][dt], 0, 0, 0);
                    Ls[br][qt] = __builtin_amdgcn_mfma_f32_16x16x32_bf16(ones, pb, Ls[br][qt], 0, 0, 0);
                }
        }
        if (kt + 1 < nt) { *(u32x4*)(nxt + kso) = rk; *(u32x4*)(nxt + vso) = rv; }
        __syncthreads();
    }
    asm volatile("" ::: "memory");
    const float* gn = p.in[26] + l * 64;
#pragma unroll
    for (int qt = 0; qt < 2; ++qt) {
        const float i1 = 1.0f / Ls[0][qt][0], i2 = lam / Ls[1][qt][0];
        float o[4][4], ss = 0.f;
#pragma unroll
        for (int dt = 0; dt < 4; ++dt)
#pragma unroll
            for (int j = 0; j < 4; ++j) { o[dt][j] = O[0][qt][dt][j] * i1 - O[1][qt][dt][j] * i2; ss += o[dt][j] * o[dt][j]; }
        ss += __shfl_xor(ss, 16); ss += __shfl_xor(ss, 32);
        const float rs = rsqrtf(ss * (1.0f / 64.0f) + 1e-6f) * (1.0f - lam_init);
        bf16_t* dst = wsp<bf16_t>(p, OFF_OUTS) + (size_t)(bl * TT + qw + qt * 16 + fr) * D + 768 + h * 64;
#pragma unroll
        for (int dt = 0; dt < 4; ++dt) {
            const f32x4 g = *(const f32x4*)(gn + dt * 16 + fq * 4);
            u32x2 w; w[0] = pack2(o[dt][0] * rs * g[0], o[dt][1] * rs * g[1]); w[1] = pack2(o[dt][2] * rs * g[2], o[dt][3] * rs * g[3]);
            *(u32x2*)(dst + dt * 16 + fq * 4) = w;
        }
    }
}

__device__ void ph_recur(const P& p, int l, char* smem) {
    const int NR = BG * 4 * 2 * 2;
    for (int u = BID(); u < NR; u += gridDim.x) {
        const int dir = u & 1, br = (u >> 1) & 1, h = (u >> 2) & 3, bl = u >> 4;
        if (br == 0) recur_unit<32>(p, l, bl, h, 0, dir, smem); else recur_unit<64>(p, l, bl, h, 1, dir, smem);
    }
}
__device__ void ph_attn(const P& p, int l, char* smem) {
    const bool last = l == NLAYER - 1;
    const int per = 16 + (last ? 0 : 1), NA = BG * 4 * per;
    for (int u = BID(); u < NA; u += gridDim.x) {
        const int qb = u % per, h = (u / per) & 3, bl = u / (per * 4);
        if (qb < 16) attn_unit(p, l, bl, h, LC + qb * 256, TT, smem);
        else attn_unit(p, l, bl, h, 0, LC, smem);
    }
}
__device__ void ph_hyena(const P& p, int l, char* smem) {
    const bool last = l == NLAYER - 1;
    const int NHL = 256, NHC = last ? 0 : BG * 256;
    for (int u = BID(); u < NHL + NHC; u += gridDim.x) {
        if (u < NHL) hyena_mfma_unit(p, l, u, smem);
        else { const int v = u - NHL; hyena_unit<LC>(p, l, v / 256, v % 256, smem); }
    }
}

__device__ void ph_gated(const P& p, int l) {
    const int tid = TID(), lane = tid & 63, wid = tid >> 6;
    const bf16_t* proj = wsp<const bf16_t>(p, OFF_BIG);
    const float* obuf = wsp<const float>(p, OFF_OBUF);
    bf16_t* outs = wsp<bf16_t>(p, OFF_OUTS);
    for (int r = BID() * 8 + wid; r < R; r += gridDim.x * 8) {
#pragma unroll
        for (int br = 0; br < 2; ++br) {
            const f32x4 a = *(const f32x4*)(obuf + ((size_t)(0 * 2 + br) * R + r) * 256 + lane * 4);
            const f32x4 b = *(const f32x4*)(obuf + ((size_t)(1 * 2 + br) * R + r) * 256 + lane * 4);
            float o[4] = {a[0] + b[0], a[1] + b[1], a[2] + b[2], a[3] + b[3]};
            float ss = o[0] * o[0] + o[1] * o[1] + o[2] * o[2] + o[3] * o[3];
            ss += __shfl_xor(ss, 1); ss += __shfl_xor(ss, 2); ss += __shfl_xor(ss, 4); ss += __shfl_xor(ss, 8);
            const float rs = rsqrtf(ss * (1.0f / 64.0f) + 1e-6f);
            const float* gn = p.in[br ? 22 : 11] + l * 64 + (lane & 15) * 4;
            const u32x2 graw = *(const u32x2*)(proj + (size_t)r * NP1 + (br ? C_HGG : C_GG) + lane * 4);
            const float gt[4] = {bf2f((bf16_t)(graw[0] & 0xffff)), bf2f((bf16_t)(graw[0] >> 16)), bf2f((bf16_t)(graw[1] & 0xffff)), bf2f((bf16_t)(graw[1] >> 16))};
#pragma unroll
            for (int c = 0; c < 4; ++c) o[c] = o[c] * rs * gn[c] * siluf_(gt[c]);
            u32x2 w; w[0] = pack2(o[0], o[1]); w[1] = pack2(o[2], o[3]);
            *(u32x2*)(outs + (size_t)r * D + (br ? 512 : 0) + lane * 4) = w;
        }
    }
}

__device__ void ph_merge(const P& p, int l, char* smem) {
    const int tid = TID(), lane = tid & 63, wid = tid >> 6, wr = wid / 4, wc = wid % 4, fr = lane & 15, fq = lane >> 4;
    const bool last = l == NLAYER - 1;
    const bf16_t* hx = wsp<const bf16_t>(p, OFF_HX); const bf16_t* outs = wsp<const bf16_t>(p, OFF_OUTS);
    const bf16_t* btg = wsp<const bf16_t>(p, OFF_BTGATE) + (size_t)l * 4096 * D;
    const bf16_t* btb = wsp<const bf16_t>(p, OFF_BTBR) + (size_t)l * 4 * 1024 * 256;
    bf16_t* merged = wsp<bf16_t>(p, OFF_BIG);
    for (int u = BID(); u < (R / 128) * 8; u += gridDim.x) {
        const int pm = u / 8, pn = u % 8;
        if (last && (pm % 34) < 2) continue;
        f32x4 mg[4][2]; ZERO_ACC(mg, 4, 2);
#pragma unroll 1
        for (int i = 0; i < 4; ++i) {
            f32x4 ag[4][2]; ZERO_ACC(ag, 4, 2);
            GSq::run(smem, [&](int r) { return hx + (size_t)(pm * 128 + r) * D; }, [&](int r) { return btg + (size_t)(i * 1024 + pn * 128 + r) * D; }, D, ag);
#pragma unroll
            for (int m = 0; m < 4; ++m)
#pragma unroll
                for (int n = 0; n < 2; ++n)
#pragma unroll
                    for (int j = 0; j < 4; ++j) ag[m][n][j] = sigmoidf_(ag[m][n][j]);
            f32x4 ab[4][2]; ZERO_ACC(ab, 4, 2);
            GSq::run(smem, [&](int r) { return outs + (size_t)(pm * 128 + r) * D + i * 256; }, [&](int r) { return btb + ((size_t)i * 1024 + pn * 128 + r) * 256; }, 256, ab);
#pragma unroll
            for (int m = 0; m < 4; ++m)
#pragma unroll
                for (int n = 0; n < 2; ++n) mg[m][n] += ag[m][n] * ab[m][n];
        }
#pragma unroll
        for (int m = 0; m < 4; ++m) {
            const int row = pm * 128 + wr * 64 + m * 16 + fr;
#pragma unroll
            for (int n = 0; n < 2; ++n) {
                const int col = pn * 128 + wc * 32 + n * 16 + fq * 4;
                u32x2 w; w[0] = pack2(mg[m][n][0], mg[m][n][1]); w[1] = pack2(mg[m][n][2], mg[m][n][3]);
                *(u32x2*)(merged + (size_t)row * D + col) = w;
            }
        }
    }
}

__device__ void ph_wout(const P& p, int l, int grp, char* smem) {
    const int tid = TID(), lane = tid & 63, wid = tid >> 6, wr = wid / 2, wc = wid % 2, fr = lane & 15, fq = lane >> 4;
    const bool last = l == NLAYER - 1;
    const bf16_t* merged = wsp<const bf16_t>(p, OFF_BIG);
    const bf16_t* bt = wsp<const bf16_t>(p, OFF_BTOUT) + (size_t)l * D * D;
    for (int u = BID(); u < (R / 256) * 8; u += gridDim.x) {
        const int pm = u / 8, pn = u % 8;
        if (last && (pm % 17) == 0) continue;
        f32x4 acc[4][4]; ZERO_ACC(acc, 4, 4);
        GBig::run(smem, [&](int i) { return merged + (size_t)(pm * 256 + i) * D; }, [&](int i) { return bt + (size_t)(pn * 128 + i) * D; }, D, acc);
#pragma unroll
        for (int m = 0; m < 4; ++m) {
            const int r = pm * 256 + wr * 64 + m * 16 + fr, bl = r / TT, pp = r % TT, b = grp * BG + bl;
            const float* src = stream_src(p, l, b, pp); float* dst = stream_dst(p, b, pp);
            const float* mod = (pp < LC ? wsp<const float>(p, OFF_MODC) + (size_t)l * 6144 : wsp<const float>(p, OFF_MODX) + ((size_t)l * NB + b) * 6144) + 2 * D;
#pragma unroll
            for (int n = 0; n < 4; ++n) {
                const int col = pn * 128 + wc * 64 + n * 16 + fq * 4;
                const f32x4 s = *(const f32x4*)(src + col), md = *(const f32x4*)(mod + col);
                *(f32x4*)(dst + col) = s + md * acc[m][n];
            }
        }
    }
}

__device__ void ph_topk(const P& p, int l, char* smem) {
    unsigned* keys = (unsigned*)smem;
    unsigned* red = keys + 4096;
    const int tid = TID(), lane = tid & 63, wid = tid >> 6;
    const bool last = l == NLAYER - 1;
    const int NU = BG * NEXP * (last ? 1 : 2);
    for (int u = BID(); u < NU; u += gridDim.x) {
        const int isctx = u >= BG * NEXP, v = isctx ? u - BG * NEXP : u, bl = v / NEXP, e = v % NEXP;
        const int L = isctx ? LC : LQ, cap = isctx ? CAPC : CAPL;
        const float* aff = wsp<const float>(p, OFF_AFF) + (isctx ? (size_t)BG * NEXP * LQ + (size_t)v * LC : (size_t)v * LQ);
        __syncthreads();
        for (int i = tid; i < 4096; i += NTHR) keys[i] = i < L ? __float_as_uint(aff[i]) : 0u;
        __syncthreads();
        unsigned my[8];
#pragma unroll
        for (int i = 0; i < 8; ++i) my[i] = keys[tid * 8 + i];
        unsigned T = 0u;
        for (int bit = 30; bit >= 0; --bit) {
            const unsigned cand = T | (1u << bit);
            int c = 0;
#pragma unroll
            for (int i = 0; i < 8; ++i) c += (my[i] >= cand) ? 1 : 0;
            c = (int)wave_sum((float)c);
            if (lane == 0) red[wid] = (unsigned)c;
            __syncthreads();
            int tot = 0;
#pragma unroll
            for (int w = 0; w < 8; ++w) tot += (int)red[w];
            __syncthreads();
            if (tot >= cap) T = cand;
        }
        int cg = 0, ce = 0;
#pragma unroll
        for (int i = 0; i < 8; ++i) { cg += (my[i] > T) ? 1 : 0; ce += (my[i] == T) ? 1 : 0; }
        unsigned pk = (unsigned)cg | ((unsigned)ce << 16), inc = pk;
#pragma unroll
        for (int o = 1; o < 64; o <<= 1) { const unsigned t = __shfl_up(inc, o); if (lane >= o) inc += t; }
        if (lane == 63) red[8 + wid] = inc;
        __syncthreads();
        unsigned base = 0u, totpk = 0u;
#pragma unroll
        for (int w = 0; w < 8; ++w) { const unsigned t = red[8 + w]; if (w < wid) base += t; totpk += t; }
        const unsigned ex = base + inc - pk;
        int rg = (int)(ex & 0xffffu), re = (int)(ex >> 16); const int G = (int)(totpk & 0xffffu);
        const int sbase = isctx ? LATS + (e * BG + bl) * CAPC : (bl * NEXP + e) * CAPL;
        int* sidx = wsp<int>(p, OFF_SIDX); float* sgv = wsp<float>(p, OFF_SGV); int* inv = wsp<int>(p, OFF_INV);
#pragma unroll
        for (int i = 0; i < 8; ++i) {
            const int tok = tid * 8 + i; int slot = -1;
            if (my[i] > T) slot = rg++;
            else if (my[i] == T) { if (G + re < cap) slot = G + re; re++; }
            if (slot >= 0 && tok < L) {
                const int r = bl * TT + (isctx ? tok : LC + tok);
                sidx[sbase + slot] = r; sgv[sbase + slot] = __uint_as_float(my[i]); inv[(size_t)r * NEXP + e] = sbase + slot;
            }
        }
    }
}

__device__ __forceinline__ int mtile_expert(int mt) { return mt < LATS / 256 ? (mt >> 1) & 15 : mt - LATS / 256; }

__device__ void ph_moe1(const P& p, int l, char* smem) {
    const int tid = TID(), lane = tid & 63, wid = tid >> 6, wr = wid / 2, wc = wid % 2, fr = lane & 15, fq = lane >> 4;
    const bool last = l == NLAYER - 1;
    const bf16_t* hx = wsp<const bf16_t>(p, OFF_HX); const int* sidx = wsp<const int>(p, OFF_SIDX);
    bf16_t* H = wsp<bf16_t>(p, OFF_BIG) + (size_t)NSLOT * D;
    const int nmt = last ? LATS / 256 : NSLOT / 256;
    for (int u = BID(); u < nmt * 16; u += gridDim.x) {
        const int mt = u / 16, pn = u % 16, e = mtile_expert(mt);
        const bf16_t* bt = wsp<const bf16_t>(p, OFF_BTW13) + ((size_t)l * NEXP + e) * 2048 * D;
        f32x4 acc[4][4]; ZERO_ACC(acc, 4, 4);
        GBig::run(smem, [&](int i) { return hx + (size_t)sidx[mt * 256 + i] * D; }, [&](int i) { return bt + (size_t)(pn * 128 + i) * D; }, D, acc);
#pragma unroll
        for (int m = 0; m < 4; ++m) {
            const int slot = mt * 256 + wr * 64 + m * 16 + fr;
#pragma unroll
            for (int n2 = 0; n2 < 2; ++n2) {
                const int col = (pn * 4 + wc * 2 + n2) * 16 + fq * 4;
                float hv[4];
#pragma unroll
                for (int j = 0; j < 4; ++j) hv[j] = siluf_(acc[m][2 * n2][j]) * acc[m][2 * n2 + 1][j];
                u32x2 w; w[0] = pack2(hv[0], hv[1]); w[1] = pack2(hv[2], hv[3]);
                *(u32x2*)(H + (size_t)slot * D + col) = w;
            }
        }
    }
}

__device__ void ph_moe2(const P& p, int l, char* smem) {
    const int tid = TID(), lane = tid & 63, wid = tid >> 6, wr = wid / 2, wc = wid % 2, fr = lane & 15, fq = lane >> 4;
    const bool last = l == NLAYER - 1;
    const bf16_t* H = wsp<const bf16_t>(p, OFF_BIG) + (size_t)NSLOT * D;
    bf16_t* Y = wsp<bf16_t>(p, OFF_BIG);
    const float* sgv = wsp<const float>(p, OFF_SGV);
    const int nmt = last ? LATS / 256 : NSLOT / 256;
    for (int u = BID(); u < nmt * 8; u += gridDim.x) {
        const int mt = u / 8, pn = u % 8, e = mtile_expert(mt);
        const bf16_t* bt = wsp<const bf16_t>(p, OFF_BTW2) + ((size_t)l * NEXP + e) * D * D;
        f32x4 acc[4][4]; ZERO_ACC(acc, 4, 4);
        GBig::run(smem, [&](int i) { return H + (size_t)(mt * 256 + i) * D; }, [&](int i) { return bt + (size_t)(pn * 128 + i) * D; }, D, acc);
#pragma unroll
        for (int m = 0; m < 4; ++m) {
            const int slot = mt * 256 + wr * 64 + m * 16 + fr; const float g = sgv[slot];
#pragma unroll
            for (int n = 0; n < 4; ++n) {
                const int col = pn * 128 + wc * 64 + n * 16 + fq * 4;
                u32x2 w; w[0] = pack2(acc[m][n][0] * g, acc[m][n][1] * g); w[1] = pack2(acc[m][n][2] * g, acc[m][n][3] * g);
                *(u32x2*)(Y + (size_t)slot * D + col) = w;
            }
        }
    }
}

__device__ void ph_combine(const P& p, int l, int grp) {
    const int tid = TID(), lane = tid & 63, wid = tid >> 6;
    const bool last = l == NLAYER - 1;
    const bf16_t* Y = wsp<const bf16_t>(p, OFF_BIG); const int* inv = wsp<const int>(p, OFF_INV);
    for (int r = BID() * 8 + wid; r < R; r += gridDim.x * 8) {
        const int bl = r / TT, pp = r % TT, b = grp * BG + bl;
        if (last && pp < LC) continue;
        float* dst = stream_dst(p, b, pp);
        const float* mod = (pp < LC ? wsp<const float>(p, OFF_MODC) + (size_t)l * 6144 : wsp<const float>(p, OFF_MODX) + ((size_t)l * NB + b) * 6144) + 5 * D;
        const int myinv = lane < NEXP ? inv[(size_t)r * NEXP + lane] : -1;
        float acc[16];
#pragma unroll
        for (int i = 0; i < 16; ++i) acc[i] = 0.f;
        for (int e = 0; e < NEXP; ++e) {
            const int s = __shfl(myinv, e);
            if (s >= 0) {
#pragma unroll
                for (int i = 0; i < 2; ++i) {
                    const u32x4 w = *(const u32x4*)(Y + (size_t)s * D + i * 512 + lane * 8);
#pragma unroll
                    for (int j = 0; j < 4; ++j) { acc[i * 8 + 2 * j] += __uint_as_float(w[j] << 16); acc[i * 8 + 2 * j + 1] += __uint_as_float(w[j] & 0xffff0000u); }
                }
            }
        }
#pragma unroll
        for (int i = 0; i < 2; ++i)
#pragma unroll
            for (int j = 0; j < 2; ++j) {
                const int c = i * 512 + lane * 8 + j * 4;
                f32x4 x = *(const f32x4*)(dst + c); const f32x4 md = *(const f32x4*)(mod + c);
#pragma unroll
                for (int q = 0; q < 4; ++q) x[q] += md[q] * acc[i * 8 + j * 4 + q];
                *(f32x4*)(dst + c) = x;
            }
    }
}

#define XB_TMO      128
#define XB_XCNT(j)  (256  + 64 * (j))
#define XB_XSUB(j)  (1280 + 64 * (j))
#define XB_XGEN(j)  (2304 + 64 * (j))
#define XB_TOP      3328
#define XB_TOPGEN   3392
#define XCD_BAR_WORDS 3456
#define XB_SPIN_CAP (1u << 18)
#define LAS __attribute__((address_space(3)))

__device__ __forceinline__ unsigned xb_ld(unsigned* p)              { return __hip_atomic_load(p, __ATOMIC_RELAXED, __HIP_MEMORY_SCOPE_AGENT); }
__device__ __forceinline__ unsigned xb_add(unsigned* p, unsigned v) { return __hip_atomic_fetch_add(p, v, __ATOMIC_RELAXED, __HIP_MEMORY_SCOPE_AGENT); }
__device__ __forceinline__ unsigned xb_xcc_id() { return (unsigned)__builtin_amdgcn_s_getreg((3 << 11) | 20) & 0xFu; }
#define XB_SPIN(cond, bar) do { unsigned _sp = 0; while (cond) { __builtin_amdgcn_s_sleep(1); \
    if ((++_sp & 255u) == 0u) { if (xb_ld(&(bar)[XB_TMO])) break; if (_sp > XB_SPIN_CAP) { atomicAdd(&(bar)[XB_TMO], 1u); break; } } } } while (0)

struct XcdBarrier {
    unsigned* bar; unsigned x;
    volatile LAS unsigned* st;
};

__device__ __forceinline__ XcdBarrier xcd_barrier_post(unsigned* bar, volatile LAS unsigned* st) {
    XcdBarrier b; b.bar = bar; b.x = xb_xcc_id(); b.st = st;
    if (threadIdx.x == 0) (void)xb_add(&bar[XB_XCNT(b.x)], 1u);
    return b;
}
__device__ __forceinline__ void xcd_barrier_complete(unsigned* bar, unsigned x, unsigned& nloc, unsigned& nx) {
    const unsigned G = gridDim.x * gridDim.y * gridDim.z;
    unsigned sum, cnt, mine, sp = 0u;
    for (;;) {
        sum = 0u; cnt = 0u; mine = 0u;
#pragma unroll
        for (unsigned j = 0; j < 16; ++j) { const unsigned c = xb_ld(&bar[XB_XCNT(j)]); sum += c; cnt += (c > 0u) ? 1u : 0u; mine = (j == x) ? c : mine; }
        if (sum == G) break;
        __builtin_amdgcn_s_sleep(1);
        if ((++sp & 255u) == 0u) { if (xb_ld(&bar[XB_TMO])) break; if (sp > XB_SPIN_CAP) { atomicAdd(&bar[XB_TMO], 1u); break; } }
    }
    nloc = mine > 0u ? mine : 1u; nx = cnt > 0u ? cnt : 1u;
}

__device__ __forceinline__ void xcd_barrier(const XcdBarrier& b) {
    asm volatile("s_waitcnt vmcnt(0)" ::: "memory");
    __syncthreads();
    if (threadIdx.x == 0) {
        unsigned* bar = b.bar;
        __builtin_amdgcn_s_waitcnt(0);
        unsigned nloc = b.st[0], nx = b.st[1];
        if (nloc == 0u) { xcd_barrier_complete(bar, b.x, nloc, nx); b.st[0] = nloc; b.st[1] = nx; }
        const unsigned old = xb_add(&bar[XB_XSUB(b.x)], 1u);
        const unsigned gen = old / nloc;
        if (old + 1u == (gen + 1u) * nloc) {
            __builtin_amdgcn_fence(__ATOMIC_RELEASE, "agent");
            asm volatile("s_waitcnt vmcnt(0)" ::: "memory");
            const unsigned og = xb_add(&bar[XB_TOP], 1u);
            const unsigned tg = og / nx;
            if (og + 1u == (tg + 1u) * nx) xb_add(&bar[XB_TOPGEN], 1u);
            else XB_SPIN(xb_ld(&bar[XB_TOPGEN]) == tg, bar);
            __builtin_amdgcn_fence(__ATOMIC_ACQUIRE, "agent");
            xb_add(&bar[XB_XGEN(b.x)], 1u);
            asm volatile("s_waitcnt vmcnt(0)" ::: "memory");
        } else {
            XB_SPIN(xb_ld(&bar[XB_XGEN(b.x)]) == gen, bar);
            __builtin_amdgcn_fence(__ATOMIC_ACQUIRE, "agent");
            asm volatile("s_waitcnt vmcnt(0)" ::: "memory");
        }
    }
    __syncthreads();
}


enum { PH_WEIGHTS, PH_MOD, PH_HFILT, PH_NORM1, PH_G1, PH_PREP, PH_RECUR, PH_ATTN, PH_HYENA, PH_GATED, PH_MERGE, PH_WOUT, PH_NORM2, PH_TOPK, PH_MOE1, PH_MOE2, PH_COMBINE };

template <int PH>
__device__ __forceinline__ void run_phase(const P& p, int l, int grp, char* smem) {
    if (PH == PH_WEIGHTS) ph_weights(p, smem);
    if (PH == PH_MOD) ph_mod(p, smem);
    if (PH == PH_HFILT) ph_hfilt(p, smem);
    if (PH == PH_NORM1) ph_norm<0>(p, l, grp, smem);
    if (PH == PH_G1) ph_g1(p, l, smem);
    if (PH == PH_PREP) { ph_attn_prep(p, l); ph_v_prep(p, smem); ph_hy_prep(p, l, smem); }
    if (PH == PH_RECUR) ph_recur(p, l, smem);
    if (PH == PH_ATTN) ph_attn(p, l, smem);
    if (PH == PH_HYENA) ph_hyena(p, l, smem);
    if (PH == PH_GATED) ph_gated(p, l);
    if (PH == PH_MERGE) ph_merge(p, l, smem);
    if (PH == PH_WOUT) ph_wout(p, l, grp, smem);
    if (PH == PH_NORM2) ph_norm<1>(p, l, grp, smem);
    if (PH == PH_TOPK) ph_topk(p, l, smem);
    if (PH == PH_MOE1) ph_moe1(p, l, smem);
    if (PH == PH_MOE2) ph_moe2(p, l, smem);
    if (PH == PH_COMBINE) ph_combine(p, l, grp);
}

#if !FUSED
template <int PH>
__global__ void __launch_bounds__(NTHR, 2) k_phase(P p, int l, int grp) {
    extern __shared__ __attribute__((aligned(16))) char smem[];
    run_phase<PH>(p, l, grp, smem);
}

template <int PH>
static void launch_phase(const P& p, int l, int grp, int grid, hipStream_t stream) {
    static bool attr = false;
    if (!attr) { (void)hipFuncSetAttribute((const void*)k_phase<PH>, hipFuncAttributeMaxDynamicSharedMemorySize, SMEM_BYTES); attr = true; }
    k_phase<PH><<<grid, NTHR, SMEM_BYTES, stream>>>(p, l, grp);
}
#endif


#define GRID_SYNC() xcd_barrier(bar)
__global__ void __launch_bounds__(NTHR, 2) k_fused(P p) {
    extern __shared__ __attribute__((aligned(16))) char smem[];
    volatile LAS unsigned* xbw = (volatile LAS unsigned*)(smem + SMEM_BYTES);
    if (threadIdx.x == 0) { xbw[0] = 0u; xbw[1] = 0u; xbw[2] = 0u; xbw[3] = 0u; }
    __syncthreads();
    XcdBarrier bar = xcd_barrier_post(wsp<unsigned>(p, OFF_BAR), xbw);
    ph_weights(p, smem);
    ph_mod(p, smem);
    ph_hfilt(p, smem);
    GRID_SYNC();
    ph_hcopies(p);
#pragma unroll 1
    for (int grp = 0; grp < NGRP; ++grp) {
#pragma unroll 1
        for (int l = 0; l < NLAYER; ++l) {
            ph_norm<0>(p, l, grp, smem); GRID_SYNC();
            ph_g1(p, l, smem); GRID_SYNC();
            ph_attn_prep(p, l); ph_v_prep(p, smem); ph_hy_prep(p, l, smem); GRID_SYNC();
            ph_recur(p, l, smem); ph_attn(p, l, smem); ph_hyena(p, l, smem); GRID_SYNC();
            ph_gated(p, l); GRID_SYNC();
            ph_merge(p, l, smem); GRID_SYNC();
            ph_wout(p, l, grp, smem); GRID_SYNC();
            ph_norm<1>(p, l, grp, smem); GRID_SYNC();
            ph_topk(p, l, smem); GRID_SYNC();
            ph_moe1(p, l, smem); GRID_SYNC();
            ph_moe2(p, l, smem); GRID_SYNC();
            ph_combine(p, l, grp); GRID_SYNC();
        }
    }
}

extern "C" void kernel_launch(void* const* d_in, const int* in_sizes, int n_in, void* d_out, int out_size, void* d_ws, size_t ws_size, hipStream_t stream) {
    P p{};
    for (int i = 0; i < 33; ++i) p.in[i] = (const float*)d_in[i];
    p.out = (float*)d_out; p.ws = (char*)d_ws;
#if FUSED
    static int grid = 0;
    if (!grid) {
        int dev = 0, cus = 0, per_cu = 0;
        (void)hipGetDevice(&dev);
        (void)hipDeviceGetAttribute(&cus, hipDeviceAttributeMultiprocessorCount, dev);
        (void)hipFuncSetAttribute((const void*)k_fused, hipFuncAttributeMaxDynamicSharedMemorySize, SMEM_BYTES + 16);
        (void)hipOccupancyMaxActiveBlocksPerMultiprocessor(&per_cu, k_fused, NTHR, SMEM_BYTES + 16);
        grid = cus * (per_cu < 1 ? per_cu : 1);
        if (grid <= 0) grid = 256;
    }
    (void)hipMemsetAsync(d_ws, 0, XCD_BAR_WORDS * sizeof(unsigned), stream);
    k_fused<<<grid, NTHR, SMEM_BYTES + 16, stream>>>(p);
#else
    const int grid = 256;
    launch_phase<PH_WEIGHTS>(p, 0, 0, grid, stream);
    launch_phase<PH_MOD>(p, 0, 0, grid, stream);
    launch_phase<PH_HFILT>(p, 0, 0, grid, stream);
    for (int grp = 0; grp < NGRP; ++grp)
        for (int l = 0; l < NLAYER; ++l) {
            launch_phase<PH_NORM1>(p, l, grp, grid, stream);
            launch_phase<PH_G1>(p, l, grp, grid, stream);
            launch_phase<PH_PREP>(p, l, grp, grid, stream);
            launch_phase<PH_RECUR>(p, l, grp, grid, stream);
            launch_phase<PH_ATTN>(p, l, grp, grid, stream);
            launch_phase<PH_HYENA>(p, l, grp, grid, stream);
            launch_phase<PH_GATED>(p, l, grp, grid, stream);
            launch_phase<PH_MERGE>(p, l, grp, grid, stream);
            launch_phase<PH_WOUT>(p, l, grp, grid, stream);
            launch_phase<PH_NORM2>(p, l, grp, grid, stream);
            launch_phase<PH_TOPK>(p, l, grp, grid, stream);
            launch_phase<PH_MOE1>(p, l, grp, grid, stream);
            launch_phase<PH_MOE2>(p, l, grp, grid, stream);
            launch_phase<PH_COMBINE>(p, l, grp, grid, stream);
        }
#endif
}
```

```cpp
#include <hip/hip_runtime.h>
#include <stdint.h>

#ifndef FUSED
#define FUSED 1
#endif

typedef unsigned short bf16_t;
typedef short bf16x8 __attribute__((ext_vector_type(8)));
typedef float f32x4 __attribute__((ext_vector_type(4)));
typedef unsigned u32x4 __attribute__((ext_vector_type(4)));
typedef unsigned u32x2 __attribute__((ext_vector_type(2)));

#define NTHR 512
constexpr int D = 1024, NB = 16, LQ = 4096, LC = 256, TT = 4352, NLAYER = 2;
constexpr int BG = 8, NGRP = NB / BG, R = BG * TT;
constexpr int NP1 = 3840;
constexpr int C_GQ = 0, C_GK = 128, C_GV = 256, C_GAF = 512, C_GAB = 528, C_GG = 544, C_HY = 800, C_HQ = 1568, C_HFF = 1824, C_HFB = 2080,
              C_HI = 2336, C_HGG = 2592, C_DQ = 2848, C_DK = 3104, C_DV = 3360, C_MG = 3616, N_IN = 7712;
constexpr int NEXP = 16, CAPL = 512, CAPC = 32, LATS = BG * NEXP * CAPL, NSLOT = LATS + BG * NEXP * CAPC;
constexpr int SMEM_BYTES = 132096;
constexpr int HY_UB = 8224, HY_HSTR = 8256, HY_NS = 515, HY_U_BYTES = 8 * HY_UB, HY_Z_OFF = HY_U_BYTES + 8 * HY_HSTR;
static_assert(HY_Z_OFF + 64 <= SMEM_BYTES, "hyena lds");

constexpr size_t al256(size_t x) { return (x + 255) & ~(size_t)255; }
constexpr size_t OFF_BAR = 0;
constexpr size_t OFF_BTIN1 = 65536;
constexpr size_t OFF_BTGATE = OFF_BTIN1 + (size_t)NLAYER * NP1 * D * 2;
constexpr size_t OFF_BTBR = OFF_BTGATE + (size_t)NLAYER * 4096 * D * 2;
constexpr size_t OFF_BTOUT = OFF_BTBR + (size_t)NLAYER * 4 * 1024 * 256 * 2;
constexpr size_t OFF_BTW13 = OFF_BTOUT + (size_t)NLAYER * D * D * 2;
constexpr size_t OFF_BTW2 = OFF_BTW13 + (size_t)NLAYER * NEXP * 2048 * D * 2;
constexpr size_t OFF_MODX = OFF_BTW2 + (size_t)NLAYER * NEXP * D * D * 2;
constexpr size_t OFF_MODC = OFF_MODX + (size_t)NLAYER * NB * 6144 * 4;
constexpr size_t OFF_HRAW = OFF_MODC + (size_t)NLAYER * 6144 * 4;
constexpr size_t HRAW_L = (size_t)512 * (LQ + LC);
constexpr size_t OFF_PSUM = OFF_HRAW + (size_t)NLAYER * HRAW_L * 4;
constexpr size_t OFF_XC = OFF_PSUM + (size_t)NLAYER * 68 * 512 * 4;
constexpr size_t OFF_HX = OFF_XC + (size_t)NB * LC * D * 4;
constexpr size_t OFF_BIG = OFF_HX + (size_t)R * D * 2;
constexpr size_t BIG_BYTES = (size_t)2 * NSLOT * D * 2;
constexpr size_t OFF_OUTS = OFF_BIG + BIG_BYTES;
constexpr size_t OFF_QA = OFF_OUTS + (size_t)R * D * 2;
constexpr size_t OFF_KA = OFF_QA + (size_t)BG * 4 * TT * 64 * 2;
constexpr size_t OFF_VA = OFF_KA + (size_t)BG * 4 * TT * 64 * 2;
constexpr size_t OFF_OBUF = OFF_VA + (size_t)BG * 4 * TT * 64 * 2;
constexpr size_t OFF_HYT = OFF_OBUF + (size_t)4 * R * 256 * 4;
constexpr size_t OFF_AFF = OFF_HYT + (size_t)BG * 768 * TT * 2;
constexpr size_t OFF_INV = OFF_AFF + (size_t)BG * NEXP * TT * 4;
constexpr size_t OFF_SIDX = OFF_INV + (size_t)R * NEXP * 4;
constexpr size_t OFF_SGV = OFF_SIDX + (size_t)NSLOT * 4;
constexpr size_t OFF_HCOP = OFF_SGV + (size_t)NSLOT * 4;
constexpr size_t WS_END = OFF_HCOP + (size_t)NLAYER * 512 * 8 * HY_HSTR;
static_assert(WS_END < (size_t)1020 * 1024 * 1024, "workspace too big");
static_assert(BIG_BYTES >= (size_t)R * NP1 * 2, "big region");

struct P {
    const float* in[33];
    float* out;
    char* ws;
};

__device__ __forceinline__ bf16_t f2bf(float f) { unsigned u = __float_as_uint(f); u += 0x7fffu + ((u >> 16) & 1u); return (bf16_t)(u >> 16); }
__device__ __forceinline__ float bf2f(bf16_t h) { return __uint_as_float((unsigned)h << 16); }
typedef float f32x2 __attribute__((ext_vector_type(2)));
typedef __bf16 bf16x2_t __attribute__((ext_vector_type(2)));
__device__ __forceinline__ unsigned cvt_pk_bf16(float lo, float hi) { const f32x2 v = {lo, hi}; return __builtin_bit_cast(unsigned, __builtin_convertvector(v, bf16x2_t)); }
__device__ __forceinline__ unsigned pack2(float a, float b) { return cvt_pk_bf16(a, b); }
__device__ __forceinline__ float sigmoidf_(float x) { return 1.0f / (1.0f + __expf(-x)); }
__device__ __forceinline__ float siluf_(float x) { return x / (1.0f + __expf(-x)); }
__device__ __forceinline__ float wave_sum(float v) {
#pragma unroll
    for (int o = 32; o > 0; o >>= 1) v += __shfl_xor(v, o);
    return v;
}

template <class T> __device__ __forceinline__ T* wsp(const P& p, size_t off) { return (T*)(p.ws + off); }

__device__ __forceinline__ const float* stream_src(const P& p, int l, int b, int pp) {
    if (pp < LC) return (l == 0 ? p.in[2] : wsp<const float>(p, OFF_XC)) + ((size_t)b * LC + pp) * D;
    return (l == 0 ? p.in[0] : (const float*)p.out) + ((size_t)b * LQ + (pp - LC)) * D;
}
__device__ __forceinline__ float* stream_dst(const P& p, int b, int pp) {
    if (pp < LC) return wsp<float>(p, OFF_XC) + ((size_t)b * LC + pp) * D;
    return p.out + ((size_t)b * LQ + (pp - LC)) * D;
}

__device__ __forceinline__ int TID() { int t = threadIdx.x; asm volatile("" : "+v"(t)); return t; }
__device__ __forceinline__ int BID() { int t = blockIdx.x; asm volatile("" : "+s"(t)); return t; }

__device__ void xpose_job(const float* __restrict__ src, int ldS, int K, int N, bf16_t* __restrict__ dst, int mode, int which, float* tile) {
    const int tid = TID();
    const int tk = K / 64, tn = (N + 63) / 64, nt = tk * tn;
    for (int t = BID(); t < nt; t += gridDim.x) {
        const int k0 = (t % tk) * 64, n0 = (t / tk) * 64;
        __syncthreads();
#pragma unroll
        for (int ps = 0; ps < 2; ++ps) {
            const int i = (tid >> 4) + 32 * ps, j4 = (tid & 15) * 4;
            f32x4 v = {0.f, 0.f, 0.f, 0.f};
            if (n0 + j4 < N) v = *(const f32x4*)(src + (size_t)(k0 + i) * ldS + n0 + j4);
            tile[i * 65 + j4 + 0] = v[0]; tile[i * 65 + j4 + 1] = v[1]; tile[i * 65 + j4 + 2] = v[2]; tile[i * 65 + j4 + 3] = v[3];
        }
        __syncthreads();
        const int n = tid >> 3, kc = (tid & 7) * 8;
        if (n0 + n < N) {
            const int ng = n0 + n;
            const int drow = mode == 0 ? ng : ((ng >> 4) * 32 + which * 16 + (ng & 15));
            u32x4 w;
            w[0] = pack2(tile[(kc + 0) * 65 + n], tile[(kc + 1) * 65 + n]);
            w[1] = pack2(tile[(kc + 2) * 65 + n], tile[(kc + 3) * 65 + n]);
            w[2] = pack2(tile[(kc + 4) * 65 + n], tile[(kc + 5) * 65 + n]);
            w[3] = pack2(tile[(kc + 6) * 65 + n], tile[(kc + 7) * 65 + n]);
            *(u32x4*)(dst + (size_t)drow * K + k0 + kc) = w;
        }
    }
}

__device__ void ph_weights(const P& p, char* smem) {
    float* tile = (float*)smem;
    for (int l = 0; l < NLAYER; ++l) {
        const float* win = p.in[8] + (size_t)l * D * N_IN;
        bf16_t* bt1 = wsp<bf16_t>(p, OFF_BTIN1) + (size_t)l * NP1 * D;
        xpose_job(win, N_IN, D, C_MG, bt1, 0, 0, tile);
        for (size_t i = (size_t)BID() * NTHR + TID(); i < (size_t)(NP1 - C_MG) * D / 8; i += (size_t)gridDim.x * NTHR)
            *(u32x4*)(bt1 + (size_t)C_MG * D + i * 8) = (u32x4){0u, 0u, 0u, 0u};
        xpose_job(win + C_MG, N_IN, D, 4096, wsp<bf16_t>(p, OFF_BTGATE) + (size_t)l * 4096 * D, 0, 0, tile);
        for (int i = 0; i < 4; ++i)
            xpose_job(p.in[27] + ((size_t)l * 4 + i) * 256 * D, D, 256, D, wsp<bf16_t>(p, OFF_BTBR) + ((size_t)l * 4 + i) * 1024 * 256, 0, 0, tile);
        xpose_job(p.in[28] + (size_t)l * D * D, D, D, D, wsp<bf16_t>(p, OFF_BTOUT) + (size_t)l * D * D, 0, 0, tile);
        for (int e = 0; e < NEXP; ++e) {
            const size_t le = (size_t)l * NEXP + e;
            xpose_job(p.in[30] + le * D * D, D, D, D, wsp<bf16_t>(p, OFF_BTW13) + le * 2048 * D, 1, 0, tile);
            xpose_job(p.in[31] + le * D * D, D, D, D, wsp<bf16_t>(p, OFF_BTW13) + le * 2048 * D, 1, 1, tile);
            xpose_job(p.in[32] + le * D * D, D, D, D, wsp<bf16_t>(p, OFF_BTW2) + le * D * D, 0, 0, tile);
        }
    }
}

__device__ void ph_mod(const P& p, char* smem) {
    float* s = (float*)smem;
    float* red = s + 17 * 1024;
    const int tid = TID();
    for (int i = tid; i < 17 * 1024; i += NTHR) { const float v = i < 16384 ? p.in[1][i] : p.in[3][i - 16384]; s[i] = siluf_(v); }
    __syncthreads();
    for (int u = BID(); u < NLAYER * 96; u += gridDim.x) {
        const int l = u / 96, col = (u % 96) * 64 + (tid & 63), ks = tid >> 6;
        const float* w = p.in[4] + (size_t)l * D * 6144 + col;
        float acc[17];
#pragma unroll
        for (int r = 0; r < 17; ++r) acc[r] = 0.f;
        for (int k = ks * 128; k < ks * 128 + 128; ++k) {
            const float wv = w[(size_t)k * 6144];
#pragma unroll
            for (int r = 0; r < 17; ++r) acc[r] += s[r * 1024 + k] * wv;
        }
#pragma unroll
        for (int r = 0; r < 17; ++r) red[(ks * 17 + r) * 64 + (tid & 63)] = acc[r];
        __syncthreads();
        for (int i = tid; i < 17 * 64; i += NTHR) {
            const int r = i / 64, c = i % 64, cg = (u % 96) * 64 + c;
            float v = p.in[5][(size_t)l * 6144 + cg];
#pragma unroll
            for (int q = 0; q < 8; ++q) v += red[(q * 17 + r) * 64 + c];
            if (r < 16) wsp<float>(p, OFF_MODX)[((size_t)l * NB + r) * 6144 + cg] = v;
            else wsp<float>(p, OFF_MODC)[(size_t)l * 6144 + cg] = v;
        }
        __syncthreads();
    }
}

__device__ void ph_hfilt(const P& p, char* smem) {
    float* feats = (float*)smem;
    float* h1 = feats + 64 * 33;
    float* h2 = h1 + 64 * 64;
    const int tid = TID();
    for (int u = BID(); u < NLAYER * 68; u += gridDim.x) {
        const int l = u / 68, ub = u % 68, w = ub >= 64 ? 1 : 0, jb = w ? ub - 64 : ub, L = w ? LC : LQ;
        __syncthreads();
        for (int i = tid; i < 64 * 33; i += NTHR) {
            const int pos = i / 33, fi = i % 33; const float j = (float)(jb * 64 + pos);
            float v;
            if (fi == 0) v = j / (float)(L - 1);
            else {
                const int k = (fi - 1) & 15; const float f = 1e-4f + (float)k * ((15.0f - 1e-4f) / 15.0f);
                const float wv = 6.283185307179586f * j / (float)L;
                v = fi <= 16 ? cosf(wv * f) : -sinf(wv * f);
            }
            feats[i] = v;
        }
        __syncthreads();
        const float* w1 = p.in[13] + (size_t)l * 33 * 64; const float* b1 = p.in[14] + l * 64;
        const float* w2 = p.in[15] + (size_t)l * 64 * 64; const float* b2 = p.in[16] + l * 64;
        const float* w3 = p.in[17] + (size_t)l * 64 * 512; const float* fr = p.in[18] + l * 128;
        for (int i = tid; i < 64 * 64; i += NTHR) {
            const int pos = i >> 6, k = i & 63; float a = b1[k];
            for (int f = 0; f < 33; ++f) a += feats[pos * 33 + f] * w1[f * 64 + k];
            h1[i] = sinf(fr[k] * a);
        }
        __syncthreads();
        for (int i = tid; i < 64 * 64; i += NTHR) {
            const int pos = i >> 6, k = i & 63; float a = b2[k];
            for (int f = 0; f < 64; ++f) a += h1[pos * 64 + f] * w2[f * 64 + k];
            h2[i] = sinf(fr[64 + k] * a);
        }
        __syncthreads();
        {
            const int n = tid; float asum = 0.f;
            const float dec = fabsf(p.in[19][(size_t)l * 512 + n]);
            float* hr = wsp<float>(p, OFF_HRAW) + (size_t)l * HRAW_L + (w ? (size_t)512 * LQ : 0) + (size_t)n * L + jb * 64;
            for (int pos = 0; pos < 64; ++pos) {
                float a = 0.f;
                for (int k = 0; k < 64; ++k) a += h2[pos * 64 + k] * w3[k * 512 + n];
                const int j = jb * 64 + pos; const float dist = fabsf((float)(j - L / 2)) / (float)(L / 2);
                a *= __expf(-dist * dec) + 0.05f;
                hr[pos] = a; asum += fabsf(a);
            }
            wsp<float>(p, OFF_PSUM)[((size_t)l * 68 + ub) * 512 + n] = asum;
        }
    }
}

template <int WHICH>
__device__ void ph_norm(const P& p, int l, int grp, char* smem) {
    const int tid = TID(), lane = tid & 63, wid = tid >> 6;
    float* rt = (float*)smem;
    if (WHICH == 1) {
        const float* rsrc = p.in[29] + (size_t)l * D * NEXP;
        for (int i = tid; i < D * NEXP / 4; i += NTHR) ((f32x4*)rt)[i] = ((const f32x4*)rsrc)[i];
        __syncthreads();
    }
    const float* gain = p.in[WHICH ? 7 : 6] + (size_t)l * D;
    bf16_t* hx = wsp<bf16_t>(p, OFF_HX);
    for (int r = BID() * 8 + wid; r < R; r += gridDim.x * 8) {
        const int bl = r / TT, pp = r % TT, b = grp * BG + bl; const bool isctx = pp < LC;
        if (WHICH == 1 && l == NLAYER - 1 && isctx) continue;
        const float* src = WHICH == 0 ? stream_src(p, l, b, pp) : (const float*)stream_dst(p, b, pp);
        const float* mod = isctx ? wsp<const float>(p, OFF_MODC) + (size_t)l * 6144 : wsp<const float>(p, OFF_MODX) + ((size_t)l * NB + b) * 6144;
        const float* shp = mod + (WHICH ? 3 : 0) * D; const float* scp = mod + (WHICH ? 4 : 1) * D;
        f32x4 x[4]; float ss = 0.f;
#pragma unroll
        for (int i = 0; i < 4; ++i) { x[i] = *(const f32x4*)(src + i * 256 + lane * 4); ss += x[i][0] * x[i][0] + x[i][1] * x[i][1] + x[i][2] * x[i][2] + x[i][3] * x[i][3]; }
        ss = wave_sum(ss);
        const float rs = rsqrtf(ss * (1.0f / D) + 1e-6f);
        float lg[NEXP];
#pragma unroll
        for (int e = 0; e < NEXP; ++e) lg[e] = 0.f;
#pragma unroll
        for (int i = 0; i < 4; ++i) {
            const int c = i * 256 + lane * 4;
            const f32x4 g = *(const f32x4*)(gain + c), sh = *(const f32x4*)(shp + c), sc = *(const f32x4*)(scp + c);
            f32x4 y;
#pragma unroll
            for (int j = 0; j < 4; ++j) y[j] = x[i][j] * rs * g[j] * (1.0f + sc[j]) + sh[j];
            u32x2 w; w[0] = pack2(y[0], y[1]); w[1] = pack2(y[2], y[3]);
            *(u32x2*)(hx + (size_t)r * D + c) = w;
            if (WHICH == 1) {
#pragma unroll
                for (int j = 0; j < 4; ++j) {
#pragma unroll
                    for (int e4 = 0; e4 < 4; ++e4) { const f32x4 rv = *(const f32x4*)(rt + (c + j) * NEXP + e4 * 4);
                        lg[e4 * 4 + 0] += y[j] * rv[0]; lg[e4 * 4 + 1] += y[j] * rv[1]; lg[e4 * 4 + 2] += y[j] * rv[2]; lg[e4 * 4 + 3] += y[j] * rv[3]; }
                }
            }
        }
        if (WHICH == 1) {
            float mx = -1e30f;
#pragma unroll
            for (int e = 0; e < NEXP; ++e) { lg[e] = wave_sum(lg[e]); mx = fmaxf(mx, lg[e]); }
            float sum = 0.f, mine = 0.f;
#pragma unroll
            for (int e = 0; e < NEXP; ++e) { const float ev = __expf(lg[e] - mx); sum += ev; mine = (lane == e) ? ev : mine; }
            if (lane < NEXP) {
                float* aff = wsp<float>(p, OFF_AFF);
                if (isctx) aff[(size_t)BG * NEXP * LQ + ((size_t)bl * NEXP + lane) * LC + pp] = mine / sum;
                else aff[((size_t)bl * NEXP + lane) * LQ + (pp - LC)] = mine / sum;
                wsp<int>(p, OFF_INV)[(size_t)r * NEXP + lane] = -1;
            }
        }
    }
}

template <int WR, int WC, int MT, int NT>
struct GC {
    static constexpr int BM = WR * MT * 16, BN = WC * NT * 16, ROWB = 160;
    static constexpr int A_BYTES = BM * ROWB, B_BYTES = BN * ROWB, STAGE = A_BYTES + B_BYTES;
    static constexpr int A_CH = BM * 8 / NTHR, B_CH = BN * 8 / NTHR;
    static_assert(2 * STAGE <= SMEM_BYTES, "lds");
    template <class AR, class BR>
    static __device__ __forceinline__ void run(char* smem, AR arow, BR brow, int K, f32x4 (&acc)[MT][NT]) {
        const int tid = TID(), lane = tid & 63, wid = tid >> 6, wr = wid / WC, wc = wid % WC, fr = lane & 15, fq = lane >> 4;
        const bf16_t* ap[A_CH]; const bf16_t* bp[B_CH]; int aoff[A_CH], boff[B_CH];
#pragma unroll
        for (int i = 0; i < A_CH; ++i) { const int c = tid + NTHR * i, row = c >> 3, kc = c & 7; ap[i] = arow(row) + kc * 8; aoff[i] = row * ROWB + kc * 16; }
#pragma unroll
        for (int i = 0; i < B_CH; ++i) { const int c = tid + NTHR * i, row = c >> 3, kc = c & 7; bp[i] = brow(row) + kc * 8; boff[i] = A_BYTES + row * ROWB + kc * 16; }
        u32x4 ra[A_CH], rb[B_CH];
        const int nk = K / 64;
#pragma unroll
        for (int i = 0; i < A_CH; ++i) ra[i] = *(const u32x4*)(ap[i]);
#pragma unroll
        for (int i = 0; i < B_CH; ++i) rb[i] = *(const u32x4*)(bp[i]);
        __syncthreads();
#pragma unroll
        for (int i = 0; i < A_CH; ++i) *(u32x4*)(smem + aoff[i]) = ra[i];
#pragma unroll
        for (int i = 0; i < B_CH; ++i) *(u32x4*)(smem + boff[i]) = rb[i];
        __syncthreads();
        for (int kt = 0; kt < nk; ++kt) {
            const char* cur = smem + (kt & 1) * STAGE; char* nxt = smem + ((kt + 1) & 1) * STAGE;
            if (kt + 1 < nk) {
#pragma unroll
                for (int i = 0; i < A_CH; ++i) ra[i] = *(const u32x4*)(ap[i] + (kt + 1) * 64);
#pragma unroll
                for (int i = 0; i < B_CH; ++i) rb[i] = *(const u32x4*)(bp[i] + (kt + 1) * 64);
            }
#pragma unroll
            for (int kk = 0; kk < 2; ++kk) {
                bf16x8 af[MT], bfr[NT];
#pragma unroll
                for (int m = 0; m < MT; ++m) af[m] = *(const bf16x8*)(cur + (wr * MT * 16 + m * 16 + fr) * ROWB + kk * 64 + fq * 16);
#pragma unroll
                for (int n = 0; n < NT; ++n) bfr[n] = *(const bf16x8*)(cur + A_BYTES + (wc * NT * 16 + n * 16 + fr) * ROWB + kk * 64 + fq * 16);
#pragma unroll
                for (int m = 0; m < MT; ++m)
#pragma unroll
                    for (int n = 0; n < NT; ++n) acc[m][n] = __builtin_amdgcn_mfma_f32_16x16x32_bf16(bfr[n], af[m], acc[m][n], 0, 0, 0);
            }
            if (kt + 1 < nk) {
#pragma unroll
                for (int i = 0; i < A_CH; ++i) *(u32x4*)(nxt + aoff[i]) = ra[i];
#pragma unroll
                for (int i = 0; i < B_CH; ++i) *(u32x4*)(nxt + boff[i]) = rb[i];
            }
            __syncthreads();
        }
    }
};
typedef GC<4, 2, 4, 4> GBig;
typedef GC<2, 4, 4, 2> GSq;

#define ZERO_ACC(acc, MT, NT) _Pragma("unroll") for (int _m = 0; _m < MT; ++_m) _Pragma("unroll") for (int _n = 0; _n < NT; ++_n) acc[_m][_n] = (f32x4){0.f, 0.f, 0.f, 0.f}

__device__ void ph_g1(const P& p, int l, char* smem) {
    const int tid = TID(), lane = tid & 63, wid = tid >> 6, wr = wid / 2, wc = wid % 2, fr = lane & 15, fq = lane >> 4;
    const bf16_t* hx = wsp<const bf16_t>(p, OFF_HX);
    const bf16_t* bt = wsp<const bf16_t>(p, OFF_BTIN1) + (size_t)l * NP1 * D;
    bf16_t* proj = wsp<bf16_t>(p, OFF_BIG);
    constexpr int NPN = NP1 / 128;
    for (int u = BID(); u < (R / 256) * NPN; u += gridDim.x) {
        const int pm = u / NPN, pn = u % NPN;
        f32x4 acc[4][4]; ZERO_ACC(acc, 4, 4);
        GBig::run(smem, [&](int i) { return hx + (size_t)(pm * 256 + i) * D; }, [&](int i) { return bt + (size_t)(pn * 128 + i) * D; }, D, acc);
#pragma unroll
        for (int m = 0; m < 4; ++m) {
            const int row = pm * 256 + wr * 64 + m * 16 + fr;
#pragma unroll
            for (int n = 0; n < 4; ++n) {
                const int col = pn * 128 + wc * 64 + n * 16 + fq * 4;
                u32x2 w; w[0] = pack2(acc[m][n][0], acc[m][n][1]); w[1] = pack2(acc[m][n][2], acc[m][n][3]);
                *(u32x2*)(proj + (size_t)row * NP1 + col) = w;
            }
        }
    }
}

__device__ void ph_attn_prep(const P& p, int l) {
    const int tid = TID(), lane = tid & 63, wid = tid >> 6;
    const bf16_t* proj = wsp<const bf16_t>(p, OFF_BIG);
    bf16_t* Qa = wsp<bf16_t>(p, OFF_QA); bf16_t* Ka = wsp<bf16_t>(p, OFF_KA);
    const int j = lane & 7, d0 = j * 4;
    const float* gq = p.in[23] + l * 32; const float* gk = p.in[24] + l * 32;
    for (int r = BID() * 8 + wid; r < R; r += gridDim.x * 8) {
        const int bl = r / TT, pp = r % TT; const bool lat = pp >= LC; const int t = pp - LC;
        const int h = lane >> 4;
        float cs[4], sn[4];
        if (lat) {
            const float pos = (float)((j < 4) ? (t >> 6) : (t & 63));
#pragma unroll
            for (int c = 0; c < 4; ++c) { const int i = (j & 1) * 4 + c; const float fq_ = exp2f(-(float)i * (13.287712379549449f / 8.0f)); sincosf(pos * fq_, &sn[c], &cs[c]); }
        }
#pragma unroll
        for (int which = 0; which < 2; ++which) {
            const u32x2 raw = *(const u32x2*)(proj + (size_t)r * NP1 + (which ? C_DK : C_DQ) + lane * 4);
            float v[4] = {bf2f((bf16_t)(raw[0] & 0xffff)), bf2f((bf16_t)(raw[0] >> 16)), bf2f((bf16_t)(raw[1] & 0xffff)), bf2f((bf16_t)(raw[1] >> 16))};
            float ss = v[0] * v[0] + v[1] * v[1] + v[2] * v[2] + v[3] * v[3];
            ss += __shfl_xor(ss, 1); ss += __shfl_xor(ss, 2); ss += __shfl_xor(ss, 4);
            const float rs = rsqrtf(ss * (1.0f / 32.0f) + 1e-6f);
            const float* g = which ? gk : gq;
#pragma unroll
            for (int c = 0; c < 4; ++c) v[c] = v[c] * rs * g[d0 + c];
            if (lat) {
#pragma unroll
                for (int c = 0; c < 4; ++c) {
                    const float o = __shfl_xor(v[c], 2);
                    v[c] = (j & 2) ? (o * sn[c] + v[c] * cs[c]) : (v[c] * cs[c] - o * sn[c]);
                }
            }
            if (!which) {
#pragma unroll
                for (int c = 0; c < 4; ++c) v[c] *= 0.17677669529663687f * 1.4426950408889634f;
            }
            u32x2 w; w[0] = pack2(v[0], v[1]); w[1] = pack2(v[2], v[3]);
            *(u32x2*)((which ? Ka : Qa) + (((size_t)bl * 4 + h) * TT + pp) * 64 + (lane & 15) * 4) = w;
        }
    }
}

__device__ void ph_v_prep(const P& p, char* smem) {
    bf16_t* tile = (bf16_t*)smem;
    const int tid = TID();
    const bf16_t* proj = wsp<const bf16_t>(p, OFF_BIG);
    bf16_t* Vt = wsp<bf16_t>(p, OFF_VA);
    constexpr int NTT = TT / 64;
    for (int u = BID(); u < BG * NTT * 4; u += gridDim.x) {
        const int h = u & 3, tt = (u >> 2) % NTT, bl = u / (4 * NTT);
        __syncthreads();
        {
            const int tok = tid >> 3, c8 = (tid & 7) * 8;
            *(u32x4*)(tile + tok * 72 + c8) = *(const u32x4*)(proj + (size_t)(bl * TT + tt * 64 + tok) * NP1 + C_DV + h * 64 + c8);
        }
        __syncthreads();
        const int dv = tid >> 3, t8 = (tid & 7) * 8;
        u32x4 w;
#pragma unroll
        for (int j = 0; j < 4; ++j) w[j] = (unsigned)tile[(t8 + 2 * j) * 72 + dv] | ((unsigned)tile[(t8 + 2 * j + 1) * 72 + dv] << 16);
        *(u32x4*)(Vt + (((size_t)bl * 4 + h) * 64 + dv) * TT + tt * 64 + t8) = w;
    }
}

__device__ void ph_hy_prep(const P& p, int l, char* smem) {
    float* tile = (float*)smem;
    const int tid = TID();
    const bf16_t* proj = wsp<const bf16_t>(p, OFF_BIG);
    bf16_t* hyT = wsp<bf16_t>(p, OFF_HYT);
    const float* cw = p.in[12] + (size_t)l * 3 * 768;
    constexpr int NTT = TT / 64;
    for (int u = BID(); u < BG * NTT * 12; u += gridDim.x) {
        const int ct = u % 12, tt = (u / 12) % NTT, bl = u / (12 * NTT);
        const int p0 = tt * 64; const bool lat = p0 >= LC; const int seg0 = lat ? LC : 0, segL = lat ? LQ : LC;
        __syncthreads();
        for (int i = tid; i < 66 * 16; i += NTHR) {
            const int rr = i >> 4, c4 = (i & 15) * 4; const int pp = p0 - 1 + rr;
            float v[4] = {0.f, 0.f, 0.f, 0.f};
            if (pp >= seg0 && pp < seg0 + segL) {
                const u32x2 raw = *(const u32x2*)(proj + (size_t)(bl * TT + pp) * NP1 + C_HY + ct * 64 + c4);
                v[0] = bf2f((bf16_t)(raw[0] & 0xffff)); v[1] = bf2f((bf16_t)(raw[0] >> 16)); v[2] = bf2f((bf16_t)(raw[1] & 0xffff)); v[3] = bf2f((bf16_t)(raw[1] >> 16));
            }
            tile[rr * 65 + c4] = v[0]; tile[rr * 65 + c4 + 1] = v[1]; tile[rr * 65 + c4 + 2] = v[2]; tile[rr * 65 + c4 + 3] = v[3];
        }
        __syncthreads();
        const int ch = tid >> 3, t8 = (tid & 7) * 8, cg = ct * 64 + ch;
        const float w0 = cw[cg], w1 = cw[768 + cg], w2 = cw[1536 + cg];
        float o[8];
#pragma unroll
        for (int q = 0; q < 8; ++q) { const int rr = t8 + q + 1; o[q] = tile[(rr - 1) * 65 + ch] * w0 + tile[rr * 65 + ch] * w1 + tile[(rr + 1) * 65 + ch] * w2; }
        bf16_t* dst = lat ? hyT + ((size_t)bl * 768 + cg) * LQ + (p0 - LC) + t8 : hyT + (size_t)BG * 768 * LQ + ((size_t)bl * 768 + cg) * LC + p0 + t8;
        u32x4 w; w[0] = pack2(o[0], o[1]); w[1] = pack2(o[2], o[3]); w[2] = pack2(o[4], o[5]); w[3] = pack2(o[6], o[7]);
        *(u32x4*)dst = w;
    }
}

template <int DK>
__device__ void recur_unit(const P& p, int l, int bl, int h, int br, int dir, char* smem) {
    constexpr int DPL = DK / 8;
    float* qS = (float*)smem;
    float* kS = qS + 64 * DK;
    float* gS = kS + 64 * DK;
    float* vS = gS + 64 * DK;
    float* oS = vS + 64 * 64;
    const int tid = TID(), lane = tid & 63, wid = tid >> 6;
    const bf16_t* proj = wsp<const bf16_t>(p, OFF_BIG);
    float* obuf = wsp<float>(p, OFF_OBUF) + ((size_t)dir * 2 + br) * R * 256;
    const int e = wid * 8 + (lane & 7), d0 = (lane >> 3) * DPL;
    float S[DPL];
#pragma unroll
    for (int j = 0; j < DPL; ++j) S[j] = 0.f;
    const float* wa2 = p.in[9] + ((size_t)l * 2 + dir) * 16 * 128; const float* ba = p.in[10] + ((size_t)l * 2 + dir) * 128;
    const float* hl = p.in[21];
    for (int ch = 0; ch < TT / 64; ++ch) {
        __syncthreads();
        for (int i = tid; i < 64 * DK; i += NTHR) {
            const int tk = i / DK, d = i % DK, n = ch * 64 + tk;
            const int pp = dir == 0 ? n : (n < LC ? LC - 1 - n : LC + (LQ - 1 - (n - LC)));
            const bf16_t* row = proj + (size_t)(bl * TT + pp) * NP1;
            float q, k, g;
            if (br == 0) {
                q = bf2f(row[C_GQ + h * 32 + d]) * 0.17677669529663687f; k = bf2f(row[C_GK + h * 32 + d]);
                float z = ba[h * 32 + d];
#pragma unroll
                for (int rr = 0; rr < 16; ++rr) z += bf2f(row[(dir ? C_GAB : C_GAF) + rr]) * wa2[rr * 128 + h * 32 + d];
                const float ls = fminf(z, 0.f) - log1pf(__expf(-fabsf(z)));
                g = __expf(ls * (1.0f / 16.0f));
            } else {
                q = siluf_(bf2f(row[C_HQ + h * 64 + d]));
                const float z = bf2f(row[(dir ? C_HFB : C_HFF) + h * 64 + d]);
                float lb = 0.f;
                if (l == 1) { const float a0 = hl[(0 * 2 + dir) * 256 + h * 64 + d], a1 = hl[(1 * 2 + dir) * 256 + h * 64 + d]; lb = 1.0f / (1.0f + __expf(a0 - a1)); }
                g = fmaxf(lb + (1.0f - lb) * sigmoidf_(z), 1e-20f);
                k = (1.0f - lb) * sigmoidf_(-z);
            }
            qS[i] = q; kS[i] = k; gS[i] = g;
        }
        for (int i = tid; i < 64 * 64; i += NTHR) {
            const int tk = i >> 6, ee = i & 63, n = ch * 64 + tk;
            const int pp = dir == 0 ? n : (n < LC ? LC - 1 - n : LC + (LQ - 1 - (n - LC)));
            vS[i] = bf2f(proj[(size_t)(bl * TT + pp) * NP1 + (br == 0 ? C_GV : C_HI) + h * 64 + ee]);
        }
        __syncthreads();
        for (int tk = 0; tk < 64; ++tk) {
            const float v = vS[tk * 64 + e]; float o = 0.f;
#pragma unroll
            for (int j = 0; j < DPL; ++j) {
                S[j] = gS[tk * DK + d0 + j] * S[j] + kS[tk * DK + d0 + j] * v;
                o += S[j] * qS[tk * DK + d0 + j];
            }
            o += __shfl_xor(o, 8); o += __shfl_xor(o, 16); o += __shfl_xor(o, 32);
            if ((lane >> 3) == 0) oS[tk * 64 + e] = o;
        }
        __syncthreads();
        {
            const int tk = tid >> 3, e8 = (tid & 7) * 8, n = ch * 64 + tk;
            const int pp = dir == 0 ? n : (n < LC ? LC - 1 - n : LC + (LQ - 1 - (n - LC)));
            float* dst = obuf + (size_t)(bl * TT + pp) * 256 + h * 64 + e8;
            *(f32x4*)dst = *(const f32x4*)(oS + tk * 64 + e8); *(f32x4*)(dst + 4) = *(const f32x4*)(oS + tk * 64 + e8 + 4);
        }
    }
}

template <int DK, int BR>
__device__ void recur_chunk_unit(const P& p, int l, int bl, int h, int dir, char* smem) {
    constexpr int RS = DK == 64 ? 160 : 96, NKC = DK / 32, NDT = DK / 16, NST = NDT / 2, VPT = DK / 8, NTG = NTHR / DK, TG = 64 / NTG;
    float* Bf = (float*)smem;
    float* Gp = Bf + 64 * DK;
    float* Bref = Gp + 16 * DK;
    float* Bend = Bref + DK;
    float* Wa = Bend + DK;
    char* Qs = (char*)(Wa + 512);
    char* Ks = Qs + 64 * RS;
    char* STs = Ks + 64 * RS;
    char* KTs = STs + 64 * RS;
    char* Vts = KTs + DK * 160;
    const int tid = TID(), lane = tid & 63, wid = tid >> 6, fr = lane & 15, fq = lane >> 4;
    const int st = tid >> 3, sc = tid & 7, d0 = sc * VPT;
    const int tt = wid & 3, eh = wid >> 2;
    const bf16_t* proj = wsp<const bf16_t>(p, OFF_BIG);
    float* obuf = wsp<float>(p, OFF_OBUF) + ((size_t)dir * 2 + BR) * R * 256;
    __syncthreads();
    float lbv[VPT];
#pragma unroll
    for (int j = 0; j < VPT; ++j) lbv[j] = 0.f;
    if (BR == 1 && l == 1) {
        const float* hl = p.in[21];
#pragma unroll
        for (int j = 0; j < VPT; ++j) { const float a0 = hl[(0 * 2 + dir) * 256 + h * 64 + d0 + j], a1 = hl[(1 * 2 + dir) * 256 + h * 64 + d0 + j]; lbv[j] = 1.0f / (1.0f + __expf(a0 - a1)); }
    }
    float bav[VPT];
#pragma unroll
    for (int j = 0; j < VPT; ++j) bav[j] = 0.f;
    if (BR == 0) {
        const float* wa2 = p.in[9] + ((size_t)l * 2 + dir) * 16 * 128; const float* ba = p.in[10] + ((size_t)l * 2 + dir) * 128;
        Wa[tid] = wa2[(tid >> 5) * 128 + h * 32 + (tid & 31)];
#pragma unroll
        for (int j = 0; j < VPT; ++j) bav[j] = ba[h * 32 + d0 + j];
    }
    __syncthreads();
    f32x4 S[NST];
#pragma unroll
    for (int i = 0; i < NST; ++i) S[i] = (f32x4){0.f, 0.f, 0.f, 0.f};
    u32x4 rq = {0u, 0u, 0u, 0u}, rk = {0u, 0u, 0u, 0u}, rv = {0u, 0u, 0u, 0u}, ra0 = {0u, 0u, 0u, 0u}, ra1 = {0u, 0u, 0u, 0u};
    auto chunk_pos = [&](int ci) { return dir == 0 ? ci : (ci < 4 ? 3 - ci : 67 - (ci - 4)); };
    auto load_raw = [&](int ci) {
        const bf16_t* row = proj + (size_t)(bl * TT + chunk_pos(ci) * 64 + st) * NP1;
        if (BR == 1) {
            rq = *(const u32x4*)(row + C_HQ + h * 64 + d0); rk = *(const u32x4*)(row + (dir ? C_HFB : C_HFF) + h * 64 + d0); rv = *(const u32x4*)(row + C_HI + h * 64 + sc * 8);
        } else {
            const u32x2 a = *(const u32x2*)(row + C_GQ + h * 32 + d0), b = *(const u32x2*)(row + C_GK + h * 32 + d0);
            rq[0] = a[0]; rq[1] = a[1]; rk[0] = b[0]; rk[1] = b[1];
            ra0 = *(const u32x4*)(row + (dir ? C_GAB : C_GAF)); ra1 = *(const u32x4*)(row + (dir ? C_GAB : C_GAF) + 8);
            rv = *(const u32x4*)(row + C_GV + h * 64 + sc * 8);
        }
    };
    load_raw(0);
#pragma unroll 1
    for (int ci = 0; ci < TT / 64; ++ci) {
        const int cp = chunk_pos(ci);
        float qv[VPT], kv[VPT], lg[VPT];
#pragma unroll
        for (int j = 0; j < VPT; ++j) {
            const unsigned wq = rq[j >> 1], wk = rk[j >> 1];
            const float qr = (j & 1) ? __uint_as_float(wq & 0xffff0000u) : __uint_as_float(wq << 16);
            const float kr = (j & 1) ? __uint_as_float(wk & 0xffff0000u) : __uint_as_float(wk << 16);
            if (BR == 1) {
                qv[j] = siluf_(qr);
                const float sg = sigmoidf_(kr), f = lbv[j] + (1.0f - lbv[j]) * sg;
                lg[j] = __logf(fmaxf(f, 1e-20f));
                kv[j] = (1.0f - lbv[j]) * (1.0f - sg);
            } else {
                qv[j] = qr * 0.17677669529663687f; kv[j] = kr;
                float z = bav[j];
#pragma unroll
                for (int rr = 0; rr < 16; ++rr) {
                    const unsigned wa = rr < 8 ? ra0[rr >> 1] : ra1[(rr - 8) >> 1];
                    const float av = (rr & 1) ? __uint_as_float(wa & 0xffff0000u) : __uint_as_float(wa << 16);
                    z += av * Wa[rr * 32 + d0 + j];
                }
                lg[j] = (fminf(z, 0.f) - log1pf(__expf(-fabsf(z)))) * (1.0f / 16.0f);
            }
        }
#pragma unroll
        for (int j = 0; j < VPT; j += 4) *(f32x4*)(Bf + st * DK + d0 + j) = (f32x4){lg[j], lg[j + 1], lg[j + 2], lg[j + 3]};
#pragma unroll
        for (int j = 0; j < 8; ++j) { const unsigned w = rv[j >> 1]; *(bf16_t*)(Vts + (sc * 8 + j) * 160 + st * 2) = (bf16_t)((j & 1) ? (w >> 16) : (w & 0xffffu)); }
        if (ci + 1 < TT / 64) load_raw(ci + 1);
        __syncthreads();
        {
            const int sd = tid % DK, tg = tid / DK;
            float run = 0.f;
#pragma unroll
            for (int i = 0; i < TG; ++i) { const int t = tg * TG + (dir ? TG - 1 - i : i); run += Bf[t * DK + sd]; Bf[t * DK + sd] = run; }
            Gp[tg * DK + sd] = run;
            __syncthreads();
            float off = 0.f;
            for (int g = 0; g < NTG; ++g) { const float gv = Gp[g * DK + sd]; off += (dir ? (g > tg) : (g < tg)) ? gv : 0.f; }
            const int tref = dir ? 32 : 31, tend = dir ? 0 : 63;
#pragma unroll
            for (int i = 0; i < TG; ++i) { const int t = tg * TG + i; const float v = Bf[t * DK + sd] + off; Bf[t * DK + sd] = v; if (t == tref) Bref[sd] = v; if (t == tend) Bend[sd] = v; }
        }
        __syncthreads();
        {
            unsigned qp[VPT / 2], kp[VPT / 2];
#pragma unroll
            for (int j = 0; j < VPT; j += 2) {
                const float b0 = Bf[st * DK + d0 + j], b1 = Bf[st * DK + d0 + j + 1], r0 = Bref[d0 + j], r1 = Bref[d0 + j + 1];
                const float q0 = qv[j] * __expf(b0 - r0), q1 = qv[j + 1] * __expf(b1 - r1), k0 = kv[j] * __expf(r0 - b0), k1 = kv[j + 1] * __expf(r1 - b1);
                qp[j >> 1] = pack2(q0, q1); kp[j >> 1] = pack2(k0, k1);
                *(bf16_t*)(KTs + (d0 + j) * 160 + st * 2) = (bf16_t)(kp[j >> 1] & 0xffffu);
                *(bf16_t*)(KTs + (d0 + j + 1) * 160 + st * 2) = (bf16_t)(kp[j >> 1] >> 16);
            }
            if (VPT == 8) { *(u32x4*)(Qs + st * RS + d0 * 2) = (u32x4){qp[0], qp[1], qp[2 % (VPT / 2)], qp[3 % (VPT / 2)]}; *(u32x4*)(Ks + st * RS + d0 * 2) = (u32x4){kp[0], kp[1], kp[2 % (VPT / 2)], kp[3 % (VPT / 2)]}; }
            else { *(u32x2*)(Qs + st * RS + d0 * 2) = (u32x2){qp[0], qp[1]}; *(u32x2*)(Ks + st * RS + d0 * 2) = (u32x2){kp[0], kp[1]}; }
#pragma unroll
            for (int i = 0; i < NST; ++i) {
                const int id = wid * NST + i, et = id / NDT, dt = id % NDT, d = dt * 16 + fr;
                const float er = __expf(Bref[d]);
#pragma unroll
                for (int rg = 0; rg < 4; ++rg) *(bf16_t*)(STs + (et * 16 + fq * 4 + rg) * RS + d * 2) = f2bf(S[i][rg] * er);
            }
        }
        __syncthreads();
        {
            bf16x8 qf[NKC];
#pragma unroll
            for (int kc = 0; kc < NKC; ++kc) qf[kc] = *(const bf16x8*)(Qs + (tt * 16 + fr) * RS + kc * 64 + fq * 16);
            u32x4 pk[2];
#pragma unroll
            for (int pr = 0; pr < 2; ++pr) {
                float sv[2][4];
#pragma unroll
                for (int half = 0; half < 2; ++half) {
                    const int stl = pr * 2 + half;
                    const bool allowed = dir ? (stl >= tt) : (stl <= tt);
                    f32x4 c = {0.f, 0.f, 0.f, 0.f};
                    if (allowed) {
#pragma unroll
                        for (int kc = 0; kc < NKC; ++kc) {
                            const bf16x8 kf = *(const bf16x8*)(Ks + (stl * 16 + fr) * RS + kc * 64 + fq * 16);
                            c = __builtin_amdgcn_mfma_f32_16x16x32_bf16(kf, qf[kc], c, 0, 0, 0);
                        }
                    }
#pragma unroll
                    for (int rg = 0; rg < 4; ++rg) {
                        const int s = fq * 4 + rg;
                        const bool keep = (stl != tt) || (dir ? (s >= fr) : (s <= fr));
                        sv[half][rg] = keep ? c[rg] : 0.f;
                    }
                }
                pk[pr][0] = pack2(sv[0][0], sv[0][1]); pk[pr][1] = pack2(sv[0][2], sv[0][3]); pk[pr][2] = pack2(sv[1][0], sv[1][1]); pk[pr][3] = pack2(sv[1][2], sv[1][3]);
            }
#pragma unroll
            for (int ei = 0; ei < 2; ++ei) {
                const int et = eh * 2 + ei;
                f32x4 O = {0.f, 0.f, 0.f, 0.f};
#pragma unroll
                for (int pr = 0; pr < 2; ++pr) {
                    const u32x2 a = *(const u32x2*)(Vts + (et * 16 + fr) * 160 + pr * 64 + fq * 8);
                    const u32x2 b = *(const u32x2*)(Vts + (et * 16 + fr) * 160 + pr * 64 + 32 + fq * 8);
                    const u32x4 cv = {a[0], a[1], b[0], b[1]};
                    O = __builtin_amdgcn_mfma_f32_16x16x32_bf16(__builtin_bit_cast(bf16x8, cv), __builtin_bit_cast(bf16x8, pk[pr]), O, 0, 0, 0);
                }
#pragma unroll
                for (int kc = 0; kc < NKC; ++kc) {
                    const bf16x8 sf = *(const bf16x8*)(STs + (et * 16 + fr) * RS + kc * 64 + fq * 16);
                    O = __builtin_amdgcn_mfma_f32_16x16x32_bf16(sf, qf[kc], O, 0, 0, 0);
                }
                *(f32x4*)(obuf + (size_t)(bl * TT + cp * 64 + tt * 16 + fr) * 256 + h * 64 + et * 16 + fq * 4) = O;
            }
#pragma unroll
            for (int i = 0; i < NST; ++i) {
                const int id = wid * NST + i, et = id / NDT, dt = id % NDT, d = dt * 16 + fr;
                f32x4 A = {0.f, 0.f, 0.f, 0.f};
#pragma unroll
                for (int k2 = 0; k2 < 2; ++k2) {
                    const bf16x8 vf = *(const bf16x8*)(Vts + (et * 16 + fr) * 160 + k2 * 64 + fq * 16);
                    const bf16x8 kt = *(const bf16x8*)(KTs + (dt * 16 + fr) * 160 + k2 * 64 + fq * 16);
                    A = __builtin_amdgcn_mfma_f32_16x16x32_bf16(vf, kt, A, 0, 0, 0);
                }
                const float be = Bend[d], e1 = __expf(be), e2 = __expf(be - Bref[d]);
#pragma unroll
                for (int rg = 0; rg < 4; ++rg) S[i][rg] = e1 * S[i][rg] + e2 * A[rg];
            }
        }
        __syncthreads();
    }
}

__device__ void ph_hcopies(const P& p) {
    const int tid = TID();
    for (int u = BID(); u < NLAYER * 512; u += gridDim.x) {
        const int l = u / 512, n = u % 512;
        const float* hr = wsp<const float>(p, OFF_HRAW) + (size_t)l * HRAW_L + (size_t)n * LQ;
        const float* psum = wsp<const float>(p, OFF_PSUM) + (size_t)l * 68 * 512;
        float sc = 0.f;
        for (int q = 0; q < 64; ++q) sc += psum[q * 512 + n];
        const float inv = 1.0f / sc;
        char* dst = wsp<char>(p, OFF_HCOP) + (size_t)u * (8 * HY_HSTR);
        for (int i = tid; i < 8 * HY_NS; i += NTHR) {
            const int kap = i / HY_NS, s = i % HY_NS; const int y0 = 8 * s + kap - 16;
            float v[8];
#pragma unroll
            for (int e = 0; e < 8; ++e) { const int y = y0 + e; v[e] = (y >= 0 && y < LQ) ? hr[LQ - 1 - y] * inv : 0.f; }
            u32x4 w; w[0] = pack2(v[0], v[1]); w[1] = pack2(v[2], v[3]); w[2] = pack2(v[4], v[5]); w[3] = pack2(v[6], v[7]);
            *(u32x4*)(dst + kap * HY_HSTR + s * 16) = w;
        }
    }
}

__device__ void hyena_mfma_unit(const P& p, int l, int c, char* smem) {
    const int tid = TID(), lane = tid & 63, wid = tid >> 6, fr = lane & 15, fq = lane >> 4;
    const int sg = fr >> 3;
    char* Us = smem; char* Hs = smem + HY_U_BYTES; const char* zero16 = smem + HY_Z_OFF;
    const bf16_t* hyT = wsp<const bf16_t>(p, OFF_HYT);
    bf16_t* outs = wsp<bf16_t>(p, OFF_OUTS);
    __syncthreads();
    for (int i = tid; i < 8 * 512; i += NTHR) {
        const int bb = i >> 9, s8 = (i & 511) * 8;
        *(u32x4*)(Us + bb * HY_UB + s8 * 2) = *(const u32x4*)(hyT + ((size_t)bb * 768 + c) * LQ + s8);
    }
    if (tid < 4) ((unsigned*)(smem + HY_Z_OFF))[tid] = 0u;
    const int tw = wid * 256;
    const int c0 = fq + (fr < 8 ? 1 : 0);
    const char* hl = Hs + ((7 - fr) & 7) * HY_HSTR;
#pragma unroll 1
    for (int o = 0; o < 2; ++o) {
        const char* hc = wsp<const char>(p, OFF_HCOP) + ((size_t)l * 512 + o * 256 + c) * (8 * HY_HSTR);
        for (int i = tid; i < 8 * HY_HSTR / 16; i += NTHR) *(u32x4*)(Hs + i * 16) = *(const u32x4*)(hc + i * 16);
        __syncthreads();
        f32x4 acc[16];
#pragma unroll
        for (int m = 0; m < 16; ++m) acc[m] = (f32x4){0.f, 0.f, 0.f, 0.f};
        bf16x8 F[16];
#pragma unroll
        for (int q = 2; q < 16; ++q) { int s = -2 * q + c0; s = s < 0 ? 0 : s; F[q] = *(const bf16x8*)(hl + s * 16); }
#pragma unroll 1
        for (int jo = 0; jo < 17; ++jo) {
#pragma unroll
            for (int ji = 0; ji < 8; ++ji) {
                const int j = jo * 8 + ji;
                {
                    int s0 = 4 * j + c0, s1 = 4 * j - 2 + c0;
                    s0 = s0 > HY_NS - 1 ? HY_NS - 1 : s0; s1 = s1 < 0 ? 0 : (s1 > HY_NS - 1 ? HY_NS - 1 : s1);
                    F[(16 - 2 * ji) & 15] = *(const bf16x8*)(hl + s0 * 16);
                    F[(17 - 2 * ji) & 15] = *(const bf16x8*)(hl + s1 * 16);
                }
                const int sidx = tw - 2048 + 32 * j + sg * 2048;
                const char* ba = ((unsigned)sidx < 4096u) ? (Us + (fr & 7) * HY_UB + (sidx + 8 * fq) * 2) : zero16;
                const bf16x8 B = *(const bf16x8*)ba;
#pragma unroll
                for (int m = 0; m < 16; ++m) acc[m] = __builtin_amdgcn_mfma_f32_16x16x32_bf16(F[(m - 2 * ji) & 15], B, acc[m], 0, 0, 0);
            }
        }
        __syncthreads();
        const float bias = p.in[20][((size_t)l * 2 + o) * 256 + c];
        const int tid2 = TID(), fr2 = tid2 & 15, fq2 = (tid2 >> 4) & 3, b = fr2 & 7, sg2 = fr2 >> 3, tw2 = (tid2 >> 6) * 256;
        const bf16_t* gp = hyT + ((size_t)b * 768 + (o + 1) * 256 + c) * LQ;
#pragma unroll
        for (int m = 0; m < 16; ++m) {
            const int t = tw2 + 16 * m + sg2 * 2048 + 4 * fq2;
            const u32x2 gr = *(const u32x2*)(gp + t);
            const float g[4] = {__uint_as_float(gr[0] << 16), __uint_as_float(gr[0] & 0xffff0000u), __uint_as_float(gr[1] << 16), __uint_as_float(gr[1] & 0xffff0000u)};
            const u32x2 zr = *(const u32x2*)(Us + b * HY_UB + t * 2);
            const float z0 = __uint_as_float(zr[0] << 16), z1 = __uint_as_float(zr[0] & 0xffff0000u), z2 = __uint_as_float(zr[1] << 16), z3 = __uint_as_float(zr[1] & 0xffff0000u);
            const float r0 = g[0] * (acc[m][0] + bias * z0), r1 = g[1] * (acc[m][1] + bias * z1), r2 = g[2] * (acc[m][2] + bias * z2), r3 = g[3] * (acc[m][3] + bias * z3);
            if (o == 0) { u32x2 w; w[0] = pack2(r0, r1); w[1] = pack2(r2, r3); *(u32x2*)(Us + b * HY_UB + t * 2) = w; }
            else {
                bf16_t* dp = outs + (size_t)(b * TT + LC + t) * D + 256 + c;
                dp[0] = f2bf(r0); dp[D] = f2bf(r1); dp[2 * D] = f2bf(r2); dp[3 * D] = f2bf(r3);
            }
            if (m & 1) asm volatile("" ::: "memory");
        }
        __syncthreads();
    }
}

template <int L>
__device__ void hyena_unit(const P& p, int l, int bl, int c, char* smem) {
    constexpr int W = L == LQ ? 0 : 1, NU = L / 64;
    float* upad = (float*)smem;
    float* hS = upad + 2 * L;
    const int tid = TID();
    const bf16_t* hyT = wsp<const bf16_t>(p, OFF_HYT) + (W ? (size_t)BG * 768 * LQ : 0) + (size_t)bl * 768 * L;
    const float* hraw = wsp<const float>(p, OFF_HRAW) + (size_t)l * HRAW_L + (W ? (size_t)512 * LQ : 0);
    const float* psum = wsp<const float>(p, OFF_PSUM) + (size_t)l * 68 * 512 + (W ? 64 * 512 : 0);
    bf16_t* outs = wsp<bf16_t>(p, OFF_OUTS);
    const bool act = tid * 8 < L; const int t0 = tid * 8;
    float z[8];
    __syncthreads();
    for (int i = tid; i < 2 * L; i += NTHR) { const int s = i - L / 2; upad[i] = (s >= 0 && s < L) ? bf2f(hyT[(size_t)c * L + s]) : 0.f; }
    if (act) {
#pragma unroll
        for (int i = 0; i < 8; ++i) z[i] = bf2f(hyT[(size_t)c * L + t0 + i]);
    }
    for (int o = 0; o < 2; ++o) {
        const int n = o * 256 + c;
        float sc = 0.f;
        for (int q = 0; q < NU; ++q) sc += psum[q * 512 + n];
        const float inv = 1.0f / sc;
        for (int i = tid; i < L; i += NTHR) hS[i] = hraw[(size_t)n * L + i];
        __syncthreads();
        float acc[8];
#pragma unroll
        for (int i = 0; i < 8; ++i) acc[i] = 0.f;
        if (act) {
            float hi[8], lo[8];
            const float* wp = upad + t0 + L - 8;
#pragma unroll
            for (int m = 0; m < 8; ++m) hi[m] = wp[8 + m];
            for (int J = 0; J < L / 8; ++J) {
                const f32x4 l0 = *(const f32x4*)(wp - 8 * J), l1 = *(const f32x4*)(wp - 8 * J + 4);
                lo[0] = l0[0]; lo[1] = l0[1]; lo[2] = l0[2]; lo[3] = l0[3]; lo[4] = l1[0]; lo[5] = l1[1]; lo[6] = l1[2]; lo[7] = l1[3];
                const f32x4 h0 = *(const f32x4*)(hS + 8 * J), h1 = *(const f32x4*)(hS + 8 * J + 4);
                const float hv[8] = {h0[0], h0[1], h0[2], h0[3], h1[0], h1[1], h1[2], h1[3]};
#pragma unroll
                for (int jj = 0; jj < 8; ++jj)
#pragma unroll
                    for (int i = 0; i < 8; ++i) { const int m = i - jj + 8; acc[i] += hv[jj] * (m >= 8 ? hi[m - 8] : lo[m]); }
#pragma unroll
                for (int m = 0; m < 8; ++m) hi[m] = lo[m];
            }
        }
        const float bias = p.in[20][((size_t)l * 2 + o) * 256 + c];
        if (act) {
#pragma unroll
            for (int i = 0; i < 8; ++i) { const float gate = bf2f(hyT[(size_t)((o + 1) * 256 + c) * L + t0 + i]); z[i] = gate * (acc[i] * inv + bias * z[i]); }
        }
        __syncthreads();
        if (o == 0) {
            if (act) {
#pragma unroll
                for (int i = 0; i < 8; ++i) upad[L / 2 + t0 + i] = z[i];
            }
        } else if (act) {
#pragma unroll
            for (int i = 0; i < 8; ++i) outs[(size_t)(bl * TT + (W ? 0 : LC) + t0 + i) * D + 256 + c] = f2bf(z[i]);
        }
        __syncthreads();
    }
}

__device__ void attn_unit(const P& p, int l, int bl, int h, int q0, int nkeys, char* smem) {
    constexpr int KROW = 160, VROW = 144, KT_BYTES = 64 * KROW, STG = KT_BYTES + 64 * VROW;
    const int tid = TID(), lane = tid & 63, wid = tid >> 6, fr = lane & 15, fq = lane >> 4;
    const bf16_t* Qa = wsp<const bf16_t>(p, OFF_QA) + ((size_t)bl * 4 + h) * TT * 64;
    const bf16_t* Ka = wsp<const bf16_t>(p, OFF_KA) + ((size_t)bl * 4 + h) * TT * 64;
    const bf16_t* Vt = wsp<const bf16_t>(p, OFF_VA) + ((size_t)bl * 4 + h) * 64 * TT;
    const int ln32 = tid & 31;
    float gqm = fabsf(p.in[23][l * 32 + ln32]), gkm = fabsf(p.in[24][l * 32 + ln32]);
#pragma unroll
    for (int o = 16; o > 0; o >>= 1) { gqm = fmaxf(gqm, __shfl_xor(gqm, o)); gkm = fmaxf(gkm, __shfl_xor(gkm, o)); }
    const float Mx2 = 32.0f * 0.17677669529663687f * 1.4426950408889634f * gqm * gkm;
    const float* lp = p.in[25] + (size_t)l * 128;
    float s01 = lp[ln32] * lp[32 + ln32], s23 = lp[64 + ln32] * lp[96 + ln32];
#pragma unroll
    for (int o = 16; o > 0; o >>= 1) { s01 += __shfl_xor(s01, o); s23 += __shfl_xor(s23, o); }
    const float lam_init = 0.8f - 0.6f * expf(-0.3f * (float)l);
    const float lam = expf(s01) - expf(s23) + lam_init;
    const f32x4 cinit = {-Mx2, -Mx2, -Mx2, -Mx2};
    const int qw = q0 + wid * 32;
    bf16x8 qf[2][2];
#pragma unroll
    for (int br = 0; br < 2; ++br)
#pragma unroll
        for (int qt = 0; qt < 2; ++qt) qf[br][qt] = *(const bf16x8*)(Qa + (size_t)(qw + qt * 16 + fr) * 64 + br * 32 + fq * 8);
    f32x4 O[2][2][4], Ls[2][2];
#pragma unroll
    for (int br = 0; br < 2; ++br)
#pragma unroll
        for (int qt = 0; qt < 2; ++qt) { Ls[br][qt] = (f32x4){0.f, 0.f, 0.f, 0.f};
#pragma unroll
            for (int dt = 0; dt < 4; ++dt) O[br][qt][dt] = (f32x4){0.f, 0.f, 0.f, 0.f}; }
    bf16x8 ones;
#pragma unroll
    for (int j = 0; j < 8; ++j) ones[j] = (short)0x3F80;
    const int srow = tid >> 3, sc = tid & 7;
    const bf16_t* kg = Ka + (size_t)srow * 64 + sc * 8;
    const bf16_t* vg = Vt + (size_t)srow * TT + sc * 8;
    const int kso = srow * KROW + sc * 16, vso = KT_BYTES + srow * VROW + sc * 16;
    u32x4 rk = *(const u32x4*)kg, rv = *(const u32x4*)vg;
    __syncthreads();
    *(u32x4*)(smem + kso) = rk; *(u32x4*)(smem + vso) = rv;
    __syncthreads();
    const int nt = nkeys / 64;
    for (int kt = 0; kt < nt; ++kt) {
        const char* cur = smem + (kt & 1) * STG; char* nxt = smem + ((kt + 1) & 1) * STG;
        if (kt + 1 < nt) { rk = *(const u32x4*)(kg + (size_t)(kt + 1) * 64 * 64); rv = *(const u32x4*)(vg + (kt + 1) * 64); }
#pragma unroll
        for (int kp = 0; kp < 2; ++kp) {
            bf16x8 kf[2][2], vf[4];
#pragma unroll
            for (int br = 0; br < 2; ++br)
#pragma unroll
                for (int t = 0; t < 2; ++t) kf[br][t] = *(const bf16x8*)(cur + (kp * 32 + t * 16 + fr) * KROW + br * 64 + fq * 16);
#pragma unroll
            for (int dt = 0; dt < 4; ++dt) {
                const u32x2 a = *(const u32x2*)(cur + KT_BYTES + (dt * 16 + fr) * VROW + kp * 64 + fq * 8);
                const u32x2 b = *(const u32x2*)(cur + KT_BYTES + (dt * 16 + fr) * VROW + kp * 64 + 32 + fq * 8);
                u32x4 c; c[0] = a[0]; c[1] = a[1]; c[2] = b[0]; c[3] = b[1];
                vf[dt] = __builtin_bit_cast(bf16x8, c);
            }
#pragma unroll
            for (int qt = 0; qt < 2; ++qt)
#pragma unroll
                for (int br = 0; br < 2; ++br) {
                    const f32x4 s0 = __builtin_amdgcn_mfma_f32_16x16x32_bf16(kf[br][0], qf[br][qt], cinit, 0, 0, 0);
                    const f32x4 s1 = __builtin_amdgcn_mfma_f32_16x16x32_bf16(kf[br][1], qf[br][qt], cinit, 0, 0, 0);
                    u32x4 pk;
                    pk[0] = cvt_pk_bf16(__builtin_amdgcn_exp2f(s0[0]), __builtin_amdgcn_exp2f(s0[1]));
                    pk[1] = cvt_pk_bf16(__builtin_amdgcn_exp2f(s0[2]), __builtin_amdgcn_exp2f(s0[3]));
                    pk[2] = cvt_pk_bf16(__builtin_amdgcn_exp2f(s1[0]), __builtin_amdgcn_exp2f(s1[1]));
                    pk[3] = cvt_pk_bf16(__builtin_amdgcn_exp2f(s1[2]), __builtin_amdgcn_exp2f(s1[3]));
                    const bf16x8 pb = __builtin_bit_cast(bf16x8, pk);
#pragma unroll
                    for (int dt = 0; dt < 4; ++dt) O[br][qt][dt] = __builtin_amdgcn_mfma_f32_16x16x32_bf16(vf[dt], pb, O[br][qt][dt], 0, 0, 0);
                    Ls[br][qt] = __builtin_amdgcn_mfma_f32_16x16x32_bf16(ones, pb, Ls[br][qt], 0, 0, 0);
                }
        }
        if (kt + 1 < nt) { *(u32x4*)(nxt + kso) = rk; *(u32x4*)(nxt + vso) = rv; }
        __syncthreads();
    }
    asm volatile("" ::: "memory");
    const float* gn = p.in[26] + l * 64;
#pragma unroll
    for (int qt = 0; qt < 2; ++qt) {
        const float i1 = 1.0f / Ls[0][qt][0], i2 = lam / Ls[1][qt][0];
        float o[4][4], ss = 0.f;
#pragma unroll
        for (int dt = 0; dt < 4; ++dt)
#pragma unroll
            for (int j = 0; j < 4; ++j) { o[dt][j] = O[0][qt][dt][j] * i1 - O[1][qt][dt][j] * i2; ss += o[dt][j] * o[dt][j]; }
        ss += __shfl_xor(ss, 16); ss += __shfl_xor(ss, 32);
        const float rs = rsqrtf(ss * (1.0f / 64.0f) + 1e-6f) * (1.0f - lam_init);
        bf16_t* dst = wsp<bf16_t>(p, OFF_OUTS) + (size_t)(bl * TT + qw + qt * 16 + fr) * D + 768 + h * 64;
#pragma unroll
        for (int dt = 0; dt < 4; ++dt) {
            const f32x4 g = *(const f32x4*)(gn + dt * 16 + fq * 4);
            u32x2 w; w[0] = pack2(o[dt][0] * rs * g[0], o[dt][1] * rs * g[1]); w[1] = pack2(o[dt][2] * rs * g[2], o[dt][3] * rs * g[3]);
            *(u32x2*)(dst + dt * 16 + fq * 4) = w;
        }
    }
}

__device__ void ph_recur(const P& p, int l, char* smem) {
    const int NR = BG * 4 * 2 * 2;
    for (int u = BID(); u < NR; u += gridDim.x) {
        const int dir = u & 1, br = (u >> 1) & 1, h = (u >> 2) & 3, bl = u >> 4;
        if (br == 0) recur_chunk_unit<32, 0>(p, l, bl, h, dir, smem); else recur_chunk_unit<64, 1>(p, l, bl, h, dir, smem);
    }
}
__device__ void ph_attn(const P& p, int l, char* smem) {
    const bool last = l == NLAYER - 1;
    const int per = 16 + (last ? 0 : 1), NA = BG * 4 * per;
    for (int u = BID(); u < NA; u += gridDim.x) {
        const int qb = u % per, h = (u / per) & 3, bl = u / (per * 4);
        if (qb < 16) attn_unit(p, l, bl, h, LC + qb * 256, TT, smem);
        else attn_unit(p, l, bl, h, 0, LC, smem);
    }
}
__device__ void ph_hyena(const P& p, int l, char* smem) {
    const bool last = l == NLAYER - 1;
    const int NHL = 256, NHC = last ? 0 : BG * 256;
    for (int u = BID(); u < NHL + NHC; u += gridDim.x) {
        if (u < NHL) hyena_mfma_unit(p, l, u, smem);
        else { const int v = u - NHL; hyena_unit<LC>(p, l, v / 256, v % 256, smem); }
    }
}

__device__ void ph_gated(const P& p, int l) {
    const int tid = TID(), lane = tid & 63, wid = tid >> 6;
    const bf16_t* proj = wsp<const bf16_t>(p, OFF_BIG);
    const float* obuf = wsp<const float>(p, OFF_OBUF);
    bf16_t* outs = wsp<bf16_t>(p, OFF_OUTS);
    for (int r = BID() * 8 + wid; r < R; r += gridDim.x * 8) {
#pragma unroll
        for (int br = 0; br < 2; ++br) {
            const f32x4 a = *(const f32x4*)(obuf + ((size_t)(0 * 2 + br) * R + r) * 256 + lane * 4);
            const f32x4 b = *(const f32x4*)(obuf + ((size_t)(1 * 2 + br) * R + r) * 256 + lane * 4);
            float o[4] = {a[0] + b[0], a[1] + b[1], a[2] + b[2], a[3] + b[3]};
            float ss = o[0] * o[0] + o[1] * o[1] + o[2] * o[2] + o[3] * o[3];
            ss += __shfl_xor(ss, 1); ss += __shfl_xor(ss, 2); ss += __shfl_xor(ss, 4); ss += __shfl_xor(ss, 8);
            const float rs = rsqrtf(ss * (1.0f / 64.0f) + 1e-6f);
            const float* gn = p.in[br ? 22 : 11] + l * 64 + (lane & 15) * 4;
            const u32x2 graw = *(const u32x2*)(proj + (size_t)r * NP1 + (br ? C_HGG : C_GG) + lane * 4);
            const float gt[4] = {bf2f((bf16_t)(graw[0] & 0xffff)), bf2f((bf16_t)(graw[0] >> 16)), bf2f((bf16_t)(graw[1] & 0xffff)), bf2f((bf16_t)(graw[1] >> 16))};
#pragma unroll
            for (int c = 0; c < 4; ++c) o[c] = o[c] * rs * gn[c] * siluf_(gt[c]);
            u32x2 w; w[0] = pack2(o[0], o[1]); w[1] = pack2(o[2], o[3]);
            *(u32x2*)(outs + (size_t)r * D + (br ? 512 : 0) + lane * 4) = w;
        }
    }
}

__device__ void ph_merge(const P& p, int l, char* smem) {
    const int tid = TID(), lane = tid & 63, wid = tid >> 6, wr = wid / 4, wc = wid % 4, fr = lane & 15, fq = lane >> 4;
    const bool last = l == NLAYER - 1;
    const bf16_t* hx = wsp<const bf16_t>(p, OFF_HX); const bf16_t* outs = wsp<const bf16_t>(p, OFF_OUTS);
    const bf16_t* btg = wsp<const bf16_t>(p, OFF_BTGATE) + (size_t)l * 4096 * D;
    const bf16_t* btb = wsp<const bf16_t>(p, OFF_BTBR) + (size_t)l * 4 * 1024 * 256;
    bf16_t* merged = wsp<bf16_t>(p, OFF_BIG);
    for (int u = BID(); u < (R / 128) * 8; u += gridDim.x) {
        const int pm = u / 8, pn = u % 8;
        if (last && (pm % 34) < 2) continue;
        f32x4 mg[4][2]; ZERO_ACC(mg, 4, 2);
#pragma unroll 1
        for (int i = 0; i < 4; ++i) {
            f32x4 ag[4][2]; ZERO_ACC(ag, 4, 2);
            GSq::run(smem, [&](int r) { return hx + (size_t)(pm * 128 + r) * D; }, [&](int r) { return btg + (size_t)(i * 1024 + pn * 128 + r) * D; }, D, ag);
#pragma unroll
            for (int m = 0; m < 4; ++m)
#pragma unroll
                for (int n = 0; n < 2; ++n)
#pragma unroll
                    for (int j = 0; j < 4; ++j) ag[m][n][j] = sigmoidf_(ag[m][n][j]);
            f32x4 ab[4][2]; ZERO_ACC(ab, 4, 2);
            GSq::run(smem, [&](int r) { return outs + (size_t)(pm * 128 + r) * D + i * 256; }, [&](int r) { return btb + ((size_t)i * 1024 + pn * 128 + r) * 256; }, 256, ab);
#pragma unroll
            for (int m = 0; m < 4; ++m)
#pragma unroll
                for (int n = 0; n < 2; ++n) mg[m][n] += ag[m][n] * ab[m][n];
        }
#pragma unroll
        for (int m = 0; m < 4; ++m) {
            const int row = pm * 128 + wr * 64 + m * 16 + fr;
#pragma unroll
            for (int n = 0; n < 2; ++n) {
                const int col = pn * 128 + wc * 32 + n * 16 + fq * 4;
                u32x2 w; w[0] = pack2(mg[m][n][0], mg[m][n][1]); w[1] = pack2(mg[m][n][2], mg[m][n][3]);
                *(u32x2*)(merged + (size_t)row * D + col) = w;
            }
        }
    }
}

__device__ void ph_wout(const P& p, int l, int grp, char* smem) {
    const int tid = TID(), lane = tid & 63, wid = tid >> 6, wr = wid / 2, wc = wid % 2, fr = lane & 15, fq = lane >> 4;
    const bool last = l == NLAYER - 1;
    const bf16_t* merged = wsp<const bf16_t>(p, OFF_BIG);
    const bf16_t* bt = wsp<const bf16_t>(p, OFF_BTOUT) + (size_t)l * D * D;
    for (int u = BID(); u < (R / 256) * 8; u += gridDim.x) {
        const int pm = u / 8, pn = u % 8;
        if (last && (pm % 17) == 0) continue;
        f32x4 acc[4][4]; ZERO_ACC(acc, 4, 4);
        GBig::run(smem, [&](int i) { return merged + (size_t)(pm * 256 + i) * D; }, [&](int i) { return bt + (size_t)(pn * 128 + i) * D; }, D, acc);
#pragma unroll
        for (int m = 0; m < 4; ++m) {
            const int r = pm * 256 + wr * 64 + m * 16 + fr, bl = r / TT, pp = r % TT, b = grp * BG + bl;
            const float* src = stream_src(p, l, b, pp); float* dst = stream_dst(p, b, pp);
            const float* mod = (pp < LC ? wsp<const float>(p, OFF_MODC) + (size_t)l * 6144 : wsp<const float>(p, OFF_MODX) + ((size_t)l * NB + b) * 6144) + 2 * D;
#pragma unroll
            for (int n = 0; n < 4; ++n) {
                const int col = pn * 128 + wc * 64 + n * 16 + fq * 4;
                const f32x4 s = *(const f32x4*)(src + col), md = *(const f32x4*)(mod + col);
                *(f32x4*)(dst + col) = s + md * acc[m][n];
            }
        }
    }
}

__device__ void ph_topk(const P& p, int l, char* smem) {
    unsigned* keys = (unsigned*)smem;
    unsigned* red = keys + 4096;
    const int tid = TID(), lane = tid & 63, wid = tid >> 6;
    const bool last = l == NLAYER - 1;
    const int NU = BG * NEXP * (last ? 1 : 2);
    for (int u = BID(); u < NU; u += gridDim.x) {
        const int isctx = u >= BG * NEXP, v = isctx ? u - BG * NEXP : u, bl = v / NEXP, e = v % NEXP;
        const int L = isctx ? LC : LQ, cap = isctx ? CAPC : CAPL;
        const float* aff = wsp<const float>(p, OFF_AFF) + (isctx ? (size_t)BG * NEXP * LQ + (size_t)v * LC : (size_t)v * LQ);
        __syncthreads();
        for (int i = tid; i < 4096; i += NTHR) keys[i] = i < L ? __float_as_uint(aff[i]) : 0u;
        __syncthreads();
        unsigned my[8];
#pragma unroll
        for (int i = 0; i < 8; ++i) my[i] = keys[tid * 8 + i];
        unsigned T = 0u;
        for (int bit = 30; bit >= 0; --bit) {
            const unsigned cand = T | (1u << bit);
            int c = 0;
#pragma unroll
            for (int i = 0; i < 8; ++i) c += (my[i] >= cand) ? 1 : 0;
            c = (int)wave_sum((float)c);
            if (lane == 0) red[wid] = (unsigned)c;
            __syncthreads();
            int tot = 0;
#pragma unroll
            for (int w = 0; w < 8; ++w) tot += (int)red[w];
            __syncthreads();
            if (tot >= cap) T = cand;
        }
        int cg = 0, ce = 0;
#pragma unroll
        for (int i = 0; i < 8; ++i) { cg += (my[i] > T) ? 1 : 0; ce += (my[i] == T) ? 1 : 0; }
        unsigned pk = (unsigned)cg | ((unsigned)ce << 16), inc = pk;
#pragma unroll
        for (int o = 1; o < 64; o <<= 1) { const unsigned t = __shfl_up(inc, o); if (lane >= o) inc += t; }
        if (lane == 63) red[8 + wid] = inc;
        __syncthreads();
        unsigned base = 0u, totpk = 0u;
#pragma unroll
        for (int w = 0; w < 8; ++w) { const unsigned t = red[8 + w]; if (w < wid) base += t; totpk += t; }
        const unsigned ex = base + inc - pk;
        int rg = (int)(ex & 0xffffu), re = (int)(ex >> 16); const int G = (int)(totpk & 0xffffu);
        const int sbase = isctx ? LATS + (e * BG + bl) * CAPC : (bl * NEXP + e) * CAPL;
        int* sidx = wsp<int>(p, OFF_SIDX); float* sgv = wsp<float>(p, OFF_SGV); int* inv = wsp<int>(p, OFF_INV);
#pragma unroll
        for (int i = 0; i < 8; ++i) {
            const int tok = tid * 8 + i; int slot = -1;
            if (my[i] > T) slot = rg++;
            else if (my[i] == T) { if (G + re < cap) slot = G + re; re++; }
            if (slot >= 0 && tok < L) {
                const int r = bl * TT + (isctx ? tok : LC + tok);
                sidx[sbase + slot] = r; sgv[sbase + slot] = __uint_as_float(my[i]); inv[(size_t)r * NEXP + e] = sbase + slot;
            }
        }
    }
}

__device__ __forceinline__ int mtile_expert(int mt) { return mt < LATS / 256 ? (mt >> 1) & 15 : mt - LATS / 256; }

__device__ void ph_moe1(const P& p, int l, char* smem) {
    const int tid = TID(), lane = tid & 63, wid = tid >> 6, wr = wid / 2, wc = wid % 2, fr = lane & 15, fq = lane >> 4;
    const bool last = l == NLAYER - 1;
    const bf16_t* hx = wsp<const bf16_t>(p, OFF_HX); const int* sidx = wsp<const int>(p, OFF_SIDX);
    bf16_t* H = wsp<bf16_t>(p, OFF_BIG) + (size_t)NSLOT * D;
    const int nmt = last ? LATS / 256 : NSLOT / 256;
    for (int u = BID(); u < nmt * 16; u += gridDim.x) {
        const int mt = u / 16, pn = u % 16, e = mtile_expert(mt);
        const bf16_t* bt = wsp<const bf16_t>(p, OFF_BTW13) + ((size_t)l * NEXP + e) * 2048 * D;
        f32x4 acc[4][4]; ZERO_ACC(acc, 4, 4);
        GBig::run(smem, [&](int i) { return hx + (size_t)sidx[mt * 256 + i] * D; }, [&](int i) { return bt + (size_t)(pn * 128 + i) * D; }, D, acc);
#pragma unroll
        for (int m = 0; m < 4; ++m) {
            const int slot = mt * 256 + wr * 64 + m * 16 + fr;
#pragma unroll
            for (int n2 = 0; n2 < 2; ++n2) {
                const int col = (pn * 4 + wc * 2 + n2) * 16 + fq * 4;
                float hv[4];
#pragma unroll
                for (int j = 0; j < 4; ++j) hv[j] = siluf_(acc[m][2 * n2][j]) * acc[m][2 * n2 + 1][j];
                u32x2 w; w[0] = pack2(hv[0], hv[1]); w[1] = pack2(hv[2], hv[3]);
                *(u32x2*)(H + (size_t)slot * D + col) = w;
            }
        }
    }
}

__device__ void ph_moe2(const P& p, int l, char* smem) {
    const int tid = TID(), lane = tid & 63, wid = tid >> 6, wr = wid / 2, wc = wid % 2, fr = lane & 15, fq = lane >> 4;
    const bool last = l == NLAYER - 1;
    const bf16_t* H = wsp<const bf16_t>(p, OFF_BIG) + (size_t)NSLOT * D;
    bf16_t* Y = wsp<bf16_t>(p, OFF_BIG);
    const float* sgv = wsp<const float>(p, OFF_SGV);
    const int nmt = last ? LATS / 256 : NSLOT / 256;
    for (int u = BID(); u < nmt * 8; u += gridDim.x) {
        const int mt = u / 8, pn = u % 8, e = mtile_expert(mt);
        const bf16_t* bt = wsp<const bf16_t>(p, OFF_BTW2) + ((size_t)l * NEXP + e) * D * D;
        f32x4 acc[4][4]; ZERO_ACC(acc, 4, 4);
        GBig::run(smem, [&](int i) { return H + (size_t)(mt * 256 + i) * D; }, [&](int i) { return bt + (size_t)(pn * 128 + i) * D; }, D, acc);
#pragma unroll
        for (int m = 0; m < 4; ++m) {
            const int slot = mt * 256 + wr * 64 + m * 16 + fr; const float g = sgv[slot];
#pragma unroll
            for (int n = 0; n < 4; ++n) {
                const int col = pn * 128 + wc * 64 + n * 16 + fq * 4;
                u32x2 w; w[0] = pack2(acc[m][n][0] * g, acc[m][n][1] * g); w[1] = pack2(acc[m][n][2] * g, acc[m][n][3] * g);
                *(u32x2*)(Y + (size_t)slot * D + col) = w;
            }
        }
    }
}

__device__ void ph_combine(const P& p, int l, int grp) {
    const int tid = TID(), lane = tid & 63, wid = tid >> 6;
    const bool last = l == NLAYER - 1;
    const bf16_t* Y = wsp<const bf16_t>(p, OFF_BIG); const int* inv = wsp<const int>(p, OFF_INV);
    for (int r = BID() * 8 + wid; r < R; r += gridDim.x * 8) {
        const int bl = r / TT, pp = r % TT, b = grp * BG + bl;
        if (last && pp < LC) continue;
        float* dst = stream_dst(p, b, pp);
        const float* mod = (pp < LC ? wsp<const float>(p, OFF_MODC) + (size_t)l * 6144 : wsp<const float>(p, OFF_MODX) + ((size_t)l * NB + b) * 6144) + 5 * D;
        const int myinv = lane < NEXP ? inv[(size_t)r * NEXP + lane] : -1;
        float acc[16];
#pragma unroll
        for (int i = 0; i < 16; ++i) acc[i] = 0.f;
        for (int e = 0; e < NEXP; ++e) {
            const int s = __shfl(myinv, e);
            if (s >= 0) {
#pragma unroll
                for (int i = 0; i < 2; ++i) {
                    const u32x4 w = *(const u32x4*)(Y + (size_t)s * D + i * 512 + lane * 8);
#pragma unroll
                    for (int j = 0; j < 4; ++j) { acc[i * 8 + 2 * j] += __uint_as_float(w[j] << 16); acc[i * 8 + 2 * j + 1] += __uint_as_float(w[j] & 0xffff0000u); }
                }
            }
        }
#pragma unroll
        for (int i = 0; i < 2; ++i)
#pragma unroll
            for (int j = 0; j < 2; ++j) {
                const int c = i * 512 + lane * 8 + j * 4;
                f32x4 x = *(const f32x4*)(dst + c); const f32x4 md = *(const f32x4*)(mod + c);
#pragma unroll
                for (int q = 0; q < 4; ++q) x[q] += md[q] * acc[i * 8 + j * 4 + q];
                *(f32x4*)(dst + c) = x;
            }
    }
}

#define XB_TMO      128
#define XB_XCNT(j)  (256  + 64 * (j))
#define XB_XSUB(j)  (1280 + 64 * (j))
#define XB_XGEN(j)  (2304 + 64 * (j))
#define XB_TOP      3328
#define XB_TOPGEN   3392
#define XCD_BAR_WORDS 3456
#define XB_SPIN_CAP (1u << 18)
#define LAS __attribute__((address_space(3)))

__device__ __forceinline__ unsigned xb_ld(unsigned* p)              { return __hip_atomic_load(p, __ATOMIC_RELAXED, __HIP_MEMORY_SCOPE_AGENT); }
__device__ __forceinline__ unsigned xb_add(unsigned* p, unsigned v) { return __hip_atomic_fetch_add(p, v, __ATOMIC_RELAXED, __HIP_MEMORY_SCOPE_AGENT); }
__device__ __forceinline__ unsigned xb_xcc_id() { return (unsigned)__builtin_amdgcn_s_getreg((3 << 11) | 20) & 0xFu; }
#define XB_SPIN(cond, bar) do { unsigned _sp = 0; while (cond) { __builtin_amdgcn_s_sleep(1); \
    if ((++_sp & 255u) == 0u) { if (xb_ld(&(bar)[XB_TMO])) break; if (_sp > XB_SPIN_CAP) { atomicAdd(&(bar)[XB_TMO], 1u); break; } } } } while (0)

struct XcdBarrier {
    unsigned* bar; unsigned x;
    volatile LAS unsigned* st;
};

__device__ __forceinline__ XcdBarrier xcd_barrier_post(unsigned* bar, volatile LAS unsigned* st) {
    XcdBarrier b; b.bar = bar; b.x = xb_xcc_id(); b.st = st;
    if (threadIdx.x == 0) (void)xb_add(&bar[XB_XCNT(b.x)], 1u);
    return b;
}
__device__ __forceinline__ void xcd_barrier_complete(unsigned* bar, unsigned x, unsigned& nloc, unsigned& nx) {
    const unsigned G = gridDim.x * gridDim.y * gridDim.z;
    unsigned sum, cnt, mine, sp = 0u;
    for (;;) {
        sum = 0u; cnt = 0u; mine = 0u;
#pragma unroll
        for (unsigned j = 0; j < 16; ++j) { const unsigned c = xb_ld(&bar[XB_XCNT(j)]); sum += c; cnt += (c > 0u) ? 1u : 0u; mine = (j == x) ? c : mine; }
        if (sum == G) break;
        __builtin_amdgcn_s_sleep(1);
        if ((++sp & 255u) == 0u) { if (xb_ld(&bar[XB_TMO])) break; if (sp > XB_SPIN_CAP) { atomicAdd(&bar[XB_TMO], 1u); break; } }
    }
    nloc = mine > 0u ? mine : 1u; nx = cnt > 0u ? cnt : 1u;
}

__device__ __forceinline__ void xcd_barrier(const XcdBarrier& b) {
    asm volatile("s_waitcnt vmcnt(0)" ::: "memory");
    __syncthreads();
    if (threadIdx.x == 0) {
        unsigned* bar = b.bar;
        __builtin_amdgcn_s_waitcnt(0);
        unsigned nloc = b.st[0], nx = b.st[1];
        if (nloc == 0u) { xcd_barrier_complete(bar, b.x, nloc, nx); b.st[0] = nloc; b.st[1] = nx; }
        const unsigned old = xb_add(&bar[XB_XSUB(b.x)], 1u);
        const unsigned gen = old / nloc;
        if (old + 1u == (gen + 1u) * nloc) {
            __builtin_amdgcn_fence(__ATOMIC_RELEASE, "agent");
            asm volatile("s_waitcnt vmcnt(0)" ::: "memory");
            const unsigned og = xb_add(&bar[XB_TOP], 1u);
            const unsigned tg = og / nx;
            if (og + 1u == (tg + 1u) * nx) xb_add(&bar[XB_TOPGEN], 1u);
            else XB_SPIN(xb_ld(&bar[XB_TOPGEN]) == tg, bar);
            __builtin_amdgcn_fence(__ATOMIC_ACQUIRE, "agent");
            xb_add(&bar[XB_XGEN(b.x)], 1u);
            asm volatile("s_waitcnt vmcnt(0)" ::: "memory");
        } else {
            XB_SPIN(xb_ld(&bar[XB_XGEN(b.x)]) == gen, bar);
            __builtin_amdgcn_fence(__ATOMIC_ACQUIRE, "agent");
            asm volatile("s_waitcnt vmcnt(0)" ::: "memory");
        }
    }
    __syncthreads();
}


enum { PH_WEIGHTS, PH_MOD, PH_HFILT, PH_NORM1, PH_G1, PH_PREP, PH_RECUR, PH_ATTN, PH_HYENA, PH_GATED, PH_MERGE, PH_WOUT, PH_NORM2, PH_TOPK, PH_MOE1, PH_MOE2, PH_COMBINE };

template <int PH>
__device__ __forceinline__ void run_phase(const P& p, int l, int grp, char* smem) {
    if (PH == PH_WEIGHTS) ph_weights(p, smem);
    if (PH == PH_MOD) ph_mod(p, smem);
    if (PH == PH_HFILT) ph_hfilt(p, smem);
    if (PH == PH_NORM1) ph_norm<0>(p, l, grp, smem);
    if (PH == PH_G1) ph_g1(p, l, smem);
    if (PH == PH_PREP) { ph_attn_prep(p, l); ph_v_prep(p, smem); ph_hy_prep(p, l, smem); }
    if (PH == PH_RECUR) ph_recur(p, l, smem);
    if (PH == PH_ATTN) ph_attn(p, l, smem);
    if (PH == PH_HYENA) ph_hyena(p, l, smem);
    if (PH == PH_GATED) ph_gated(p, l);
    if (PH == PH_MERGE) ph_merge(p, l, smem);
    if (PH == PH_WOUT) ph_wout(p, l, grp, smem);
    if (PH == PH_NORM2) ph_norm<1>(p, l, grp, smem);
    if (PH == PH_TOPK) ph_topk(p, l, smem);
    if (PH == PH_MOE1) ph_moe1(p, l, smem);
    if (PH == PH_MOE2) ph_moe2(p, l, smem);
    if (PH == PH_COMBINE) ph_combine(p, l, grp);
}

#if !FUSED
template <int PH>
__global__ void __launch_bounds__(NTHR, 2) k_phase(P p, int l, int grp) {
    extern __shared__ __attribute__((aligned(16))) char smem[];
    run_phase<PH>(p, l, grp, smem);
}

template <int PH>
static void launch_phase(const P& p, int l, int grp, int grid, hipStream_t stream) {
    static bool attr = false;
    if (!attr) { (void)hipFuncSetAttribute((const void*)k_phase<PH>, hipFuncAttributeMaxDynamicSharedMemorySize, SMEM_BYTES); attr = true; }
    k_phase<PH><<<grid, NTHR, SMEM_BYTES, stream>>>(p, l, grp);
}
#endif


#define GRID_SYNC() xcd_barrier(bar)
__global__ void __launch_bounds__(NTHR, 2) k_fused(P p) {
    extern __shared__ __attribute__((aligned(16))) char smem[];
    volatile LAS unsigned* xbw = (volatile LAS unsigned*)(smem + SMEM_BYTES);
    if (threadIdx.x == 0) { xbw[0] = 0u; xbw[1] = 0u; xbw[2] = 0u; xbw[3] = 0u; }
    __syncthreads();
    XcdBarrier bar = xcd_barrier_post(wsp<unsigned>(p, OFF_BAR), xbw);
    ph_weights(p, smem);
    ph_mod(p, smem);
    ph_hfilt(p, smem);
    GRID_SYNC();
    ph_hcopies(p);
#pragma unroll 1
    for (int grp = 0; grp < NGRP; ++grp) {
#pragma unroll 1
        for (int l = 0; l < NLAYER; ++l) {
            ph_norm<0>(p, l, grp, smem); GRID_SYNC();
            ph_g1(p, l, smem); GRID_SYNC();
            ph_attn_prep(p, l); ph_v_prep(p, smem); ph_hy_prep(p, l, smem); GRID_SYNC();
            ph_recur(p, l, smem); ph_attn(p, l, smem); ph_hyena(p, l, smem); GRID_SYNC();
            ph_gated(p, l); GRID_SYNC();
            ph_merge(p, l, smem); GRID_SYNC();
            ph_wout(p, l, grp, smem); GRID_SYNC();
            ph_norm<1>(p, l, grp, smem); GRID_SYNC();
            ph_topk(p, l, smem); GRID_SYNC();
            ph_moe1(p, l, smem); GRID_SYNC();
            ph_moe2(p, l, smem); GRID_SYNC();
            ph_combine(p, l, grp); GRID_SYNC();
        }
    }
}

extern "C" void kernel_launch(void* const* d_in, const int* in_sizes, int n_in, void* d_out, int out_size, void* d_ws, size_t ws_size, hipStream_t stream) {
    P p{};
    for (int i = 0; i < 33; ++i) p.in[i] = (const float*)d_in[i];
    p.out = (float*)d_out; p.ws = (char*)d_ws;
#if FUSED
    static int grid = 0;
    if (!grid) {
        int dev = 0, cus = 0, per_cu = 0;
        (void)hipGetDevice(&dev);
        (void)hipDeviceGetAttribute(&cus, hipDeviceAttributeMultiprocessorCount, dev);
        (void)hipFuncSetAttribute((const void*)k_fused, hipFuncAttributeMaxDynamicSharedMemorySize, SMEM_BYTES + 16);
        (void)hipOccupancyMaxActiveBlocksPerMultiprocessor(&per_cu, k_fused, NTHR, SMEM_BYTES + 16);
        grid = cus * (per_cu < 1 ? per_cu : 1);
        if (grid <= 0) grid = 256;
    }
    (void)hipMemsetAsync(d_ws, 0, XCD_BAR_WORDS * sizeof(unsigned), stream);
    k_fused<<<grid, NTHR, SMEM_BYTES + 16, stream>>>(p);
#else
    const int grid = 256;
    launch_phase<PH_WEIGHTS>(p, 0, 0, grid, stream);
    launch_phase<PH_MOD>(p, 0, 0, grid, stream);
    launch_phase<PH_HFILT>(p, 0, 0, grid, stream);
    for (int grp = 0; grp < NGRP; ++grp)
        for (int l = 0; l < NLAYER; ++l) {
            launch_phase<PH_NORM1>(p, l, grp, grid, stream);
            launch_phase<PH_G1>(p, l, grp, grid, stream);
            launch_phase<PH_PREP>(p, l, grp, grid, stream);
            launch_phase<PH_RECUR>(p, l, grp, grid, stream);
            launch_phase<PH_ATTN>(p, l, grp, grid, stream);
            launch_phase<PH_HYENA>(p, l, grp, grid, stream);
            launch_phase<PH_GATED>(p, l, grp, grid, stream);
            launch_phase<PH_MERGE>(p, l, grp, grid, stream);
            launch_phase<PH_WOUT>(p, l, grp, grid, stream);
            launch_phase<PH_NORM2>(p, l, grp, grid, stream);
            launch_phase<PH_TOPK>(p, l, grp, grid, stream);
            launch_phase<PH_MOE1>(p, l, grp, grid, stream);
            launch_phase<PH_MOE2>(p, l, grp, grid, stream);
            launch_phase<PH_COMBINE>(p, l, grp, grid, stream);
        }
#endif
}
```

```cpp
#include <hip/hip_runtime.h>
#include <stdint.h>


typedef unsigned short bf16_t;
typedef short bf16x8 __attribute__((ext_vector_type(8)));
typedef float f32x4 __attribute__((ext_vector_type(4)));
typedef unsigned u32x4 __attribute__((ext_vector_type(4)));
typedef unsigned u32x2 __attribute__((ext_vector_type(2)));

#define NTHR 512
constexpr int D = 1024, NB = 16, LQ = 4096, LC = 256, TT = 4352, NLAYER = 2;
constexpr int BG = 8, NGRP = NB / BG, R = BG * TT;
constexpr int NP1 = 3840;
constexpr int C_GQ = 0, C_GK = 128, C_GV = 256, C_GAF = 512, C_GAB = 528, C_GG = 544, C_HY = 800, C_HQ = 1568, C_HFF = 1824, C_HFB = 2080,
              C_HI = 2336, C_HGG = 2592, C_DQ = 2848, C_DK = 3104, C_DV = 3360, C_MG = 3616, N_IN = 7712;
constexpr int NEXP = 16, CAPL = 512, CAPC = 32, LATS = BG * NEXP * CAPL, NSLOT = LATS + BG * NEXP * CAPC;
constexpr int SMEM_BYTES = 132096;
constexpr int SMEM_TOTAL = SMEM_BYTES + 16 + 288;
constexpr int HY_UB = 8224, HY_HSTR = 8256, HY_NS = 515, HY_U_BYTES = 8 * HY_UB, HY_Z_OFF = HY_U_BYTES + 8 * HY_HSTR;
static_assert(HY_Z_OFF + 64 <= SMEM_BYTES, "hyena lds");

constexpr size_t al256(size_t x) { return (x + 255) & ~(size_t)255; }
constexpr size_t OFF_BAR = 0;
constexpr size_t OFF_BTIN1 = 65536;
constexpr size_t OFF_BTGATE = OFF_BTIN1 + (size_t)NLAYER * NP1 * D * 2;
constexpr size_t OFF_BTBR = OFF_BTGATE + (size_t)NLAYER * 4096 * D * 2;
constexpr size_t OFF_BTOUT = OFF_BTBR + (size_t)NLAYER * 4 * 1024 * 256 * 2;
constexpr size_t OFF_BTW13 = OFF_BTOUT + (size_t)NLAYER * D * D * 2;
constexpr size_t OFF_BTW2 = OFF_BTW13 + (size_t)NLAYER * NEXP * 2048 * D * 2;
constexpr size_t OFF_MODX = OFF_BTW2 + (size_t)NLAYER * NEXP * D * D * 2;
constexpr size_t OFF_MODC = OFF_MODX + (size_t)NLAYER * NB * 6144 * 4;
constexpr size_t OFF_HRAW = OFF_MODC + (size_t)NLAYER * 6144 * 4;
constexpr size_t HRAW_L = (size_t)512 * (LQ + LC);
constexpr size_t OFF_PSUM = OFF_HRAW + (size_t)NLAYER * HRAW_L * 4;
constexpr size_t OFF_XC = OFF_PSUM + (size_t)NLAYER * 68 * 512 * 4;
constexpr size_t OFF_HX = OFF_XC + (size_t)NB * LC * D * 4;
constexpr size_t OFF_BIG = OFF_HX + (size_t)R * D * 2;
constexpr size_t BIG_BYTES = (size_t)2 * NSLOT * D * 2;
constexpr size_t OFF_OUTS = OFF_BIG + BIG_BYTES;
constexpr size_t OFF_QA = OFF_OUTS + (size_t)R * D * 2;
constexpr size_t OFF_KA = OFF_QA + (size_t)BG * 4 * TT * 64 * 2;
constexpr size_t OFF_VA = OFF_KA + (size_t)BG * 4 * TT * 64 * 2;
constexpr size_t OFF_OBUF = OFF_VA + (size_t)BG * 4 * TT * 64 * 2;
constexpr size_t OFF_X1 = OFF_OBUF;
constexpr size_t OFF_HYT = OFF_OBUF + (size_t)4 * R * 256 * 2;
constexpr size_t OFF_AFF = OFF_HYT + (size_t)BG * 768 * TT * 2;
constexpr size_t OFF_INV = OFF_AFF + (size_t)BG * NEXP * TT * 4;
constexpr size_t OFF_SIDX = OFF_INV + (size_t)R * NEXP * 4;
constexpr size_t OFF_SGV = OFF_SIDX + (size_t)NSLOT * 4;
constexpr size_t OFF_HCOP = OFF_SGV + (size_t)NSLOT * 4;
constexpr size_t OFF_HYO = OFF_HCOP + (size_t)NLAYER * 512 * 8 * HY_HSTR;
constexpr size_t OFF_HX8 = OFF_HYO + (size_t)BG * 256 * LQ * 2;
constexpr size_t WS_END = OFF_HX8 + (size_t)R * D;
static_assert(WS_END < (size_t)1020 * 1024 * 1024, "workspace too big");
static_assert(BIG_BYTES >= (size_t)R * NP1 * 2, "big region");

struct P {
    const float* in[33];
    float* out;
    char* ws;
};
struct PV {
    const __attribute__((address_space(3))) unsigned* tab;
    __device__ __forceinline__ unsigned long long ptr(int i) const {
        const unsigned lo = __builtin_amdgcn_readfirstlane(tab[2 * i]), hi = __builtin_amdgcn_readfirstlane(tab[2 * i + 1]);
        return ((unsigned long long)hi << 32) | lo;
    }
    __device__ __forceinline__ const float* in(int i) const { return (const float*)(const __attribute__((address_space(1))) float*)ptr(i); }
    __device__ __forceinline__ float* out() const { return (float*)(__attribute__((address_space(1))) float*)ptr(33); }
    __device__ __forceinline__ char* ws() const { return (char*)(__attribute__((address_space(1))) char*)ptr(34); }
};

__device__ __forceinline__ bf16_t f2bf(float f) { unsigned u = __float_as_uint(f); u += 0x7fffu + ((u >> 16) & 1u); return (bf16_t)(u >> 16); }
__device__ __forceinline__ float bf2f(bf16_t h) { return __uint_as_float((unsigned)h << 16); }
typedef float f32x2 __attribute__((ext_vector_type(2)));
typedef __bf16 bf16x2_t __attribute__((ext_vector_type(2)));
__device__ __forceinline__ unsigned cvt_pk_bf16(float lo, float hi) { const f32x2 v = {lo, hi}; return __builtin_bit_cast(unsigned, __builtin_convertvector(v, bf16x2_t)); }
__device__ __forceinline__ unsigned pack2(float a, float b) { return cvt_pk_bf16(a, b); }
__device__ __forceinline__ float sigmoidf_(float x) { return __builtin_amdgcn_rcpf(1.0f + __expf(-x)); }
__device__ __forceinline__ float siluf_(float x) { return x * __builtin_amdgcn_rcpf(1.0f + __expf(-x)); }
__device__ __forceinline__ float wave_sum(float v) {
#pragma unroll
    for (int o = 32; o > 0; o >>= 1) v += __shfl_xor(v, o);
    return v;
}

template <class T> __device__ __forceinline__ T* wsp(const PV& p, size_t off) { return (T*)(p.ws() + off); }

__device__ __forceinline__ const float* stream_src(const PV& p, int l, int b, int pp) {
    if (pp < LC) return (l == 0 ? p.in(2) : wsp<const float>(p, OFF_XC)) + ((size_t)b * LC + pp) * D;
    return (l == 0 ? p.in(0) : (const float*)p.out()) + ((size_t)b * LQ + (pp - LC)) * D;
}
__device__ __forceinline__ float* stream_dst(const PV& p, int b, int pp) {
    if (pp < LC) return wsp<float>(p, OFF_XC) + ((size_t)b * LC + pp) * D;
    return p.out() + ((size_t)b * LQ + (pp - LC)) * D;
}

__device__ __forceinline__ int TID() { int t = threadIdx.x; asm volatile("" : "+v"(t)); return t; }
__device__ __forceinline__ int BID() { int t = blockIdx.x; asm volatile("" : "+s"(t)); return t; }

namespace pg8 {
#define PG8_LAS __attribute__((address_space(3)))
typedef unsigned short bf16_t;
typedef short bf16x8 __attribute__((ext_vector_type(8)));
typedef float f32x4 __attribute__((ext_vector_type(4)));
typedef unsigned u32x4 __attribute__((ext_vector_type(4)));
constexpr int BM = 256, BK = 64, HALF = 128, HTB = HALF * BK * 2  , STAGE_BYTES = 8 * HTB, NXCD = 8, WGM = 4;

__host__ __device__ __forceinline__ int lds_byte(int r, int c) { const int st = (r >> 4) * 2 + (c >> 5), rr = r & 15, cc = c & 31, ob = rr * 64 + cc * 2; return st * 1024 + (ob ^ (((ob >> 9) & 1) << 5)); }
__host__ __device__ __forceinline__ void stage_rc(int b, int& R, int& C) { const int st = b / 1024, sb = b % 1024, swz = sb ^ (((sb >> 9) & 1) << 5); R = (st >> 1) * 16 + swz / 64; C = (st & 1) * 32 + (swz % 64) / 2; }
__host__ __device__ __forceinline__ int perm32(int rho) { const int n = rho >> 4, i = rho & 15; return 8 * (i >> 2) + 4 * n + (i & 3); }

struct Unit { int pm, pn; unsigned bexp; int aofs; };
struct Gemm { const bf16_t* A; const bf16_t* Bt; int lda, ldb, K; size_t bstride; const int* gidx; };
template <class Epi, class Sched, bool GATHER = false, bool FP8 = false>
__device__ __forceinline__ void gemm_phase(PG8_LAS unsigned char* lds, const Gemm g, const Sched& S, const Epi& E) {
    constexpr bool STAMP = false; unsigned long long* stamps = nullptr;
    const int tid = TID(), wid = __builtin_amdgcn_readfirstlane(tid >> 6), lane = tid & 63, wr = wid >> 2, wc = wid & 3, fr = lane & 15, fq = lane >> 4;
    const int K = g.K, nt = K / BK;
    int ts_lo = 0, ts_hi = 0, nts = 0; const unsigned long long rt_entry = STAMP ? (unsigned long long)wall_clock64() : 0ull;
#define PG8_STAMP() do { if (STAMP && wid == 0 && nts < 64) { const unsigned long long _c = (unsigned long long)clock64(); \
        ts_lo = (lane == nts) ? (int)(unsigned)_c : ts_lo; ts_hi = (lane == nts) ? (int)(unsigned)(_c >> 32) : ts_hi; ++nts; } } while (0)
    PG8_STAMP();
    unsigned voffA[2], voffB[2]; int RA[2]; unsigned cofA[2];
#pragma unroll
    for (int i = 0; i < 2; ++i) { int R, C; stage_rc(tid * 16 + i * 8192, R, C); const int Rb = Epi::PERM ? ((R & ~31) + perm32(R & 31)) : R;
        voffA[i] = (unsigned)(R * g.lda + C) * 2u; voffB[i] = (unsigned)(Rb * g.ldb + C) * 2u; RA[i] = R; cofA[i] = (unsigned)C * 2u; }
    unsigned gofs[2], gnx[2], gsel[2];
    auto ldg = [&](const Unit& u, unsigned (&o)[2]) {
#pragma unroll
        for (int h = 0; h < 2; ++h) o[h] = (unsigned)g.gidx[u.pm * 256 + h * HALF + RA[0]] | ((unsigned)g.gidx[u.pm * 256 + h * HALF + RA[1]] << 16); };
    const unsigned rowb = (unsigned)(g.lda * 2);
#define PG8_STAGEA(bufoff, gbase, pk) do { if (GATHER) { const unsigned _o[2] = {((pk) & 0xffffu) * rowb + cofA[0], ((pk) >> 16) * rowb + cofA[1]}; PG8_STAGE(bufoff, gbase, _o); } else PG8_STAGE(bufoff, gbase, voffA); } while (0)
    const size_t kstep = (size_t)(BK * 2);
    const size_t hstepA = (size_t)HALF * g.lda * 2, hstepB = (size_t)HALF * g.ldb * 2;
    const size_t tstepA = 2 * hstepA, tstepB = 2 * hstepB; const size_t hsA = GATHER ? 0 : hstepA, tsA = GATHER ? 0 : tstepA;
    const unsigned ldsw = (unsigned)wid * 1024u;
    const int aoff = lds_byte(wr * 64 + fr, fq * 8), boff = lds_byte(wc * 32 + fr, fq * 8);
#define PG8_SA(b, h) (((b) * 2 + (h)) * HTB)
#define PG8_SB(b, h) ((4 + (b) * 2 + (h)) * HTB)
#define PG8_STAGE(bufoff, gbase, voff) do { _Pragma("unroll") for (int _i = 0; _i < 2; ++_i) \
        __builtin_amdgcn_global_load_lds((const unsigned*)((const char*)(gbase) + (voff)[_i]), (PG8_LAS unsigned*)(lds + (bufoff) + ldsw + _i * 8192), 16, 0, 0); } while (0)
    typedef int v4i_t __attribute__((ext_vector_type(4))); typedef int v8i_t __attribute__((ext_vector_type(8)));
#define PG8_CAT8(x0, x1) __builtin_shufflevector(x0, x1, 0, 1, 2, 3, 4, 5, 6, 7)
#define PG8_LDA(dst, b, h) do { if constexpr (FP8) { _Pragma("unroll") for (int m = 0; m < 4; ++m) dst##8[m] = PG8_CAT8(*(const PG8_LAS v4i_t*)(lds + PG8_SA(b, h) + aoff + m * 2048), *(const PG8_LAS v4i_t*)(lds + PG8_SA(b, h) + aoff + m * 2048 + 1024)); } \
        else { _Pragma("unroll") for (int m = 0; m < 4; ++m) _Pragma("unroll") for (int k = 0; k < 2; ++k) dst[m][k] = *(const PG8_LAS bf16x8*)(lds + PG8_SA(b, h) + aoff + m * 2048 + k * 1024); } } while (0)
#define PG8_LDB(dst, b, h) do { if constexpr (FP8) { _Pragma("unroll") for (int n = 0; n < 2; ++n) dst##8[n] = PG8_CAT8(*(const PG8_LAS v4i_t*)(lds + PG8_SB(b, h) + boff + n * 2048), *(const PG8_LAS v4i_t*)(lds + PG8_SB(b, h) + boff + n * 2048 + 1024)); } \
        else { _Pragma("unroll") for (int n = 0; n < 2; ++n) _Pragma("unroll") for (int k = 0; k < 2; ++k) dst[n][k] = *(const PG8_LAS bf16x8*)(lds + PG8_SB(b, h) + boff + n * 2048 + k * 1024); } } while (0)
#define PG8_MMA16(ai, bj, At, Bt) do { __builtin_amdgcn_s_setprio(1); _Pragma("unroll") for (int m = 0; m < 4; ++m) _Pragma("unroll") for (int n = 0; n < 2; ++n) _Pragma("unroll") for (int k = 0; k < 2; ++k) \
        acc[ai][bj][m][n] = __builtin_amdgcn_mfma_f32_16x16x32_bf16(Bt[n][k], At[m][k], acc[ai][bj][m][n], 0, 0, 0); __builtin_amdgcn_s_setprio(0); } while (0)
#define PG8_MMA8(ai, bj, At, Bt) do { __builtin_amdgcn_s_setprio(1); _Pragma("unroll") for (int m = 0; m < 4; ++m) _Pragma("unroll") for (int n = 0; n < 2; ++n) \
        asm volatile("v_mfma_scale_f32_16x16x128_f8f6f4 %0, %1, %2, %0, %3, %3 op_sel_hi:[0,0,0]" : "+v"(acc[ai][bj][m][n]) : "v"(Bt##8[n]), "v"(At##8[m]), "v"(sc127)); \
        __builtin_amdgcn_s_setprio(0); } while (0)
#define PG8_MMA(ai, bj, At, Bt) do { if constexpr (FP8) PG8_MMA8(ai, bj, At, Bt); else PG8_MMA16(ai, bj, At, Bt); } while (0)
#define PG8_WAIT_V(n) asm volatile("s_waitcnt vmcnt(" #n ")" ::: "memory")
#define PG8_WAIT_L(n) asm volatile("s_waitcnt lgkmcnt(" #n ")" ::: "memory")
#define PG8_BAR __builtin_amdgcn_s_barrier()
#define PG8_SCHED __builtin_amdgcn_sched_barrier(0)
    Unit cur, nxt; int ui = 0;
    if (!S.next(0, cur)) return;
    f32x4 acc[2][2][4][2];
#pragma unroll
    for (int a = 0; a < 2; ++a)
#pragma unroll
        for (int b = 0; b < 2; ++b)
#pragma unroll
            for (int m = 0; m < 4; ++m)
#pragma unroll
                for (int n = 0; n < 2; ++n) acc[a][b][m][n] = (f32x4){0.f, 0.f, 0.f, 0.f};
    bf16x8 At[4][2], B0[2][2], B1[2][2];
    v8i_t At8[4], B08[2], B18[2];
    int sc127 = 127; asm volatile("" : "+v"(sc127));
    const char* cA = (const char*)g.A + (size_t)cur.pm * tsA + (size_t)cur.aofs * 2; const char* cB = (const char*)g.Bt + ((size_t)cur.bexp * g.bstride) * 2 + (size_t)cur.pn * tstepB;
    S.a_ready(cur);
    if (GATHER) ldg(cur, gofs);
    PG8_STAGE(PG8_SB(0, 0), cB, voffB); PG8_STAGEA(PG8_SA(0, 0), cA, gofs[0]); PG8_STAGE(PG8_SB(0, 1), cB + hstepB, voffB); PG8_STAGEA(PG8_SA(0, 1), cA + hsA, gofs[1]);
    if (wr == 1) PG8_BAR;
    PG8_WAIT_V(4); PG8_BAR;
    PG8_STAGE(PG8_SB(1, 0), cB + kstep, voffB); PG8_STAGEA(PG8_SA(1, 0), cA + kstep, gofs[0]); PG8_STAGE(PG8_SB(1, 1), cB + hstepB + kstep, voffB);
    PG8_WAIT_V(6); PG8_BAR;
    PG8_STAMP();
    for (;;) {
        const bool has_next = S.next(ui + 1, nxt);
        if (GATHER) { if (has_next) ldg(nxt, gnx); else { gnx[0] = gofs[0]; gnx[1] = gofs[1]; } }
        const char* nA = has_next ? (const char*)g.A + (size_t)nxt.pm * tsA + (size_t)nxt.aofs * 2 : cA; const char* nB = has_next ? (const char*)g.Bt + ((size_t)nxt.bexp * g.bstride) * 2 + (size_t)nxt.pn * tstepB : cB;
#pragma unroll 1
        for (int t = 0; t < nt; t += 2) {
            const bool last = (t == nt - 2);
            if (GATHER) { gsel[0] = last ? gnx[0] : gofs[0]; gsel[1] = last ? gnx[1] : gofs[1]; }
            const char* a1 = cA + (size_t)(t + 1) * kstep;
            const char* a2 = last ? nA : cA + (size_t)(t + 2) * kstep; const char* b2 = last ? nB : cB + (size_t)(t + 2) * kstep;
            const char* a3 = a2 + kstep; const char* b3 = b2 + kstep;
            if (last && has_next) S.a_ready(nxt);
            PG8_LDB(B0, 0, 0); PG8_SCHED; PG8_LDA(At, 0, 0); PG8_STAGEA(PG8_SA(1, 1), a1 + hsA, gofs[1]);
            PG8_WAIT_L(8); PG8_BAR; PG8_WAIT_L(0); PG8_MMA(0, 0, At, B0); PG8_BAR; PG8_SCHED;
            PG8_LDB(B1, 0, 1); PG8_STAGE(PG8_SB(0, 0), b2, voffB);
            PG8_BAR; PG8_WAIT_L(0); PG8_MMA(0, 1, At, B1); PG8_BAR;
            PG8_LDA(At, 0, 1); PG8_STAGEA(PG8_SA(0, 0), a2, gsel[0]);
            PG8_BAR; PG8_WAIT_L(0); PG8_MMA(1, 0, At, B0); PG8_BAR; PG8_SCHED;
            PG8_STAGE(PG8_SB(0, 1), b2 + hstepB, voffB);
            PG8_WAIT_V(6); PG8_BAR; PG8_MMA(1, 1, At, B1); PG8_BAR;
            PG8_LDB(B0, 1, 0); PG8_SCHED; PG8_LDA(At, 1, 0); PG8_STAGEA(PG8_SA(0, 1), a2 + hsA, gsel[1]);
            PG8_WAIT_L(8); PG8_BAR; PG8_WAIT_L(0); PG8_MMA(0, 0, At, B0); PG8_BAR; PG8_SCHED;
            PG8_LDB(B1, 1, 1); PG8_STAGE(PG8_SB(1, 0), b3, voffB);
            PG8_BAR; PG8_WAIT_L(0); PG8_MMA(0, 1, At, B1); PG8_BAR;
            PG8_LDA(At, 1, 1); PG8_STAGEA(PG8_SA(1, 0), a3, gsel[0]);
            PG8_BAR; PG8_WAIT_L(0); PG8_MMA(1, 0, At, B0); PG8_BAR; PG8_SCHED;
            PG8_STAGE(PG8_SB(1, 1), b3 + hstepB, voffB);
            PG8_WAIT_V(6); PG8_BAR; PG8_MMA(1, 1, At, B1); PG8_BAR;
        }
        PG8_STAMP();
        if constexpr (FP8) asm volatile("s_nop 15\n\ts_nop 15" ::: "memory");
        if constexpr (!Epi::AFTER_DRAIN) { E(acc, cur, wr, wc, fr, fq); S.done(cur); }
        PG8_STAMP();
        if (!has_next) break;
#pragma unroll
        for (int a = 0; a < 2; ++a)
#pragma unroll
            for (int b = 0; b < 2; ++b)
#pragma unroll
                for (int m = 0; m < 4; ++m)
#pragma unroll
                    for (int n = 0; n < 2; ++n) acc[a][b][m][n] = (f32x4){0.f, 0.f, 0.f, 0.f};
        cur = nxt; cA = nA; cB = nB; ++ui;
        if (GATHER) { gofs[0] = gnx[0]; gofs[1] = gnx[1]; }
    }
    PG8_WAIT_V(0);
    if (wr == 0) PG8_BAR;
    PG8_BAR;
    if constexpr (Epi::AFTER_DRAIN) { E.fused(acc, cur, wr, wc, fr, fq, lds, wid, lane); S.done(cur); }
    PG8_STAMP();
    if (STAMP && wid == 0) { stamps[lane] = lane < nts ? (((unsigned long long)(unsigned)ts_hi << 32) | (unsigned)ts_lo) : 0ull;
        if (lane == 62) stamps[62] = rt_entry; if (lane == 63) stamps[63] = (unsigned long long)wall_clock64(); }
#undef PG8_STAMP
#undef PG8_SA
#undef PG8_SB
#undef PG8_STAGE
#undef PG8_LDA
#undef PG8_LDB
#undef PG8_MMA
#undef PG8_MMA8
#undef PG8_MMA16
#undef PG8_CAT8
#undef PG8_WAIT_V
#undef PG8_WAIT_L
#undef PG8_BAR
#undef PG8_SCHED
#undef PG8_STAGEA
}
}

struct WTile { const float* src; bf16_t* dst; int ldS, K, N, k0, n0, mode, which; };
constexpr int WT_L = 912 + 1024 + 256 + 256 + NEXP * 3 * 256;
__device__ __forceinline__ void wtile_decode(const PV& p, int t, WTile& d) {
    const int l = t / WT_L; int r = t % WT_L;
    d.mode = 0; d.which = 0; d.ldS = D; d.K = D; d.N = D;
    if (r < 1936) {
        const float* win = p.in(8) + (size_t)l * D * N_IN;
        d.ldS = N_IN;
        if (r < 912) { d.src = win; d.N = C_MG; d.dst = wsp<bf16_t>(p, OFF_BTIN1) + (size_t)l * NP1 * D; }
        else { r -= 912; d.src = win + C_MG; d.N = 4096; d.dst = wsp<bf16_t>(p, OFF_BTGATE) + (size_t)l * 4096 * D / 2; d.mode = 3;     }
        if (d.mode == 3) { d.n0 = (r & 63) * 64; d.k0 = (r >> 6) * 64; } else { d.n0 = (r % 57) * 64; d.k0 = (r / 57) * 64; }
    } else if (r < 2192) {
        r -= 1936; const int i = r >> 6, q = r & 63;
        d.src = p.in(27) + ((size_t)l * 4 + i) * 256 * D; d.K = 256; d.dst = wsp<bf16_t>(p, OFF_BTBR) + ((size_t)l * 4 + i) * 1024 * 256;
        d.n0 = (q & 15) * 64; d.k0 = (q >> 4) * 64;
    } else if (r < 2448) {
        r -= 2192; d.src = p.in(28) + (size_t)l * D * D; d.dst = wsp<bf16_t>(p, OFF_BTOUT) + (size_t)l * D * D;
        d.n0 = (r & 15) * 64; d.k0 = (r >> 4) * 64;
    } else {
        r -= 2448; const int e = r / 768, q = r % 768, mat = q >> 8, tq = q & 255; const size_t le = (size_t)l * NEXP + e;
        if (mat == 2) { d.src = p.in(32) + le * D * D; d.dst = wsp<bf16_t>(p, OFF_BTW2) + le * D * D; }
        else { d.src = p.in(mat == 0 ? 30 : 31) + le * D * D; d.dst = wsp<bf16_t>(p, OFF_BTW13) + le * 2048 * D; d.mode = 1; d.which = mat; }
        d.n0 = (tq & 15) * 64; d.k0 = (tq >> 4) * 64;
    }
}
constexpr int WQ_WORD = 3520;
__device__ __forceinline__ void ph_weights(const PV& p, char* smem) {
    float* tiles = (float*)smem;
    const int tid = TID();
    for (int l = 0; l < NLAYER; ++l) {
        bf16_t* bt1 = wsp<bf16_t>(p, OFF_BTIN1) + (size_t)l * NP1 * D;
        for (size_t i = (size_t)BID() * NTHR + tid; i < (size_t)(NP1 - C_MG) * D / 8; i += (size_t)gridDim.x * NTHR)
            *(u32x4*)(bt1 + (size_t)C_MG * D + i * 8) = (u32x4){0u, 0u, 0u, 0u};
    }
    constexpr int nchunk = NLAYER * WT_L / 4;
    static_assert(WT_L % 4 == 0, "chunking");
    unsigned* ctr = wsp<unsigned>(p, OFF_BAR) + WQ_WORD;
    volatile __attribute__((address_space(3))) unsigned* qw = (volatile __attribute__((address_space(3))) unsigned*)(smem + SMEM_BYTES + 16 + 280);
    const int li = tid >> 4, lj4 = (tid & 15) * 4;
    auto issue = [&](int c, f32x4 (&v)[4][2]) {
#pragma unroll
        for (int q = 0; q < 4; ++q) {
            WTile d; wtile_decode(p, c * 4 + q, d);
#pragma unroll
            for (int ps = 0; ps < 2; ++ps) {
                v[q][ps] = (f32x4){0.f, 0.f, 0.f, 0.f};
                if (d.n0 + lj4 < d.N) v[q][ps] = *(const f32x4*)(d.src + (size_t)(d.k0 + li + 32 * ps) * d.ldS + d.n0 + lj4);
            }
        }
    };
    __syncthreads();
    if (tid == 0) *qw = __hip_atomic_fetch_add(ctr, 2u, __ATOMIC_RELAXED, __HIP_MEMORY_SCOPE_AGENT);
    __syncthreads();
    int c0 = (int)__builtin_amdgcn_readfirstlane(*qw), c1 = c0 + 1;
    f32x4 cur[4][2], nxt[4][2];
#pragma unroll
    for (int q = 0; q < 4; ++q) { cur[q][0] = cur[q][1] = nxt[q][0] = nxt[q][1] = (f32x4){0.f, 0.f, 0.f, 0.f}; }
    if (c0 < nchunk) issue(c0, cur);
    if (c1 < nchunk) issue(c1, nxt);
    while (c0 < nchunk) {
        unsigned c2r = 0u;
        if (tid == 0) c2r = __hip_atomic_fetch_add(ctr, 1u, __ATOMIC_RELAXED, __HIP_MEMORY_SCOPE_AGENT);
        __syncthreads();
#pragma unroll
        for (int q = 0; q < 4; ++q)
#pragma unroll
            for (int ps = 0; ps < 2; ++ps) { const int i = li + 32 * ps; float* tile = tiles + q * (64 * 65);
                tile[i * 65 + lj4 + 0] = cur[q][ps][0]; tile[i * 65 + lj4 + 1] = cur[q][ps][1]; tile[i * 65 + lj4 + 2] = cur[q][ps][2]; tile[i * 65 + lj4 + 3] = cur[q][ps][3]; }
        __syncthreads();
#pragma unroll 1
        for (int q = 0; q < 4; ++q) {
            WTile d; wtile_decode(p, c0 * 4 + q, d);
            const float* tile = tiles + q * (64 * 65);
            const int n = tid >> 3, kc = (tid & 7) * 8;
            if (d.n0 + n < d.N) {
                const int ng = d.n0 + n;
                int drow = ng;
                if (d.mode == 1) drow = (ng >> 7) * 256 + d.which * 128 + (ng & 127);
                if (d.mode == 3) { const int i = ng >> 10, mc = ng & 1023; drow = (mc >> 6) * 256 + 128 * (i >> 1) + 32 * ((mc & 63) >> 4) + 16 * (i & 1) + (mc & 15); }
                if (d.mode == 3) {
                    int q0 = 0, q1 = 0;
                    q0 = __builtin_amdgcn_cvt_pk_fp8_f32(tile[(kc + 0) * 65 + n] * 32.f, tile[(kc + 1) * 65 + n] * 32.f, q0, false);
                    q0 = __builtin_amdgcn_cvt_pk_fp8_f32(tile[(kc + 2) * 65 + n] * 32.f, tile[(kc + 3) * 65 + n] * 32.f, q0, true);
                    q1 = __builtin_amdgcn_cvt_pk_fp8_f32(tile[(kc + 4) * 65 + n] * 32.f, tile[(kc + 5) * 65 + n] * 32.f, q1, false);
                    q1 = __builtin_amdgcn_cvt_pk_fp8_f32(tile[(kc + 6) * 65 + n] * 32.f, tile[(kc + 7) * 65 + n] * 32.f, q1, true);
                    *(u32x2*)((unsigned char*)d.dst + (size_t)drow * d.K + d.k0 + kc) = (u32x2){(unsigned)q0, (unsigned)q1};
                } else {
                    u32x4 w;
                    w[0] = pack2(tile[(kc + 0) * 65 + n], tile[(kc + 1) * 65 + n]);
                    w[1] = pack2(tile[(kc + 2) * 65 + n], tile[(kc + 3) * 65 + n]);
                    w[2] = pack2(tile[(kc + 4) * 65 + n], tile[(kc + 5) * 65 + n]);
                    w[3] = pack2(tile[(kc + 6) * 65 + n], tile[(kc + 7) * 65 + n]);
                    *(u32x4*)(d.dst + (size_t)drow * d.K + d.k0 + kc) = w;
                }
            }
        }
        if (tid == 0) *qw = c2r;
        __syncthreads();
        const int c2 = (int)__builtin_amdgcn_readfirstlane(*qw);
#pragma unroll
        for (int q = 0; q < 4; ++q) { cur[q][0] = nxt[q][0]; cur[q][1] = nxt[q][1]; }
        c0 = c1; c1 = c2;
        if (c1 < nchunk) issue(c1, nxt);
    }
    __syncthreads();
}

__device__ __forceinline__ void ph_mod(const PV& p, char* smem) {
    float* s = (float*)smem;
    float* red = s + 17 * 1024;
    const int tid = TID();
    for (int i = tid; i < 17 * 1024; i += NTHR) { const float v = i < 16384 ? p.in(1)[i] : p.in(3)[i - 16384]; s[i] = siluf_(v); }
    __syncthreads();
    for (int u = gridDim.x - 1 - BID(); u < NLAYER * 96; u += gridDim.x) {
        const int l = u / 96, col = (u % 96) * 64 + (tid & 63), ks = tid >> 6;
        const float* w = p.in(4) + (size_t)l * D * 6144 + col;
        float acc[17];
#pragma unroll
        for (int r = 0; r < 17; ++r) acc[r] = 0.f;
        for (int k0 = ks * 128; k0 < ks * 128 + 128; k0 += 16) {
            float wv[16];
#pragma unroll
            for (int q = 0; q < 16; ++q) wv[q] = w[(size_t)(k0 + q) * 6144];
#pragma unroll
            for (int q = 0; q < 16; ++q)
#pragma unroll
                for (int r = 0; r < 17; ++r) acc[r] += s[r * 1024 + k0 + q] * wv[q];
        }
#pragma unroll
        for (int r = 0; r < 17; ++r) red[(ks * 17 + r) * 64 + (tid & 63)] = acc[r];
        __syncthreads();
        for (int i = tid; i < 17 * 64; i += NTHR) {
            const int r = i / 64, c = i % 64, cg = (u % 96) * 64 + c;
            float v = p.in(5)[(size_t)l * 6144 + cg];
#pragma unroll
            for (int q = 0; q < 8; ++q) v += red[(q * 17 + r) * 64 + c];
            if (r < 16) wsp<float>(p, OFF_MODX)[((size_t)l * NB + r) * 6144 + cg] = v;
            else wsp<float>(p, OFF_MODC)[(size_t)l * 6144 + cg] = v;
        }
        __syncthreads();
    }
}

__device__ __forceinline__ void ph_hfilt(const PV& p, char* smem) {
    float* feats = (float*)smem;
    float* h1 = feats + 64 * 33;
    float* h2 = h1 + 64 * 64;
    const int tid = TID();
    for (int u = BID(); u < NLAYER * 68; u += gridDim.x) {
        const int l = u / 68, ub = u % 68, w = ub >= 64 ? 1 : 0, jb = w ? ub - 64 : ub, L = w ? LC : LQ;
        __syncthreads();
        for (int i = tid; i < 64 * 33; i += NTHR) {
            const int pos = i / 33, fi = i % 33; const float j = (float)(jb * 64 + pos);
            float v;
            if (fi == 0) v = j / (float)(L - 1);
            else {
                const int k = (fi - 1) & 15; const float f = 1e-4f + (float)k * ((15.0f - 1e-4f) / 15.0f);
                const float wv = 6.283185307179586f * j / (float)L;
                v = fi <= 16 ? cosf(wv * f) : -sinf(wv * f);
            }
            feats[i] = v;
        }
        __syncthreads();
        const float* w1 = p.in(13) + (size_t)l * 33 * 64; const float* b1 = p.in(14) + l * 64;
        const float* w2 = p.in(15) + (size_t)l * 64 * 64; const float* b2 = p.in(16) + l * 64;
        const float* w3 = p.in(17) + (size_t)l * 64 * 512; const float* fr = p.in(18) + l * 128;
        for (int i = tid; i < 64 * 64; i += NTHR) {
            const int pos = i >> 6, k = i & 63; float a = b1[k];
            float wq[33];
#pragma unroll
            for (int f = 0; f < 33; ++f) wq[f] = w1[f * 64 + k];
#pragma unroll
            for (int f = 0; f < 33; ++f) a += feats[pos * 33 + f] * wq[f];
            h1[i] = sinf(fr[k] * a);
        }
        __syncthreads();
        for (int i = tid; i < 64 * 64; i += NTHR) {
            const int pos = i >> 6, k = i & 63; float a = b2[k];
#pragma unroll
            for (int f0 = 0; f0 < 64; f0 += 16) {
                float wq[16];
#pragma unroll
                for (int f = 0; f < 16; ++f) wq[f] = w2[(f0 + f) * 64 + k];
#pragma unroll
                for (int f = 0; f < 16; ++f) a += h1[pos * 64 + f0 + f] * wq[f];
            }
            h2[i] = sinf(fr[64 + k] * a);
        }
        __syncthreads();
        {
            const int n = tid; float asum = 0.f;
            const float dec = fabsf(p.in(19)[(size_t)l * 512 + n]);
            float* hr = wsp<float>(p, OFF_HRAW) + (size_t)l * HRAW_L + (w ? (size_t)512 * LQ : 0) + (size_t)n * L + jb * 64;
            float w3c[64];
#pragma unroll
            for (int k = 0; k < 64; ++k) w3c[k] = w3[k * 512 + n];
            for (int pos = 0; pos < 64; ++pos) {
                float a = 0.f;
#pragma unroll
                for (int k = 0; k < 64; ++k) a += h2[pos * 64 + k] * w3c[k];
                const int j = jb * 64 + pos; const float dist = fabsf((float)(j - L / 2)) / (float)(L / 2);
                a *= __expf(-dist * dec) + 0.05f;
                hr[pos] = a; asum += fabsf(a);
            }
            wsp<float>(p, OFF_PSUM)[((size_t)l * 68 + ub) * 512 + n] = asum;
        }
    }
}

template <int WHICH>
__device__ __forceinline__ void ph_norm(const PV& p, int l, int grp, char* smem) {
    const int tid = TID(), lane = tid & 63, wid = tid >> 6;
    float* rt = (float*)smem;
    if (WHICH == 1) {
        const float* rsrc = p.in(29) + (size_t)l * D * NEXP;
#pragma unroll
        for (int i0 = 0; i0 < D * NEXP; i0 += NTHR * 8) {
            float t[8];
#pragma unroll
            for (int k = 0; k < 8; ++k) t[k] = rsrc[i0 + k * NTHR + tid];
#pragma unroll
            for (int k = 0; k < 8; ++k) { const int i = i0 + k * NTHR + tid; rt[(i & 15) * D + (i >> 4)] = t[k]; }
        }
        __syncthreads();
    }
    const float* gain = p.in(WHICH ? 7 : 6) + (size_t)l * D;
    bf16_t* hx = wsp<bf16_t>(p, OFF_HX);
    const bool compact = WHICH == 1 && l == NLAYER - 1; const int nrows = compact ? BG * LQ : R, qstride = gridDim.x * 8;
    auto rowof = [&](int q) { return compact ? (q / LQ) * TT + LC + (q % LQ) : q; };
    auto rowsrc = [&](int r) { const int bl = r / TT, pp = r % TT, b = grp * BG + bl; return WHICH == 0 ? stream_src(p, l, b, pp) : (const float*)stream_dst(p, b, pp); };
    const bf16_t* X1 = wsp<const bf16_t>(p, OFF_X1);
    f32x4 xn[4]; u32x2 xb[4];
    { const int q0 = BID() * 8 + wid; if (q0 < nrows) {
        if (WHICH == 0) { const float* s0 = rowsrc(rowof(q0));
#pragma unroll
            for (int i = 0; i < 4; ++i) xn[i] = *(const f32x4*)(s0 + i * 256 + lane * 4); }
        else {
#pragma unroll
            for (int i = 0; i < 4; ++i) xb[i] = *(const u32x2*)(X1 + (size_t)rowof(q0) * D + i * 256 + lane * 4); } } }
    for (int q = BID() * 8 + wid; q < nrows; q += qstride) {
        asm volatile("" ::: "memory");
        const int r = rowof(q);
        const int bl = r / TT, pp = r % TT, b = grp * BG + bl; const bool isctx = pp < LC;
        const float* mod = isctx ? wsp<const float>(p, OFF_MODC) + (size_t)l * 6144 : wsp<const float>(p, OFF_MODX) + ((size_t)l * NB + b) * 6144;
        const float* shp = mod + (WHICH ? 3 : 0) * D; const float* scp = mod + (WHICH ? 4 : 1) * D;
        f32x4 x[4]; float ss = 0.f;
#pragma unroll
        for (int i = 0; i < 4; ++i) {
            if (WHICH == 0) x[i] = xn[i];
            else x[i] = (f32x4){__uint_as_float(xb[i][0] << 16), __uint_as_float(xb[i][0] & 0xffff0000u), __uint_as_float(xb[i][1] << 16), __uint_as_float(xb[i][1] & 0xffff0000u)};
            ss += x[i][0] * x[i][0] + x[i][1] * x[i][1] + x[i][2] * x[i][2] + x[i][3] * x[i][3]; }
        if (q + qstride < nrows) {
            if (WHICH == 0) { const float* s1 = rowsrc(rowof(q + qstride));
#pragma unroll
                for (int i = 0; i < 4; ++i) xn[i] = *(const f32x4*)(s1 + i * 256 + lane * 4); }
            else {
#pragma unroll
                for (int i = 0; i < 4; ++i) xb[i] = *(const u32x2*)(X1 + (size_t)rowof(q + qstride) * D + i * 256 + lane * 4); } }
        ss = wave_sum(ss);
        const float rs = rsqrtf(ss * (1.0f / D) + 1e-6f);
        float lg[NEXP];
#pragma unroll
        for (int e = 0; e < NEXP; ++e) lg[e] = 0.f;
#pragma unroll
        for (int i = 0; i < 4; ++i) {
            const int c = i * 256 + lane * 4;
            const f32x4 g = *(const f32x4*)(gain + c), sh = *(const f32x4*)(shp + c), sc = *(const f32x4*)(scp + c);
            f32x4 y;
#pragma unroll
            for (int j = 0; j < 4; ++j) y[j] = x[i][j] * rs * g[j] * (1.0f + sc[j]) + sh[j];
            u32x2 w; w[0] = pack2(y[0], y[1]); w[1] = pack2(y[2], y[3]);
            *(u32x2*)(hx + (size_t)r * D + c) = w;
            if (WHICH == 0) {
                int q8 = 0; q8 = __builtin_amdgcn_cvt_pk_fp8_f32(y[0], y[1], q8, false); q8 = __builtin_amdgcn_cvt_pk_fp8_f32(y[2], y[3], q8, true);
                *(unsigned*)(wsp<unsigned char>(p, OFF_HX8) + (size_t)r * D + c) = (unsigned)q8;
            }
            if (WHICH == 1) {
#pragma unroll
                for (int e = 0; e < NEXP; ++e) { const f32x4 rv = *(const f32x4*)(rt + e * D + c); lg[e] += y[0] * rv[0] + y[1] * rv[1] + y[2] * rv[2] + y[3] * rv[3]; }
            }
        }
        if (WHICH == 1) {
            float v8[8], v4[4], v2[2], v1;
            { const bool hi = (lane & 32) != 0;
#pragma unroll
              for (int i = 0; i < 8; ++i) { const float keep = hi ? lg[i + 8] : lg[i], send = hi ? lg[i] : lg[i + 8]; v8[i] = keep + __shfl_xor(send, 32); } }
            { const bool hi = (lane & 16) != 0;
#pragma unroll
              for (int i = 0; i < 4; ++i) { const float keep = hi ? v8[i + 4] : v8[i], send = hi ? v8[i] : v8[i + 4]; v4[i] = keep + __shfl_xor(send, 16); } }
            { const bool hi = (lane & 8) != 0;
#pragma unroll
              for (int i = 0; i < 2; ++i) { const float keep = hi ? v4[i + 2] : v4[i], send = hi ? v4[i] : v4[i + 2]; v2[i] = keep + __shfl_xor(send, 8); } }
            { const bool hi = (lane & 4) != 0; const float keep = hi ? v2[1] : v2[0], send = hi ? v2[0] : v2[1]; v1 = keep + __shfl_xor(send, 4); }
            v1 += __shfl_xor(v1, 2); v1 += __shfl_xor(v1, 1);
            const int myexp = ((lane >> 5) & 1) * 8 + ((lane >> 4) & 1) * 4 + ((lane >> 3) & 1) * 2 + ((lane >> 2) & 1);
            float mx = v1;
#pragma unroll
            for (int o = 4; o < 64; o <<= 1) mx = fmaxf(mx, __shfl_xor(mx, o));
            const float ev = __expf(v1 - mx); float sum = ev;
#pragma unroll
            for (int o = 4; o < 64; o <<= 1) sum += __shfl_xor(sum, o);
            if ((lane & 3) == 0) {
                float* aff = wsp<float>(p, OFF_AFF);
                const float a = ev * __builtin_amdgcn_rcpf(sum);
                if (isctx) aff[(size_t)BG * NEXP * LQ + ((size_t)bl * NEXP + myexp) * LC + pp] = a;
                else aff[((size_t)bl * NEXP + myexp) * LQ + (pp - LC)] = a;
                wsp<int>(p, OFF_INV)[(size_t)r * NEXP + myexp] = -1;
            }
        }
    }
}

__device__ __forceinline__ void ph_norm2(const PV& p, int l, int grp, char* smem) {
    const int tid = TID(), lane = tid & 63, wid = tid >> 6;
    float* rt = (float*)smem;
    {
        const float* rsrc = p.in(29) + (size_t)l * D * NEXP;
#pragma unroll
        for (int i0 = 0; i0 < D * NEXP; i0 += NTHR * 8) {
            float t[8];
#pragma unroll
            for (int k = 0; k < 8; ++k) t[k] = rsrc[i0 + k * NTHR + tid];
#pragma unroll
            for (int k = 0; k < 8; ++k) { const int i = i0 + k * NTHR + tid; rt[(i & 15) * D + (i >> 4)] = t[k]; }
        }
        __syncthreads();
    }
    const float* gain = p.in(7) + (size_t)l * D;
    bf16_t* hx = wsp<bf16_t>(p, OFF_HX);
    const bf16_t* X1 = wsp<const bf16_t>(p, OFF_X1);
    const bool compact = l == NLAYER - 1; const int npairs = (compact ? BG * LQ : R) / 2, G = gridDim.x, ppc = (npairs + G - 1) / G;
    const int j0 = BID() * ppc, j1 = (j0 + ppc < npairs) ? j0 + ppc : npairs;
    auto rowof = [&](int q) { return compact ? (q / LQ) * TT + LC + (q % LQ) : q; };
    u32x2 xa[4], xb[4], xa2[4], xb2[4];
#pragma unroll
    for (int i = 0; i < 4; ++i) { xa[i] = (u32x2){0u, 0u}; xb[i] = (u32x2){0u, 0u}; xa2[i] = (u32x2){0u, 0u}; xb2[i] = (u32x2){0u, 0u}; }
    if (j0 + wid < j1) { const bf16_t* s0 = X1 + (size_t)rowof(2 * (j0 + wid)) * D + lane * 4;
#pragma unroll
        for (int i = 0; i < 4; ++i) { xa[i] = *(const u32x2*)(s0 + i * 256); xb[i] = *(const u32x2*)(s0 + D + i * 256); } }
    if (j0 + wid + 8 < j1) { const bf16_t* s0 = X1 + (size_t)rowof(2 * (j0 + wid + 8)) * D + lane * 4;
#pragma unroll
        for (int i = 0; i < 4; ++i) { xa2[i] = *(const u32x2*)(s0 + i * 256); xb2[i] = *(const u32x2*)(s0 + D + i * 256); } }
    int curkey = -1; f32x4 gsc[4], shv[4];
#pragma unroll
    for (int i = 0; i < 4; ++i) { gsc[i] = (f32x4){0.f, 0.f, 0.f, 0.f}; shv[i] = (f32x4){0.f, 0.f, 0.f, 0.f}; }
    for (int j = j0 + wid; j < j1; j += 8) {
        asm volatile("" ::: "memory");
        const int rA = rowof(2 * j), bl = rA / TT, pp = rA % TT, key = bl * 2 + (pp < LC ? 1 : 0);
        if (key != curkey) {
            const int b = grp * BG + bl;
            const float* mod = pp < LC ? wsp<const float>(p, OFF_MODC) + (size_t)l * 6144 : wsp<const float>(p, OFF_MODX) + ((size_t)l * NB + b) * 6144;
#pragma unroll
            for (int i = 0; i < 4; ++i) { const int c = i * 256 + lane * 4;
                const f32x4 g = *(const f32x4*)(gain + c), sc = *(const f32x4*)(mod + 4 * D + c); shv[i] = *(const f32x4*)(mod + 3 * D + c);
#pragma unroll
                for (int q = 0; q < 4; ++q) gsc[i][q] = g[q] * (1.0f + sc[q]); }
            curkey = key;
        }
        f32x4 x[2][4]; float ss[2] = {0.f, 0.f};
#pragma unroll
        for (int i = 0; i < 4; ++i) {
            x[0][i] = (f32x4){__uint_as_float(xa[i][0] << 16), __uint_as_float(xa[i][0] & 0xffff0000u), __uint_as_float(xa[i][1] << 16), __uint_as_float(xa[i][1] & 0xffff0000u)};
            x[1][i] = (f32x4){__uint_as_float(xb[i][0] << 16), __uint_as_float(xb[i][0] & 0xffff0000u), __uint_as_float(xb[i][1] << 16), __uint_as_float(xb[i][1] & 0xffff0000u)};
#pragma unroll
            for (int q = 0; q < 4; ++q) { ss[0] += x[0][i][q] * x[0][i][q]; ss[1] += x[1][i][q] * x[1][i][q]; }
        }
#pragma unroll
        for (int i = 0; i < 4; ++i) { xa[i] = xa2[i]; xb[i] = xb2[i]; }
        if (j + 16 < j1) { const bf16_t* s0 = X1 + (size_t)rowof(2 * (j + 16)) * D + lane * 4;
#pragma unroll
            for (int i = 0; i < 4; ++i) { xa2[i] = *(const u32x2*)(s0 + i * 256); xb2[i] = *(const u32x2*)(s0 + D + i * 256); } }
#pragma unroll
        for (int o = 32; o > 0; o >>= 1) { ss[0] += __shfl_xor(ss[0], o); ss[1] += __shfl_xor(ss[1], o); }
        const float rs[2] = {rsqrtf(ss[0] * (1.0f / D) + 1e-6f), rsqrtf(ss[1] * (1.0f / D) + 1e-6f)};
        float lg[2][NEXP];
#pragma unroll
        for (int e = 0; e < NEXP; ++e) { lg[0][e] = 0.f; lg[1][e] = 0.f; }
        bf16_t* hrow = hx + (size_t)rA * D + lane * 4;
#pragma unroll
        for (int i = 0; i < 4; ++i) {
            asm volatile("" ::: "memory");
            const int c = i * 256 + lane * 4;
            f32x4 y[2];
#pragma unroll
            for (int k = 0; k < 2; ++k)
#pragma unroll
                for (int q = 0; q < 4; ++q) y[k][q] = (x[k][i][q] * rs[k]) * gsc[i][q] + shv[i][q];
            { u32x2 w; w[0] = pack2(y[0][0], y[0][1]); w[1] = pack2(y[0][2], y[0][3]); *(u32x2*)(hrow + i * 256) = w; }
            { u32x2 w; w[0] = pack2(y[1][0], y[1][1]); w[1] = pack2(y[1][2], y[1][3]); *(u32x2*)(hrow + D + i * 256) = w; }
#pragma unroll
            for (int e = 0; e < NEXP; ++e) { const f32x4 rv = *(const f32x4*)(rt + e * D + c);
                lg[0][e] += y[0][0] * rv[0] + y[0][1] * rv[1] + y[0][2] * rv[2] + y[0][3] * rv[3];
                lg[1][e] += y[1][0] * rv[0] + y[1][1] * rv[1] + y[1][2] * rv[2] + y[1][3] * rv[3]; }
        }
        float v8[2][8], v4[2][4], v2[2][2], v1[2];
        { const bool hi = (lane & 32) != 0;
#pragma unroll
          for (int k = 0; k < 2; ++k)
#pragma unroll
            for (int i = 0; i < 8; ++i) { const float keep = hi ? lg[k][i + 8] : lg[k][i], send = hi ? lg[k][i] : lg[k][i + 8]; v8[k][i] = keep + __shfl_xor(send, 32); } }
        { const bool hi = (lane & 16) != 0;
#pragma unroll
          for (int k = 0; k < 2; ++k)
#pragma unroll
            for (int i = 0; i < 4; ++i) { const float keep = hi ? v8[k][i + 4] : v8[k][i], send = hi ? v8[k][i] : v8[k][i + 4]; v4[k][i] = keep + __shfl_xor(send, 16); } }
        { const bool hi = (lane & 8) != 0;
#pragma unroll
          for (int k = 0; k < 2; ++k)
#pragma unroll
            for (int i = 0; i < 2; ++i) { const float keep = hi ? v4[k][i + 2] : v4[k][i], send = hi ? v4[k][i] : v4[k][i + 2]; v2[k][i] = keep + __shfl_xor(send, 8); } }
        { const bool hi = (lane & 4) != 0;
#pragma unroll
          for (int k = 0; k < 2; ++k) { const float keep = hi ? v2[k][1] : v2[k][0], send = hi ? v2[k][0] : v2[k][1]; v1[k] = keep + __shfl_xor(send, 4); } }
#pragma unroll
        for (int k = 0; k < 2; ++k) { v1[k] += __shfl_xor(v1[k], 2); }
#pragma unroll
        for (int k = 0; k < 2; ++k) { v1[k] += __shfl_xor(v1[k], 1); }
        const int myexp = ((lane >> 5) & 1) * 8 + ((lane >> 4) & 1) * 4 + ((lane >> 3) & 1) * 2 + ((lane >> 2) & 1);
        float mx[2] = {v1[0], v1[1]};
#pragma unroll
        for (int o = 4; o < 64; o <<= 1) { mx[0] = fmaxf(mx[0], __shfl_xor(mx[0], o)); mx[1] = fmaxf(mx[1], __shfl_xor(mx[1], o)); }
        const float ev[2] = {__expf(v1[0] - mx[0]), __expf(v1[1] - mx[1])}; float sum[2] = {ev[0], ev[1]};
#pragma unroll
        for (int o = 4; o < 64; o <<= 1) { sum[0] += __shfl_xor(sum[0], o); sum[1] += __shfl_xor(sum[1], o); }
        if ((lane & 3) == 0) {
            float* aff = wsp<float>(p, OFF_AFF);
            const f32x2 a2 = {ev[0] * __builtin_amdgcn_rcpf(sum[0]), ev[1] * __builtin_amdgcn_rcpf(sum[1])};
            if (pp < LC) *(f32x2*)(aff + (size_t)BG * NEXP * LQ + ((size_t)bl * NEXP + myexp) * LC + pp) = a2;
            else *(f32x2*)(aff + ((size_t)bl * NEXP + myexp) * LQ + (pp - LC)) = a2;
            int* inv = wsp<int>(p, OFF_INV) + (size_t)rA * NEXP + myexp;
            inv[0] = -1; inv[NEXP] = -1;
        }
    }
}

__device__ __forceinline__ int mtile_expert(int mt) { return mt < LATS / 256 ? mt / (2 * BG) : mt - LATS / 256; }
struct SOrder {
    int nM, nN, nwg, G, c, mode;
    __device__ void init(int nM_, int nN_, int mode_) { nM = nM_; nN = nN_; nwg = nM * nN; G = gridDim.x; c = BID(); mode = mode_; }
    __device__ bool next(int i, pg8::Unit& u) const {
        const long L = (long)i * G + c; if (L >= nwg) return false;
        int wgid = (int)L; { const int q = nwg / pg8::NXCD, r = nwg % pg8::NXCD, xcd = wgid % pg8::NXCD, off = wgid / pg8::NXCD; wgid = (xcd < r ? xcd * (q + 1) : r * (q + 1) + (xcd - r) * q) + off; }
        const int nig = pg8::WGM * nN, gid = wgid / nig, fm = gid * pg8::WGM, gsz = (nM - fm) < pg8::WGM ? (nM - fm) : pg8::WGM;
        int pm = fm + ((wgid % nig) % gsz); u.pn = (wgid % nig) / gsz;
        if (mode & 8) pm = nM - 1 - pm;
        if (mode & 1) pm = (pm >> 4) * 17 + 1 + (pm & 15);
        u.pm = pm; u.bexp = (mode & 2) ? (unsigned)mtile_expert(pm) : 0u; u.aofs = (mode & 4) ? (u.pn >> 2) * 256 : 0;
        return true;
    }
    __device__ __forceinline__ void a_ready(const pg8::Unit&) const {}
    __device__ __forceinline__ void done(const pg8::Unit&) const {}
};
struct EpiStoreBf16 {
    static constexpr bool PERM = true, AFTER_DRAIN = false;
    bf16_t* O; int ldc; const float* rowscale;
    __device__ __forceinline__ void operator()(const f32x4 (&acc)[2][2][4][2], const pg8::Unit& u, int wr, int wc, int fr, int fq) const {
        const int row0 = u.pm * 256 + wr * 64 + fr, col0 = u.pn * 256 + wc * 32 + 8 * fq;
#pragma unroll
        for (int ai = 0; ai < 2; ++ai)
#pragma unroll
            for (int m = 0; m < 4; ++m) {
                const int row = row0 + ai * 128 + m * 16; const float s = rowscale ? rowscale[row] : 1.0f;
                bf16_t* rowp = O + (size_t)row * ldc + col0;
#pragma unroll
                for (int bj = 0; bj < 2; ++bj) { const f32x4 v0 = acc[ai][bj][m][0] * s, v1 = acc[ai][bj][m][1] * s;
                    u32x4 w; w[0] = pack2(v0[0], v0[1]); w[1] = pack2(v0[2], v0[3]); w[2] = pack2(v1[0], v1[1]); w[3] = pack2(v1[2], v1[3]);
                    *(u32x4*)(rowp + bj * 128) = w; }
            }
    }
};
struct EpiSwiglu {
    static constexpr bool PERM = true, AFTER_DRAIN = false;
    bf16_t* H;
    __device__ __forceinline__ void operator()(const f32x4 (&acc)[2][2][4][2], const pg8::Unit& u, int wr, int wc, int fr, int fq) const {
        const int row0 = u.pm * 256 + wr * 64 + fr, col0 = u.pn * 128 + wc * 32 + 8 * fq;
#pragma unroll
        for (int ai = 0; ai < 2; ++ai)
#pragma unroll
            for (int m = 0; m < 4; ++m) {
                float hv[8];
#pragma unroll
                for (int n = 0; n < 2; ++n)
#pragma unroll
                    for (int j = 0; j < 4; ++j) hv[n * 4 + j] = siluf_(acc[ai][0][m][n][j]) * acc[ai][1][m][n][j];
                u32x4 w; w[0] = pack2(hv[0], hv[1]); w[1] = pack2(hv[2], hv[3]); w[2] = pack2(hv[4], hv[5]); w[3] = pack2(hv[6], hv[7]);
                *(u32x4*)(H + (size_t)(row0 + ai * 128 + m * 16) * D + col0) = w;
            }
    }
};
struct EpiResid {
    static constexpr bool PERM = true, AFTER_DRAIN = false;
    const PV* pp; int l, grp;
    __device__ __forceinline__ void operator()(const f32x4 (&acc)[2][2][4][2], const pg8::Unit& u, int wr, int wc, int fr, int fq) const {
        const PV& p = *pp;
        const int bl = u.pm / 17, p0 = (u.pm % 17) * 256, b = grp * BG + bl;
        const float* mod = (p0 < LC ? wsp<const float>(p, OFF_MODC) + (size_t)l * 6144 : wsp<const float>(p, OFF_MODX) + ((size_t)l * NB + b) * 6144) + 2 * D;
        const int col0 = u.pn * 256 + wc * 32 + 8 * fq;
        bf16_t* X1 = wsp<bf16_t>(p, OFF_X1);
        f32x4 mv[2][2];
#pragma unroll
        for (int bj = 0; bj < 2; ++bj)
#pragma unroll
            for (int n = 0; n < 2; ++n) mv[bj][n] = *(const f32x4*)(mod + col0 + bj * 128 + n * 4);
        f32x4 sc[4], sn[4];
        { const float* s0 = stream_src(p, l, b, p0 + wr * 64 + fr) + col0;
#pragma unroll
          for (int q = 0; q < 4; ++q) sc[q] = *(const f32x4*)(s0 + (q >> 1) * 128 + (q & 1) * 4); }
#pragma unroll
        for (int g = 0; g < 8; ++g) {
            const int ai = g >> 2, m = g & 3;
            const int pq = p0 + ai * 128 + wr * 64 + m * 16 + fr;
            if (g + 1 < 8) { const float* s1 = stream_src(p, l, b, p0 + ((g + 1) >> 2) * 128 + wr * 64 + ((g + 1) & 3) * 16 + fr) + col0;
#pragma unroll
                for (int q = 0; q < 4; ++q) sn[q] = *(const f32x4*)(s1 + (q >> 1) * 128 + (q & 1) * 4); }
            asm volatile("" ::: "memory");
            bf16_t* dst = X1 + (size_t)(bl * TT + pq) * D + col0;
#pragma unroll
            for (int bj = 0; bj < 2; ++bj) {
                const f32x4 v0 = sc[bj * 2] + mv[bj][0] * acc[ai][bj][m][0], v1 = sc[bj * 2 + 1] + mv[bj][1] * acc[ai][bj][m][1];
                u32x4 w; w[0] = pack2(v0[0], v0[1]); w[1] = pack2(v0[2], v0[3]); w[2] = pack2(v1[0], v1[1]); w[3] = pack2(v1[2], v1[3]);
                *(u32x4*)(dst + bj * 128) = w;
            }
#pragma unroll
            for (int q = 0; q < 4; ++q) sc[q] = sn[q];
        }
    }
};

__device__ __forceinline__ void ph_g1(const PV& p, int l, char* smem) {
    pg8::Gemm g; g.A = wsp<const bf16_t>(p, OFF_HX); g.Bt = wsp<const bf16_t>(p, OFF_BTIN1) + (size_t)l * NP1 * D; g.lda = D; g.ldb = D; g.K = D; g.bstride = 0; g.gidx = nullptr;
    SOrder S; S.init(R / 256, NP1 / 256, 0);
    EpiStoreBf16 E; E.O = wsp<bf16_t>(p, OFF_BIG); E.ldc = NP1; E.rowscale = nullptr;
    __syncthreads();
    pg8::gemm_phase(( PG8_LAS unsigned char*)smem, g, S, E);
    __syncthreads();
}

__device__ __forceinline__ void ph_attn_prep(const PV& p, int l, char* smem) {
    const int tid = TID(), lane = tid & 63, wid = tid >> 6;
    float* rt = (float*)smem;
    __syncthreads();
    { const int pos = tid >> 3, i = tid & 7; float sn, cs; sincosf((float)pos * exp2f(-(float)i * (13.287712379549449f / 8.0f)), &sn, &cs); rt[tid * 2] = cs; rt[tid * 2 + 1] = sn; }
    __syncthreads();
    const bf16_t* proj = wsp<const bf16_t>(p, OFF_BIG);
    bf16_t* Qa = wsp<bf16_t>(p, OFF_QA); bf16_t* Ka = wsp<bf16_t>(p, OFF_KA);
    const int j = lane & 7, d0 = j * 4;
    const float* gq = p.in(23) + l * 32; const float* gk = p.in(24) + l * 32;
    const f32x4 gqv = *(const f32x4*)(gq + d0), gkv = *(const f32x4*)(gk + d0);
    u32x2 nq = {0u, 0u}, nk = {0u, 0u};
    { const int r0 = BID() * 8 + wid; if (r0 < R) { nq = *(const u32x2*)(proj + (size_t)r0 * NP1 + C_DQ + lane * 4); nk = *(const u32x2*)(proj + (size_t)r0 * NP1 + C_DK + lane * 4); } }
    for (int r = BID() * 8 + wid; r < R; r += gridDim.x * 8) {
        const u32x2 cq = nq, ck = nk;
        { const int r1 = r + gridDim.x * 8; if (r1 < R) { nq = *(const u32x2*)(proj + (size_t)r1 * NP1 + C_DQ + lane * 4); nk = *(const u32x2*)(proj + (size_t)r1 * NP1 + C_DK + lane * 4); } }
        const int bl = r / TT, pp = r % TT; const bool lat = pp >= LC; const int t = pp - LC;
        const int h = lane >> 4;
        float cs[4], sn[4];
        if (lat) {
            const int pos = (j < 4) ? (t >> 6) : (t & 63);
            const f32x4 a = *(const f32x4*)(rt + (pos * 8 + (j & 1) * 4) * 2), b = *(const f32x4*)(rt + (pos * 8 + (j & 1) * 4) * 2 + 4);
            cs[0] = a[0]; sn[0] = a[1]; cs[1] = a[2]; sn[1] = a[3]; cs[2] = b[0]; sn[2] = b[1]; cs[3] = b[2]; sn[3] = b[3];
        }
#pragma unroll
        for (int which = 0; which < 2; ++which) {
            const u32x2 raw = which ? ck : cq;
            float v[4] = {bf2f((bf16_t)(raw[0] & 0xffff)), bf2f((bf16_t)(raw[0] >> 16)), bf2f((bf16_t)(raw[1] & 0xffff)), bf2f((bf16_t)(raw[1] >> 16))};
            float ss = v[0] * v[0] + v[1] * v[1] + v[2] * v[2] + v[3] * v[3];
            ss += __shfl_xor(ss, 1); ss += __shfl_xor(ss, 2); ss += __shfl_xor(ss, 4);
            const float rs = rsqrtf(ss * (1.0f / 32.0f) + 1e-6f);
            const f32x4 g = which ? gkv : gqv;
#pragma unroll
            for (int c = 0; c < 4; ++c) v[c] = v[c] * rs * g[c];
            if (lat) {
#pragma unroll
                for (int c = 0; c < 4; ++c) {
                    const float o = __shfl_xor(v[c], 2);
                    v[c] = (j & 2) ? (o * sn[c] + v[c] * cs[c]) : (v[c] * cs[c] - o * sn[c]);
                }
            }
            if (!which) {
#pragma unroll
                for (int c = 0; c < 4; ++c) v[c] *= 0.17677669529663687f * 1.4426950408889634f;
            }
            u32x2 w; w[0] = pack2(v[0], v[1]); w[1] = pack2(v[2], v[3]);
            *(u32x2*)((which ? Ka : Qa) + (((size_t)bl * 4 + h) * TT + pp) * 64 + (lane & 15) * 4) = w;
        }
    }
}

__device__ __forceinline__ void ph_v_prep(const PV& p, char* smem) {
    bf16_t* tile = (bf16_t*)smem;
    const int tid = TID();
    const bf16_t* proj = wsp<const bf16_t>(p, OFF_BIG);
    bf16_t* Vt = wsp<bf16_t>(p, OFF_VA);
    constexpr int NTT = TT / 64;
    const int total = BG * NTT * 4, G = gridDim.x;
    const int tok = tid >> 3, c8 = (tid & 7) * 8;
    u32x4 cur = {0u, 0u, 0u, 0u}, nxt = {0u, 0u, 0u, 0u};
    int u = BID();
    if (u < total) { const int h = u & 3, tt = (u >> 2) % NTT, bl = u / (4 * NTT); cur = *(const u32x4*)(proj + (size_t)(bl * TT + tt * 64 + tok) * NP1 + C_DV + h * 64 + c8); }
    for (; u < total; u += G) {
        const int h = u & 3, tt = (u >> 2) % NTT, bl = u / (4 * NTT);
        if (u + G < total) { const int u2 = u + G, h2 = u2 & 3, tt2 = (u2 >> 2) % NTT, bl2 = u2 / (4 * NTT); nxt = *(const u32x4*)(proj + (size_t)(bl2 * TT + tt2 * 64 + tok) * NP1 + C_DV + h2 * 64 + c8); }
        __syncthreads();
        *(u32x4*)(tile + tok * 72 + c8) = cur;
        __syncthreads();
        const int dv = tid >> 3, t8 = (tid & 7) * 8;
        u32x4 w;
#pragma unroll
        for (int j = 0; j < 4; ++j) w[j] = (unsigned)tile[(t8 + 2 * j) * 72 + dv] | ((unsigned)tile[(t8 + 2 * j + 1) * 72 + dv] << 16);
        *(u32x4*)(Vt + (((size_t)bl * 4 + h) * 64 + dv) * TT + tt * 64 + t8) = w;
        cur = nxt;
    }
}

__device__ __forceinline__ void ph_hy_prep(const PV& p, int l, char* smem) {
    float* tile = (float*)smem;
    const int tid = TID();
    const bf16_t* proj = wsp<const bf16_t>(p, OFF_BIG);
    bf16_t* hyT = wsp<bf16_t>(p, OFF_HYT);
    const float* cw = p.in(12) + (size_t)l * 3 * 768;
    constexpr int NTT = TT / 64;
    const int total = BG * NTT * 12, G = gridDim.x;
    u32x2 c0 = {0u, 0u}, c1 = {0u, 0u}, c2 = {0u, 0u}, n0 = {0u, 0u}, n1 = {0u, 0u}, n2 = {0u, 0u};
#define HYP_LOAD(uu, r0, r1, r2) do { const int _ct = (uu) % 12, _tt = ((uu) / 12) % NTT, _bl = (uu) / (12 * NTT), _p0 = _tt * 64; \
        const int _s0 = _p0 >= LC ? LC : 0, _sl = _p0 >= LC ? LQ : LC; \
        { const int i = tid, rr = i >> 4, c4 = (i & 15) * 4, pp = _p0 - 1 + rr; r0 = (u32x2){0u, 0u}; if (pp >= _s0 && pp < _s0 + _sl) r0 = *(const u32x2*)(proj + (size_t)(_bl * TT + pp) * NP1 + C_HY + _ct * 64 + c4); } \
        { const int i = tid + 512, rr = i >> 4, c4 = (i & 15) * 4, pp = _p0 - 1 + rr; r1 = (u32x2){0u, 0u}; if (pp >= _s0 && pp < _s0 + _sl) r1 = *(const u32x2*)(proj + (size_t)(_bl * TT + pp) * NP1 + C_HY + _ct * 64 + c4); } \
        { const int i = tid + 1024, rr = i >> 4, c4 = (i & 15) * 4, pp = _p0 - 1 + rr; r2 = (u32x2){0u, 0u}; if (i < 66 * 16 && pp >= _s0 && pp < _s0 + _sl) r2 = *(const u32x2*)(proj + (size_t)(_bl * TT + pp) * NP1 + C_HY + _ct * 64 + c4); } } while (0)
#define HYP_PUT(i, r) do { const int rr = (i) >> 4, c4 = ((i) & 15) * 4; tile[rr * 65 + c4] = __uint_as_float(r[0] << 16); tile[rr * 65 + c4 + 1] = __uint_as_float(r[0] & 0xffff0000u); \
        tile[rr * 65 + c4 + 2] = __uint_as_float(r[1] << 16); tile[rr * 65 + c4 + 3] = __uint_as_float(r[1] & 0xffff0000u); } while (0)
    int u = BID();
    if (u < total) HYP_LOAD(u, c0, c1, c2);
    for (; u < total; u += G) {
        const int ct = u % 12, tt = (u / 12) % NTT, bl = u / (12 * NTT);
        const int p0 = tt * 64; const bool lat = p0 >= LC;
        if (u + G < total) HYP_LOAD(u + G, n0, n1, n2);
        __syncthreads();
        HYP_PUT(tid, c0); HYP_PUT(tid + 512, c1); if (tid + 1024 < 66 * 16) HYP_PUT(tid + 1024, c2);
        __syncthreads();
        const int ch = tid >> 3, t8 = (tid & 7) * 8, cg = ct * 64 + ch;
        const float w0 = cw[cg], w1 = cw[768 + cg], w2 = cw[1536 + cg];
        float o[8];
#pragma unroll
        for (int q = 0; q < 8; ++q) { const int rr = t8 + q + 1; o[q] = tile[(rr - 1) * 65 + ch] * w0 + tile[rr * 65 + ch] * w1 + tile[(rr + 1) * 65 + ch] * w2; }
        bf16_t* dst = lat ? hyT + ((size_t)bl * 768 + cg) * LQ + (p0 - LC) + t8 : hyT + (size_t)BG * 768 * LQ + ((size_t)bl * 768 + cg) * LC + p0 + t8;
        u32x4 w; w[0] = pack2(o[0], o[1]); w[1] = pack2(o[2], o[3]); w[2] = pack2(o[4], o[5]); w[3] = pack2(o[6], o[7]);
        *(u32x4*)dst = w;
        c0 = n0; c1 = n1; c2 = n2;
    }
#undef HYP_LOAD
#undef HYP_PUT
}

__device__ __forceinline__ int kmaj_off(int row, int chunk) { return row * 160 + (((chunk ^ (row >> 3)) & 7) << 4); }
template <int DK, int BR>
__device__ __forceinline__ void recur_chunk_unit(const PV& p, int l, int bl, int h, int dir, char* smem) {
    constexpr int RS = DK == 64 ? 160 : 96, NKC = DK / 32, NDT = DK / 16, NST = NDT / 2, VPT = DK / 8, NTG = NTHR / DK, TG = 64 / NTG;
    float* Bf = (float*)smem;
    float* Gp = Bf + 64 * DK;
    float* Bref = Gp + 16 * DK;
    float* Bend = Bref + DK;
    float* Wa = Bend + DK;
    char* Qs = (char*)(Wa + 512);
    char* Ks = Qs + 64 * RS;
    char* STs = Ks + 64 * RS;
    char* KTs = STs + 64 * RS;
    char* Vts = KTs + DK * 160;
    const int tid = TID(), lane = tid & 63, wid = tid >> 6, fr = lane & 15, fq = lane >> 4;
    const int st = tid >> 3, sc = tid & 7;
    const int stq = BR == 1 ? st : (wid & 3) * 16 + fr, d0 = BR == 1 ? sc * VPT : (wid >> 2) * 16 + fq * 4;
    const int tt = wid & 3, eh = wid >> 2;
    const bf16_t* proj = wsp<const bf16_t>(p, OFF_BIG);
    bf16_t* obuf = wsp<bf16_t>(p, OFF_OBUF) + ((size_t)dir * 2 + BR) * R * 256;
    __syncthreads();
    float lbv[VPT];
#pragma unroll
    for (int j = 0; j < VPT; ++j) lbv[j] = 0.f;
    if (BR == 1 && l == 1) {
        const float* hl = p.in(21);
#pragma unroll
        for (int j = 0; j < VPT; ++j) { const float a0 = hl[(0 * 2 + dir) * 256 + h * 64 + d0 + j], a1 = hl[(1 * 2 + dir) * 256 + h * 64 + d0 + j]; lbv[j] = 1.0f / (1.0f + __expf(a0 - a1)); }
    }
    float bav[VPT];
#pragma unroll
    for (int j = 0; j < VPT; ++j) bav[j] = 0.f;
    u32x4 wahi = {0u, 0u, 0u, 0u}, walo = {0u, 0u, 0u, 0u};
    if (BR == 0) {
        const float* wa2 = p.in(9) + ((size_t)l * 2 + dir) * 16 * 128; const float* ba = p.in(10) + ((size_t)l * 2 + dir) * 128;
        if (fq < 2) {
            float wv[8];
#pragma unroll
            for (int jj = 0; jj < 8; ++jj) wv[jj] = wa2[(fq * 8 + jj) * 128 + h * 32 + (wid >> 2) * 16 + fr];
#pragma unroll
            for (int jj = 0; jj < 8; jj += 2) {
                const unsigned hi = pack2(wv[jj], wv[jj + 1]);
                const float r0 = wv[jj] - __uint_as_float(hi << 16), r1 = wv[jj + 1] - __uint_as_float(hi & 0xffff0000u);
                wahi[jj >> 1] = hi; walo[jj >> 1] = pack2(r0, r1);
            }
        }
#pragma unroll
        for (int j = 0; j < VPT; ++j) bav[j] = ba[h * 32 + d0 + j];
    }
    __syncthreads();
    f32x4 S[NST];
#pragma unroll
    for (int i = 0; i < NST; ++i) S[i] = (f32x4){0.f, 0.f, 0.f, 0.f};
    float gmask[NTG];
#pragma unroll
    for (int g = 0; g < NTG; ++g) gmask[g] = (dir ? (g > tid / DK) : (g < tid / DK)) ? 1.0f : 0.0f;
    u32x4 rq = {0u, 0u, 0u, 0u}, rk = {0u, 0u, 0u, 0u}, rv = {0u, 0u, 0u, 0u}, ra0 = {0u, 0u, 0u, 0u}, ra1 = {0u, 0u, 0u, 0u};
    auto chunk_pos = [&](int ci) { return dir == 0 ? ci : (ci < 4 ? 3 - ci : 67 - (ci - 4)); };
    auto load_raw = [&](int ci) {
        const bf16_t* row = proj + (size_t)(bl * TT + chunk_pos(ci) * 64 + st) * NP1;
        if (BR == 1) {
            rq = *(const u32x4*)(row + C_HQ + h * 64 + d0); rk = *(const u32x4*)(row + (dir ? C_HFB : C_HFF) + h * 64 + d0); rv = *(const u32x4*)(row + C_HI + h * 64 + sc * 8);
        } else {
            const bf16_t* rowq = proj + (size_t)(bl * TT + chunk_pos(ci) * 64 + stq) * NP1;
            const u32x2 a = *(const u32x2*)(rowq + C_GQ + h * 32 + d0), b = *(const u32x2*)(rowq + C_GK + h * 32 + d0);
            rq[0] = a[0]; rq[1] = a[1]; rk[0] = b[0]; rk[1] = b[1];
            ra0 = (u32x4){0u, 0u, 0u, 0u};
            if (fq < 2) ra0 = *(const u32x4*)(rowq + (dir ? C_GAB : C_GAF) + fq * 8);
            rv = *(const u32x4*)(row + C_GV + h * 64 + sc * 8);
        }
    };
    load_raw(0);
#pragma unroll 1
    for (int ci = 0; ci < TT / 64; ++ci) {
        const int cp = chunk_pos(ci);
        float qv[VPT], kv[VPT], lg[VPT];
        f32x4 z4 = {0.f, 0.f, 0.f, 0.f};
        if (BR == 0) {
            z4 = __builtin_amdgcn_mfma_f32_16x16x32_bf16(__builtin_bit_cast(bf16x8, wahi), __builtin_bit_cast(bf16x8, ra0), z4, 0, 0, 0);
            z4 = __builtin_amdgcn_mfma_f32_16x16x32_bf16(__builtin_bit_cast(bf16x8, walo), __builtin_bit_cast(bf16x8, ra0), z4, 0, 0, 0);
        }
#pragma unroll
        for (int j = 0; j < VPT; ++j) {
            const unsigned wq = rq[j >> 1], wk = rk[j >> 1];
            const float qr = (j & 1) ? __uint_as_float(wq & 0xffff0000u) : __uint_as_float(wq << 16);
            const float kr = (j & 1) ? __uint_as_float(wk & 0xffff0000u) : __uint_as_float(wk << 16);
            if (BR == 1) {
                qv[j] = siluf_(qr);
                const float sg = sigmoidf_(kr), f = lbv[j] + (1.0f - lbv[j]) * sg;
                lg[j] = __builtin_amdgcn_logf(fmaxf(f, 1e-20f)) * 0.6931471805599453f;
                kv[j] = (1.0f - lbv[j]) * (1.0f - sg);
            } else {
                qv[j] = qr * 0.17677669529663687f; kv[j] = kr;
                const float z = bav[j] + z4[j & 3];
                lg[j] = (fminf(z, 0.f) - __builtin_amdgcn_logf(1.0f + __expf(-fabsf(z))) * 0.6931471805599453f) * (1.0f / 16.0f);
            }
        }
#pragma unroll
        for (int j = 0; j < VPT; j += 4) *(f32x4*)(Bf + stq * DK + d0 + j) = (f32x4){lg[j], lg[j + 1], lg[j + 2], lg[j + 3]};
#pragma unroll
        for (int j = 0; j < 8; ++j) { const unsigned w = rv[j >> 1]; *(bf16_t*)(Vts + kmaj_off(sc * 8 + j, st >> 3) + (st & 7) * 2) = (bf16_t)((j & 1) ? (w >> 16) : (w & 0xffffu)); }
        if (ci + 1 < TT / 64) load_raw(ci + 1);
        __syncthreads();
        {
            const int sd = tid % DK, tg = tid / DK;
            float lv[TG];
#pragma unroll
            for (int i = 0; i < TG; ++i) lv[i] = Bf[(tg * TG + i) * DK + sd];
            if (dir) {
#pragma unroll
                for (int i = TG - 2; i >= 0; --i) lv[i] += lv[i + 1];
            } else {
#pragma unroll
                for (int i = 1; i < TG; ++i) lv[i] += lv[i - 1];
            }
            Gp[tg * DK + sd] = dir ? lv[0] : lv[TG - 1];
            __syncthreads();
            float gq[NTG];
#pragma unroll
            for (int g = 0; g < NTG; ++g) gq[g] = Gp[g * DK + sd];
            float off = 0.f;
#pragma unroll
            for (int g = 0; g < NTG; ++g) off += gmask[g] * gq[g];
#pragma unroll
            for (int i = 0; i < TG; ++i) Bf[(tg * TG + i) * DK + sd] = lv[i] + off;
            const float vsel = (dir ? lv[0] : lv[TG - 1]) + off;
            if (tg == (dir ? 32 / TG : 31 / TG)) Bref[sd] = vsel;
            if (tg == (dir ? 0 : NTG - 1)) Bend[sd] = vsel;
        }
        __syncthreads();
        {
            unsigned qp[VPT / 2], kp[VPT / 2];
            float bfv[VPT], brv[VPT];
#pragma unroll
            for (int j = 0; j < VPT; j += 4) { const f32x4 t0 = *(const f32x4*)(Bf + stq * DK + d0 + j), t1 = *(const f32x4*)(Bref + d0 + j);
                bfv[j] = t0[0]; bfv[j + 1] = t0[1]; bfv[j + 2] = t0[2]; bfv[j + 3] = t0[3]; brv[j] = t1[0]; brv[j + 1] = t1[1]; brv[j + 2] = t1[2]; brv[j + 3] = t1[3]; }
#pragma unroll
            for (int j = 0; j < VPT; j += 2) {
                const float b0 = bfv[j], b1 = bfv[j + 1], r0 = brv[j], r1 = brv[j + 1];
                const float e0 = __expf(b0 - r0), e1 = __expf(b1 - r1);
                const float q0 = qv[j] * e0, q1 = qv[j + 1] * e1, k0 = kv[j] * __builtin_amdgcn_rcpf(e0), k1 = kv[j + 1] * __builtin_amdgcn_rcpf(e1);
                qp[j >> 1] = pack2(q0, q1); kp[j >> 1] = pack2(k0, k1);
                *(bf16_t*)(KTs + kmaj_off(d0 + j, stq >> 3) + (stq & 7) * 2) = (bf16_t)(kp[j >> 1] & 0xffffu);
                *(bf16_t*)(KTs + kmaj_off(d0 + j + 1, stq >> 3) + (stq & 7) * 2) = (bf16_t)(kp[j >> 1] >> 16);
            }
            if (VPT == 8) { *(u32x4*)(Qs + stq * RS + d0 * 2) = (u32x4){qp[0], qp[1], qp[2 % (VPT / 2)], qp[3 % (VPT / 2)]}; *(u32x4*)(Ks + stq * RS + d0 * 2) = (u32x4){kp[0], kp[1], kp[2 % (VPT / 2)], kp[3 % (VPT / 2)]}; }
            else { *(u32x2*)(Qs + stq * RS + d0 * 2) = (u32x2){qp[0], qp[1]}; *(u32x2*)(Ks + stq * RS + d0 * 2) = (u32x2){kp[0], kp[1]}; }
#pragma unroll
            for (int i = 0; i < NST; ++i) {
                const int id = wid * NST + i, et = id / NDT, dt = id % NDT, d = dt * 16 + fr;
                const float er = __expf(Bref[d]);
                const unsigned s01 = pack2(S[i][0] * er, S[i][1] * er), s23 = pack2(S[i][2] * er, S[i][3] * er);
                *(bf16_t*)(STs + (et * 16 + fq * 4 + 0) * RS + d * 2) = (bf16_t)(s01 & 0xffffu); *(bf16_t*)(STs + (et * 16 + fq * 4 + 1) * RS + d * 2) = (bf16_t)(s01 >> 16);
                *(bf16_t*)(STs + (et * 16 + fq * 4 + 2) * RS + d * 2) = (bf16_t)(s23 & 0xffffu); *(bf16_t*)(STs + (et * 16 + fq * 4 + 3) * RS + d * 2) = (bf16_t)(s23 >> 16);
            }
        }
        __syncthreads();
        {
            bf16x8 qf[NKC];
#pragma unroll
            for (int kc = 0; kc < NKC; ++kc) qf[kc] = *(const bf16x8*)(Qs + (tt * 16 + fr) * RS + kc * 64 + fq * 16);
            u32x4 pk[2];
#pragma unroll
            for (int pr = 0; pr < 2; ++pr) {
                float sv[2][4];
#pragma unroll
                for (int half = 0; half < 2; ++half) {
                    const int stl = pr * 2 + half;
                    const bool allowed = dir ? (stl >= tt) : (stl <= tt);
                    f32x4 c = {0.f, 0.f, 0.f, 0.f};
#pragma unroll
                    for (int kc = 0; kc < NKC; ++kc) {
                        const bf16x8 kf = *(const bf16x8*)(Ks + (stl * 16 + fr) * RS + kc * 64 + fq * 16);
                        c = __builtin_amdgcn_mfma_f32_16x16x32_bf16(kf, qf[kc], c, 0, 0, 0);
                    }
#pragma unroll
                    for (int rg = 0; rg < 4; ++rg) {
                        const int s = fq * 4 + rg;
                        const bool keep = allowed && ((stl != tt) || (dir ? (s >= fr) : (s <= fr)));
                        sv[half][rg] = keep ? c[rg] : 0.f;
                    }
                }
                pk[pr][0] = pack2(sv[0][0], sv[0][1]); pk[pr][1] = pack2(sv[0][2], sv[0][3]); pk[pr][2] = pack2(sv[1][0], sv[1][1]); pk[pr][3] = pack2(sv[1][2], sv[1][3]);
            }
#pragma unroll
            for (int ei = 0; ei < 2; ++ei) {
                const int et = eh * 2 + ei;
                f32x4 O = {0.f, 0.f, 0.f, 0.f};
#pragma unroll
                for (int pr = 0; pr < 2; ++pr) {
                    const u32x2 a = *(const u32x2*)(Vts + kmaj_off(et * 16 + fr, pr * 4 + (fq >> 1)) + (fq & 1) * 8);
                    const u32x2 b = *(const u32x2*)(Vts + kmaj_off(et * 16 + fr, pr * 4 + 2 + (fq >> 1)) + (fq & 1) * 8);
                    const u32x4 cv = {a[0], a[1], b[0], b[1]};
                    O = __builtin_amdgcn_mfma_f32_16x16x32_bf16(__builtin_bit_cast(bf16x8, cv), __builtin_bit_cast(bf16x8, pk[pr]), O, 0, 0, 0);
                }
#pragma unroll
                for (int kc = 0; kc < NKC; ++kc) {
                    const bf16x8 sf = *(const bf16x8*)(STs + (et * 16 + fr) * RS + kc * 64 + fq * 16);
                    O = __builtin_amdgcn_mfma_f32_16x16x32_bf16(sf, qf[kc], O, 0, 0, 0);
                }
                { u32x2 ow; ow[0] = pack2(O[0], O[1]); ow[1] = pack2(O[2], O[3]); *(u32x2*)(obuf + (size_t)(bl * TT + cp * 64 + tt * 16 + fr) * 256 + h * 64 + et * 16 + fq * 4) = ow; }
            }
#pragma unroll
            for (int i = 0; i < NST; ++i) {
                const int id = wid * NST + i, et = id / NDT, dt = id % NDT, d = dt * 16 + fr;
                f32x4 A = {0.f, 0.f, 0.f, 0.f};
#pragma unroll
                for (int k2 = 0; k2 < 2; ++k2) {
                    const bf16x8 vf = *(const bf16x8*)(Vts + kmaj_off(et * 16 + fr, k2 * 4 + fq));
                    const bf16x8 kt = *(const bf16x8*)(KTs + kmaj_off(dt * 16 + fr, k2 * 4 + fq));
                    A = __builtin_amdgcn_mfma_f32_16x16x32_bf16(vf, kt, A, 0, 0, 0);
                }
                const float be = Bend[d], e1 = __expf(be), e2 = __expf(be - Bref[d]);
#pragma unroll
                for (int rg = 0; rg < 4; ++rg) S[i][rg] = e1 * S[i][rg] + e2 * A[rg];
            }
        }
        __syncthreads();
    }
}

__device__ __forceinline__ void ph_hcopies(const PV& p) {
    const int tid = TID();
    for (int u = BID(); u < NLAYER * 512; u += gridDim.x) {
        const int l = u / 512, n = u % 512;
        const float* hr = wsp<const float>(p, OFF_HRAW) + (size_t)l * HRAW_L + (size_t)n * LQ;
        const float* psum = wsp<const float>(p, OFF_PSUM) + (size_t)l * 68 * 512;
        float sc = 0.f;
        for (int q = 0; q < 64; ++q) sc += psum[q * 512 + n];
        const float inv = 1.0f / sc;
        char* dst = wsp<char>(p, OFF_HCOP) + (size_t)u * (8 * HY_HSTR);
        for (int i = tid; i < 8 * HY_NS; i += NTHR) {
            const int kap = i / HY_NS, s = i % HY_NS; const int y0 = 8 * s + kap - 16;
            float v[8];
#pragma unroll
            for (int e = 0; e < 8; ++e) { const int y = y0 + e; v[e] = (y >= 0 && y < LQ) ? hr[LQ - 1 - y] * inv : 0.f; }
            u32x4 w; w[0] = pack2(v[0], v[1]); w[1] = pack2(v[2], v[3]); w[2] = pack2(v[4], v[5]); w[3] = pack2(v[6], v[7]);
            *(u32x4*)(dst + kap * HY_HSTR + s * 16) = w;
        }
    }
}

__device__ __forceinline__ void hyena_mfma_unit(const PV& p, int l, int c, char* smem) {
    const int tid = TID(), lane = tid & 63, wid = tid >> 6, fr = lane & 15, fq = lane >> 4;
    const int sg = fr >> 3;
    char* Us = smem; char* Hs = smem + HY_U_BYTES; const char* zero16 = smem + HY_Z_OFF;
    const bf16_t* hyT = wsp<const bf16_t>(p, OFF_HYT);
    bf16_t* outs = wsp<bf16_t>(p, OFF_OUTS);
    __syncthreads();
    {
        u32x4 t[8];
#pragma unroll
        for (int k = 0; k < 8; ++k) t[k] = *(const u32x4*)(hyT + ((size_t)k * 768 + c) * LQ + tid * 8);
#pragma unroll
        for (int k = 0; k < 8; ++k) *(u32x4*)(Us + k * HY_UB + tid * 16) = t[k];
    }
    if (tid < 4) ((unsigned*)(smem + HY_Z_OFF))[tid] = 0u;
    const int tw = wid * 256;
    const int c0 = fq + (fr < 8 ? 1 : 0);
    const char* hl = Hs + ((7 - fr) & 7) * HY_HSTR;
#pragma unroll 1
    for (int o = 0; o < 2; ++o) {
        const char* hc = wsp<const char>(p, OFF_HCOP) + ((size_t)l * 512 + o * 256 + c) * (8 * HY_HSTR);
        {
            u32x4 t[8];
#pragma unroll
            for (int k = 0; k < 8; ++k) t[k] = *(const u32x4*)(hc + (k * NTHR + tid) * 16);
            u32x4 tl = {0u, 0u, 0u, 0u};
            if (tid < 8 * HY_HSTR / 16 - 8 * NTHR) tl = *(const u32x4*)(hc + (8 * NTHR + tid) * 16);
#pragma unroll
            for (int k = 0; k < 8; ++k) *(u32x4*)(Hs + (k * NTHR + tid) * 16) = t[k];
            if (tid < 8 * HY_HSTR / 16 - 8 * NTHR) *(u32x4*)(Hs + (8 * NTHR + tid) * 16) = tl;
        }
        __syncthreads();
        f32x4 acc[16];
#pragma unroll
        for (int m = 0; m < 16; ++m) acc[m] = (f32x4){0.f, 0.f, 0.f, 0.f};
        bf16x8 F[16];
#pragma unroll
        for (int q = 2; q < 16; ++q) { int s = -2 * q + c0; s = s < 0 ? 0 : s; F[q] = *(const bf16x8*)(hl + s * 16); }
        auto ldA = [&](int sraw) { const int s = sraw < 0 ? 0 : (sraw > HY_NS - 1 ? HY_NS - 1 : sraw); return *(const bf16x8*)(hl + s * 16); };
        auto ldB = [&](int j) { const int sidx = tw - 2048 + 32 * j + sg * 2048;
            const char* ba = ((unsigned)sidx < 4096u) ? (Us + (fr & 7) * HY_UB + (sidx + 8 * fq) * 2) : zero16; return *(const bf16x8*)ba; };
        bf16x8 N0 = ldA(c0), N1 = ldA(c0 - 2), Bn = ldB(0);
#pragma unroll 1
        for (int jo = 0; jo < 17; ++jo) {
#pragma unroll
            for (int ji = 0; ji < 8; ++ji) {
                const int j = jo * 8 + ji;
                F[(16 - 2 * ji) & 15] = N0; F[(17 - 2 * ji) & 15] = N1;
                const bf16x8 B = Bn;
                N0 = ldA(4 * (j + 1) + c0); N1 = ldA(4 * (j + 1) - 2 + c0); Bn = ldB(j + 1);
#pragma unroll
                for (int m = 0; m < 16; ++m) acc[m] = __builtin_amdgcn_mfma_f32_16x16x32_bf16(F[(m - 2 * ji) & 15], B, acc[m], 0, 0, 0);
            }
        }
        __syncthreads();
        const float bias = p.in(20)[((size_t)l * 2 + o) * 256 + c];
        const int tid2 = TID(), fr2 = tid2 & 15, fq2 = (tid2 >> 4) & 3, b = fr2 & 7, sg2 = fr2 >> 3, tw2 = (tid2 >> 6) * 256;
        const bf16_t* gp = hyT + ((size_t)b * 768 + (o + 1) * 256 + c) * LQ;
        u32x2 grv[16];
#pragma unroll
        for (int m = 0; m < 16; ++m) grv[m] = *(const u32x2*)(gp + tw2 + 16 * m + sg2 * 2048 + 4 * fq2);
        bf16_t* dstp = o == 0 ? (bf16_t*)(Us + b * HY_UB) : wsp<bf16_t>(p, OFF_HYO) + ((size_t)b * 256 + c) * LQ;
        if (o == 0) {
#pragma unroll
            for (int m = 0; m < 16; ++m) {
                const int t = tw2 + 16 * m + sg2 * 2048 + 4 * fq2;
                const u32x2 gr = grv[m];
                const u32x2 zr = *(const u32x2*)(Us + b * HY_UB + t * 2);
                const float r0 = __uint_as_float(gr[0] << 16) * (acc[m][0] + bias * __uint_as_float(zr[0] << 16)), r1 = __uint_as_float(gr[0] & 0xffff0000u) * (acc[m][1] + bias * __uint_as_float(zr[0] & 0xffff0000u));
                const float r2 = __uint_as_float(gr[1] << 16) * (acc[m][2] + bias * __uint_as_float(zr[1] << 16)), r3 = __uint_as_float(gr[1] & 0xffff0000u) * (acc[m][3] + bias * __uint_as_float(zr[1] & 0xffff0000u));
                u32x2 w; w[0] = pack2(r0, r1); w[1] = pack2(r2, r3);
                *(u32x2*)(Us + b * HY_UB + t * 2) = w;
            }
        } else {
#pragma unroll
            for (int m = 0; m < 16; ++m) {
                const int t = tw2 + 16 * m + sg2 * 2048 + 4 * fq2;
                const u32x2 gr = grv[m];
                const u32x2 zr = *(const u32x2*)(Us + b * HY_UB + t * 2);
                const float r0 = __uint_as_float(gr[0] << 16) * (acc[m][0] + bias * __uint_as_float(zr[0] << 16)), r1 = __uint_as_float(gr[0] & 0xffff0000u) * (acc[m][1] + bias * __uint_as_float(zr[0] & 0xffff0000u));
                const float r2 = __uint_as_float(gr[1] << 16) * (acc[m][2] + bias * __uint_as_float(zr[1] << 16)), r3 = __uint_as_float(gr[1] & 0xffff0000u) * (acc[m][3] + bias * __uint_as_float(zr[1] & 0xffff0000u));
                u32x2 w; w[0] = pack2(r0, r1); w[1] = pack2(r2, r3);
                *(u32x2*)(dstp + t) = w;
            }
        }
        __syncthreads();
    }
}

__device__ __forceinline__ void hyena_ctx_unit(const PV& p, int l, int c, char* smem) {
    float* up = (float*)smem;
    float* hS = up + BG * 512;
    const int tid = TID(), b = tid >> 6, t0 = (tid & 63) * 4;
    const bf16_t* hyT = wsp<const bf16_t>(p, OFF_HYT) + (size_t)BG * 768 * LQ;
    const float* hraw = wsp<const float>(p, OFF_HRAW) + (size_t)l * HRAW_L + (size_t)512 * LQ;
    const float* psum = wsp<const float>(p, OFF_PSUM) + (size_t)l * 68 * 512 + 64 * 512;
    bf16_t* outs = wsp<bf16_t>(p, OFF_OUTS);
    __syncthreads();
    float z[4];
    {
        const u32x2 raw = *(const u32x2*)(hyT + ((size_t)b * 768 + c) * LC + t0);
        z[0] = __uint_as_float(raw[0] << 16); z[1] = __uint_as_float(raw[0] & 0xffff0000u); z[2] = __uint_as_float(raw[1] << 16); z[3] = __uint_as_float(raw[1] & 0xffff0000u);
        float* ub0 = up + b * 512; const int q2 = (tid & 63) * 2;
        ub0[128 + t0] = z[0]; ub0[128 + t0 + 1] = z[1]; ub0[128 + t0 + 2] = z[2]; ub0[128 + t0 + 3] = z[3];
        ub0[q2] = 0.f; ub0[q2 + 1] = 0.f; ub0[384 + q2] = 0.f; ub0[384 + q2 + 1] = 0.f;
    }
#pragma unroll 1
    for (int o = 0; o < 2; ++o) {
        const int n = o * 256 + c;
        const float inv = 1.0f / (psum[n] + psum[512 + n] + psum[1024 + n] + psum[1536 + n]);
        if (tid < LC) hS[tid] = hraw[(size_t)n * LC + tid];
        __syncthreads();
        float acc[4] = {0.f, 0.f, 0.f, 0.f}, w[4];
        const float* ub = up + b * 512 + t0 + 256;
#pragma unroll
        for (int i = 0; i < 4; ++i) w[i] = ub[i];
#pragma unroll 4
        for (int j = 0; j < LC; ++j) {
            const float hj = hS[j];
#pragma unroll
            for (int i = 0; i < 4; ++i) acc[i] += hj * w[i];
            w[3] = w[2]; w[2] = w[1]; w[1] = w[0]; w[0] = ub[-(j + 1)];
        }
        const float bias = p.in(20)[((size_t)l * 2 + o) * 256 + c];
        {
            const u32x2 gr = *(const u32x2*)(hyT + ((size_t)b * 768 + (o + 1) * 256 + c) * LC + t0);
            const float gt[4] = {__uint_as_float(gr[0] << 16), __uint_as_float(gr[0] & 0xffff0000u), __uint_as_float(gr[1] << 16), __uint_as_float(gr[1] & 0xffff0000u)};
#pragma unroll
            for (int i = 0; i < 4; ++i) z[i] = gt[i] * (acc[i] * inv + bias * z[i]);
        }
        __syncthreads();
        if (o == 0) {
#pragma unroll
            for (int i = 0; i < 4; ++i) up[b * 512 + 128 + t0 + i] = z[i];
        } else {
#pragma unroll
            for (int i = 0; i < 4; ++i) outs[(size_t)(b * TT + t0 + i) * D + 256 + c] = f2bf(z[i]);
        }
        __syncthreads();
    }
}

__device__ __forceinline__ void attn_unit(const PV& p, int l, int bl, int h, int q0, int nkeys, char* smem) {
    constexpr int KROW = 160, VROW = 144, KT_BYTES = 64 * KROW, STG = KT_BYTES + 64 * VROW;
    const int tid = TID(), lane = tid & 63, wid = tid >> 6, fr = lane & 15, fq = lane >> 4;
    const bf16_t* Qa = wsp<const bf16_t>(p, OFF_QA) + ((size_t)bl * 4 + h) * TT * 64;
    const bf16_t* Ka = wsp<const bf16_t>(p, OFF_KA) + ((size_t)bl * 4 + h) * TT * 64;
    const bf16_t* Vt = wsp<const bf16_t>(p, OFF_VA) + ((size_t)bl * 4 + h) * 64 * TT;
    const int ln32 = tid & 31;
    float gqm = fabsf(p.in(23)[l * 32 + ln32]), gkm = fabsf(p.in(24)[l * 32 + ln32]);
#pragma unroll
    for (int o = 16; o > 0; o >>= 1) { gqm = fmaxf(gqm, __shfl_xor(gqm, o)); gkm = fmaxf(gkm, __shfl_xor(gkm, o)); }
    const float Mx2 = 32.0f * 0.17677669529663687f * 1.4426950408889634f * gqm * gkm;
    const float* lp = p.in(25) + (size_t)l * 128;
    float s01 = lp[ln32] * lp[32 + ln32], s23 = lp[64 + ln32] * lp[96 + ln32];
#pragma unroll
    for (int o = 16; o > 0; o >>= 1) { s01 += __shfl_xor(s01, o); s23 += __shfl_xor(s23, o); }
    const float lam_init = 0.8f - 0.6f * expf(-0.3f * (float)l);
    const float lam = expf(s01) - expf(s23) + lam_init;
    const f32x4 cinit = {-Mx2, -Mx2, -Mx2, -Mx2};
    const int qw = q0 + wid * 32;
    bf16x8 qf[2][2];
#pragma unroll
    for (int br = 0; br < 2; ++br)
#pragma unroll
        for (int qt = 0; qt < 2; ++qt) qf[br][qt] = *(const bf16x8*)(Qa + (size_t)(qw + qt * 16 + fr) * 64 + br * 32 + fq * 8);
    f32x4 O[2][2][4], Ls[2][2];
#pragma unroll
    for (int br = 0; br < 2; ++br)
#pragma unroll
        for (int qt = 0; qt < 2; ++qt) { Ls[br][qt] = (f32x4){0.f, 0.f, 0.f, 0.f};
#pragma unroll
            for (int dt = 0; dt < 4; ++dt) O[br][qt][dt] = (f32x4){0.f, 0.f, 0.f, 0.f}; }
    bf16x8 ones;
#pragma unroll
    for (int j = 0; j < 8; ++j) ones[j] = (short)0x3F80;
    const int srow = tid >> 3, sc = tid & 7;
    const bf16_t* kg = Ka + (size_t)srow * 64 + sc * 8;
    const bf16_t* vg = Vt + (size_t)srow * TT + sc * 8;
    const int kso = srow * KROW + sc * 16, vso = KT_BYTES + srow * VROW + sc * 16;
    u32x4 rk = *(const u32x4*)kg, rv = *(const u32x4*)vg;
    const int nt = nkeys / 64;
    u32x4 rk2 = rk, rv2 = rv;
    if (nt > 1) { rk2 = *(const u32x4*)(kg + (size_t)64 * 64); rv2 = *(const u32x4*)(vg + 64); }
    __syncthreads();
    *(u32x4*)(smem + kso) = rk; *(u32x4*)(smem + vso) = rv;
    __syncthreads();
    for (int kt = 0; kt < nt; ++kt) {
        const char* cur = smem + (kt & 1) * STG; char* nxt = smem + ((kt + 1) & 1) * STG;
        rk = rk2; rv = rv2;
        if (kt + 2 < nt) { rk2 = *(const u32x4*)(kg + (size_t)(kt + 2) * 64 * 64); rv2 = *(const u32x4*)(vg + (kt + 2) * 64); }
#define AT_LDK(kp_, kf_) do { _Pragma("unroll") for (int br = 0; br < 2; ++br) _Pragma("unroll") for (int t = 0; t < 2; ++t) \
            kf_[br][t] = *(const bf16x8*)(cur + ((kp_) * 32 + t * 16 + fr) * KROW + br * 64 + fq * 16); } while (0)
#define AT_LDV(kp_, vf_) do { _Pragma("unroll") for (int dt = 0; dt < 4; ++dt) { \
            const u32x2 a_ = *(const u32x2*)(cur + KT_BYTES + (dt * 16 + fr) * VROW + (kp_) * 64 + fq * 8); \
            const u32x2 b_ = *(const u32x2*)(cur + KT_BYTES + (dt * 16 + fr) * VROW + (kp_) * 64 + 32 + fq * 8); \
            const u32x4 c_ = {a_[0], a_[1], b_[0], b_[1]}; vf_[dt] = __builtin_bit_cast(bf16x8, c_); } } while (0)
#define AT_S(kf_, qt_, s_) do { _Pragma("unroll") for (int br = 0; br < 2; ++br) _Pragma("unroll") for (int t = 0; t < 2; ++t) \
            s_[br][t] = __builtin_amdgcn_mfma_f32_16x16x32_bf16(kf_[br][t], qf[br][qt_], cinit, 0, 0, 0); } while (0)
#define AT_P(s_, pk_) do { _Pragma("unroll") for (int br = 0; br < 2; ++br) { \
            pk_[br][0] = cvt_pk_bf16(__builtin_amdgcn_exp2f(s_[br][0][0]), __builtin_amdgcn_exp2f(s_[br][0][1])); \
            pk_[br][1] = cvt_pk_bf16(__builtin_amdgcn_exp2f(s_[br][0][2]), __builtin_amdgcn_exp2f(s_[br][0][3])); \
            pk_[br][2] = cvt_pk_bf16(__builtin_amdgcn_exp2f(s_[br][1][0]), __builtin_amdgcn_exp2f(s_[br][1][1])); \
            pk_[br][3] = cvt_pk_bf16(__builtin_amdgcn_exp2f(s_[br][1][2]), __builtin_amdgcn_exp2f(s_[br][1][3])); } } while (0)
#define AT_PV(vf_, qt_, pk_) do { _Pragma("unroll") for (int br = 0; br < 2; ++br) { const bf16x8 pb_ = __builtin_bit_cast(bf16x8, pk_[br]); \
            _Pragma("unroll") for (int dt = 0; dt < 4; ++dt) O[br][qt_][dt] = __builtin_amdgcn_mfma_f32_16x16x32_bf16(vf_[dt], pb_, O[br][qt_][dt], 0, 0, 0); \
            Ls[br][qt_] = __builtin_amdgcn_mfma_f32_16x16x32_bf16(ones, pb_, Ls[br][qt_], 0, 0, 0); } } while (0)
        {
            bf16x8 kf0[2][2], kf1[2][2], vf0[4], vf1[4];
            f32x4 sA[2][2], sB[2][2];
            u32x4 pA[2], pB[2];
            AT_LDK(0, kf0); AT_LDV(0, vf0);
            AT_S(kf0, 0, sA);
            AT_LDK(1, kf1);
            AT_S(kf0, 1, sB);
            AT_P(sA, pA);
            AT_LDV(1, vf1);
            AT_S(kf1, 0, sA);
            AT_P(sB, pB);
            AT_PV(vf0, 0, pA);
            AT_S(kf1, 1, sB);
            AT_P(sA, pA);
            AT_PV(vf0, 1, pB);
            AT_P(sB, pB);
            AT_PV(vf1, 0, pA);
            AT_PV(vf1, 1, pB);
        }
#undef AT_LDK
#undef AT_LDV
#undef AT_S
#undef AT_P
#undef AT_PV
        if (kt + 1 < nt) { *(u32x4*)(nxt + kso) = rk; *(u32x4*)(nxt + vso) = rv; }
        __syncthreads();
    }
    asm volatile("" ::: "memory");
    const float* gn = p.in(26) + l * 64;
#pragma unroll
    for (int qt = 0; qt < 2; ++qt) {
        const float i1 = 1.0f / Ls[0][qt][0], i2 = lam / Ls[1][qt][0];
        float o[4][4], ss = 0.f;
#pragma unroll
        for (int dt = 0; dt < 4; ++dt)
#pragma unroll
            for (int j = 0; j < 4; ++j) { o[dt][j] = O[0][qt][dt][j] * i1 - O[1][qt][dt][j] * i2; ss += o[dt][j] * o[dt][j]; }
        ss += __shfl_xor(ss, 16); ss += __shfl_xor(ss, 32);
        const float rs = rsqrtf(ss * (1.0f / 64.0f) + 1e-6f) * (1.0f - lam_init);
        bf16_t* dst = wsp<bf16_t>(p, OFF_OUTS) + (size_t)(bl * TT + qw + qt * 16 + fr) * D + 768 + h * 64;
#pragma unroll
        for (int dt = 0; dt < 4; ++dt) {
            const f32x4 g = *(const f32x4*)(gn + dt * 16 + fq * 4);
            u32x2 w; w[0] = pack2(o[dt][0] * rs * g[0], o[dt][1] * rs * g[1]); w[1] = pack2(o[dt][2] * rs * g[2], o[dt][3] * rs * g[3]);
            *(u32x2*)(dst + dt * 16 + fq * 4) = w;
        }
    }
}

constexpr int QCTR_WORD0 = 3584;
__device__ __forceinline__ void ph_branches(const PV& p, int l, int it, char* smem) {
    const bool last = l == NLAYER - 1;
    const int NR = BG * 4 * 2 * 2, NH = 256, NA = BG * 4 * 16, NAC = last ? 0 : BG * 4, NHC = last ? 0 : 256;
    const int total = NR + NH + NA + NAC + NHC;
    unsigned* ctr = wsp<unsigned>(p, OFF_BAR) + QCTR_WORD0 + 64 * it;
    volatile __attribute__((address_space(3))) unsigned* qw = (volatile __attribute__((address_space(3))) unsigned*)(smem + SMEM_BYTES + 16 + 280);
    for (;;) {
        __syncthreads();
        if (threadIdx.x == 0) *qw = __hip_atomic_fetch_add(ctr, 1u, __ATOMIC_RELAXED, __HIP_MEMORY_SCOPE_AGENT);
        __syncthreads();
        int u = (int)__builtin_amdgcn_readfirstlane(*qw);
        if (u >= total) break;
        if (u < NR) {
            const int dir = u & 1, br = (u >> 1) & 1, h = (u >> 2) & 3, bl = u >> 4;
            if (br == 0) recur_chunk_unit<32, 0>(p, l, bl, h, dir, smem); else recur_chunk_unit<64, 1>(p, l, bl, h, dir, smem);
            continue;
        }
        u -= NR;
        if (u < NA) { const int qb = u & 15, h = (u >> 4) & 3, bl = u >> 6; attn_unit(p, l, bl, h, LC + qb * 256, TT, smem); continue; }
        u -= NA;
        if (u < NH) { hyena_mfma_unit(p, l, u, smem); continue; }
        u -= NH;
        if (u < NAC) { attn_unit(p, l, u >> 2, u & 3, 0, LC, smem); continue; }
        u -= NAC;
        hyena_ctx_unit(p, l, u, smem);
    }
}

__device__ __forceinline__ void ph_hy_unprep(const PV& p, char* smem) {
    bf16_t* tile = (bf16_t*)smem;
    const int tid = TID();
    const bf16_t* hyO = wsp<const bf16_t>(p, OFF_HYO);
    bf16_t* outs = wsp<bf16_t>(p, OFF_OUTS);
    const int total = BG * 4 * (LQ / 64), G = gridDim.x;
    const int ch = tid >> 3, t8 = (tid & 7) * 8;
    u32x4 cur = {0u, 0u, 0u, 0u}, nxt = {0u, 0u, 0u, 0u};
    int u = BID();
    if (u < total) { const int ct = u & 3, tt = (u >> 2) % (LQ / 64), bl = u / (4 * (LQ / 64)); cur = *(const u32x4*)(hyO + ((size_t)bl * 256 + ct * 64 + ch) * LQ + tt * 64 + t8); }
    for (; u < total; u += G) {
        const int ct = u & 3, tt = (u >> 2) % (LQ / 64), bl = u / (4 * (LQ / 64));
        if (u + G < total) { const int u2 = u + G, ct2 = u2 & 3, tt2 = (u2 >> 2) % (LQ / 64), bl2 = u2 / (4 * (LQ / 64)); nxt = *(const u32x4*)(hyO + ((size_t)bl2 * 256 + ct2 * 64 + ch) * LQ + tt2 * 64 + t8); }
        __syncthreads();
        *(u32x4*)(tile + ch * 72 + t8) = cur;
        __syncthreads();
        const int tok = tid >> 3, c8 = (tid & 7) * 8;
        u32x4 w;
#pragma unroll
        for (int j = 0; j < 4; ++j) w[j] = (unsigned)tile[(c8 + 2 * j) * 72 + tok] | ((unsigned)tile[(c8 + 2 * j + 1) * 72 + tok] << 16);
        *(u32x4*)(outs + (size_t)(bl * TT + LC + tt * 64 + tok) * D + 256 + ct * 64 + c8) = w;
        cur = nxt;
    }
}

__device__ __forceinline__ void ph_gated(const PV& p, int l) {
    const int tid = TID(), lane = tid & 63, wid = tid >> 6;
    const bf16_t* proj = wsp<const bf16_t>(p, OFF_BIG);
    const bf16_t* obuf = wsp<const bf16_t>(p, OFF_OBUF);
    bf16_t* outs = wsp<bf16_t>(p, OFF_OUTS);
    u32x2 pa0, pa1, pb0, pb1, pg0, pg1;
#define GATED_LOAD(rr) do { pa0 = *(const u32x2*)(obuf + ((size_t)0 * R + (rr)) * 256 + lane * 4); pa1 = *(const u32x2*)(obuf + ((size_t)1 * R + (rr)) * 256 + lane * 4); \
        pb0 = *(const u32x2*)(obuf + ((size_t)2 * R + (rr)) * 256 + lane * 4); pb1 = *(const u32x2*)(obuf + ((size_t)3 * R + (rr)) * 256 + lane * 4); \
        pg0 = *(const u32x2*)(proj + (size_t)(rr) * NP1 + C_GG + lane * 4); pg1 = *(const u32x2*)(proj + (size_t)(rr) * NP1 + C_HGG + lane * 4); } while (0)
    if (BID() * 8 + wid < R) GATED_LOAD(BID() * 8 + wid);
    for (int r = BID() * 8 + wid; r < R; r += gridDim.x * 8) {
        const u32x2 ca[2] = {pa0, pa1}, cb[2] = {pb0, pb1}, cg[2] = {pg0, pg1};
        if (r + (int)gridDim.x * 8 < R) GATED_LOAD(r + gridDim.x * 8);
#pragma unroll
        for (int br = 0; br < 2; ++br) {
            const u32x2 a = ca[br];
            const u32x2 b = cb[br];
            float o[4] = {__uint_as_float(a[0] << 16) + __uint_as_float(b[0] << 16), __uint_as_float(a[0] & 0xffff0000u) + __uint_as_float(b[0] & 0xffff0000u),
                          __uint_as_float(a[1] << 16) + __uint_as_float(b[1] << 16), __uint_as_float(a[1] & 0xffff0000u) + __uint_as_float(b[1] & 0xffff0000u)};
            float ss = o[0] * o[0] + o[1] * o[1] + o[2] * o[2] + o[3] * o[3];
            ss += __shfl_xor(ss, 1); ss += __shfl_xor(ss, 2); ss += __shfl_xor(ss, 4); ss += __shfl_xor(ss, 8);
            const float rs = rsqrtf(ss * (1.0f / 64.0f) + 1e-6f);
            const float* gn = p.in(br ? 22 : 11) + l * 64 + (lane & 15) * 4;
            const u32x2 graw = cg[br];
            const float gt[4] = {bf2f((bf16_t)(graw[0] & 0xffff)), bf2f((bf16_t)(graw[0] >> 16)), bf2f((bf16_t)(graw[1] & 0xffff)), bf2f((bf16_t)(graw[1] >> 16))};
#pragma unroll
            for (int c = 0; c < 4; ++c) o[c] = o[c] * rs * gn[c] * siluf_(gt[c]);
            u32x2 w; w[0] = pack2(o[0], o[1]); w[1] = pack2(o[2], o[3]);
            *(u32x2*)(outs + (size_t)r * D + (br ? 512 : 0) + lane * 4) = w;
        }
    }
}

__device__ __forceinline__ void ph_branchmm(const PV& p, int l, char* smem) {
    const bool last = l == NLAYER - 1;
    pg8::Gemm g; g.A = wsp<const bf16_t>(p, OFF_OUTS); g.Bt = wsp<const bf16_t>(p, OFF_BTBR) + (size_t)l * 4 * 1024 * 256; g.lda = D; g.ldb = 256; g.K = 256; g.bstride = 0; g.gidx = nullptr;
    SOrder S; S.init(last ? BG * 16 : R / 256, 16, last ? 5 : 4);
    EpiStoreBf16 E; E.O = wsp<bf16_t>(p, OFF_BIG); E.ldc = 4096; E.rowscale = nullptr;
    __syncthreads();
    pg8::gemm_phase((PG8_LAS unsigned char*)smem, g, S, E);
    __syncthreads();
}
struct EpiMerge {
    static constexpr bool PERM = false, AFTER_DRAIN = false;
    const bf16_t* Bm; bf16_t* M;
    __device__ __forceinline__ void operator()(const f32x4 (&acc)[2][2][4][2], const pg8::Unit& u, int wr, int wc, int fr, int fq) const {
        const int row0 = u.pm * 256 + wr * 64 + fr, mc0 = u.pn * 64 + wc * 16 + fq * 4;
        u32x2 bn[4];
        { const bf16_t* b0 = Bm + (size_t)row0 * 4096 + mc0;
#pragma unroll
          for (int i = 0; i < 4; ++i) bn[i] = *(const u32x2*)(b0 + i * 1024); }
#pragma unroll
        for (int ai = 0; ai < 2; ++ai)
#pragma unroll
            for (int m = 0; m < 4; ++m) {
                const int row = row0 + ai * 128 + m * 16;
                u32x2 br[4];
#pragma unroll
                for (int i = 0; i < 4; ++i) br[i] = bn[i];
                if (ai * 4 + m + 1 < 8) { const int g1 = ai * 4 + m + 1; const bf16_t* b1 = Bm + (size_t)(row0 + (g1 >> 2) * 128 + (g1 & 3) * 16) * 4096 + mc0;
#pragma unroll
                    for (int i = 0; i < 4; ++i) bn[i] = *(const u32x2*)(b1 + i * 1024); }
                asm volatile("" ::: "memory");
                float s[4] = {0.f, 0.f, 0.f, 0.f};
#pragma unroll
                for (int i = 0; i < 4; ++i) {
                    const f32x4 gv = acc[ai][i >> 1][m][i & 1];
                    const float b0 = __uint_as_float(br[i][0] << 16), b1 = __uint_as_float(br[i][0] & 0xffff0000u), b2 = __uint_as_float(br[i][1] << 16), b3 = __uint_as_float(br[i][1] & 0xffff0000u);
                    { constexpr float kc = -0.03125f * 1.4426950408889634f;
                      s[0] += __builtin_amdgcn_rcpf(1.0f + __builtin_amdgcn_exp2f(gv[0] * kc)) * b0; s[1] += __builtin_amdgcn_rcpf(1.0f + __builtin_amdgcn_exp2f(gv[1] * kc)) * b1;
                      s[2] += __builtin_amdgcn_rcpf(1.0f + __builtin_amdgcn_exp2f(gv[2] * kc)) * b2; s[3] += __builtin_amdgcn_rcpf(1.0f + __builtin_amdgcn_exp2f(gv[3] * kc)) * b3; }
                }
                u32x2 w; w[0] = pack2(s[0], s[1]); w[1] = pack2(s[2], s[3]);
                *(u32x2*)(M + (size_t)row * D + mc0) = w;
            }
    }
};
__device__ __forceinline__ void ph_merge(const PV& p, int l, char* smem) {
    const bool last = l == NLAYER - 1;
    pg8::Gemm g; g.A = wsp<const bf16_t>(p, OFF_HX8); g.Bt = wsp<const bf16_t>(p, OFF_BTGATE) + (size_t)l * 4096 * D / 2; g.lda = D / 2; g.ldb = D / 2; g.K = D / 2; g.bstride = 0; g.gidx = nullptr;
    SOrder S; S.init(last ? BG * 16 : R / 256, 16, (last ? 1 : 0) | 8);
    EpiMerge E; E.Bm = wsp<const bf16_t>(p, OFF_BIG); E.M = wsp<bf16_t>(p, OFF_OUTS);
    __syncthreads();
    pg8::gemm_phase<EpiMerge, SOrder, false, true>((PG8_LAS unsigned char*)smem, g, S, E);
    __syncthreads();
}

__device__ __forceinline__ void ph_wout(const PV& p, int l, int grp, char* smem) {
    const bool last = l == NLAYER - 1;
    pg8::Gemm g; g.A = wsp<const bf16_t>(p, OFF_OUTS); g.Bt = wsp<const bf16_t>(p, OFF_BTOUT) + (size_t)l * D * D; g.lda = D; g.ldb = D; g.K = D; g.bstride = 0; g.gidx = nullptr;
    SOrder S; S.init(last ? BG * 16 : R / 256, D / 256, last ? 1 : 0);
    EpiResid E; E.pp = &p; E.l = l; E.grp = grp;
    __syncthreads();
    pg8::gemm_phase((PG8_LAS unsigned char*)smem, g, S, E);
    __syncthreads();
}

__device__ __forceinline__ void ph_topk(const PV& p, int l, char* smem) {
    unsigned* keys = (unsigned*)smem;
    unsigned* red = keys + 4096;
    const int tid = TID(), lane = tid & 63, wid = tid >> 6;
    const bool last = l == NLAYER - 1;
    const int NU = BG * NEXP * (last ? 1 : 2);
    for (int u = BID(); u < NU; u += gridDim.x) {
        const int isctx = u >= BG * NEXP, v = isctx ? u - BG * NEXP : u, bl = v / NEXP, e = v % NEXP;
        const int L = isctx ? LC : LQ, cap = isctx ? CAPC : CAPL;
        const float* aff = wsp<const float>(p, OFF_AFF) + (isctx ? (size_t)BG * NEXP * LQ + (size_t)v * LC : (size_t)v * LQ);
        __syncthreads();
        {
            unsigned t[8];
#pragma unroll
            for (int k = 0; k < 8; ++k) { const int i = k * NTHR + tid; t[k] = i < L ? __float_as_uint(aff[i]) : 0u; }
#pragma unroll
            for (int k = 0; k < 8; ++k) keys[k * NTHR + tid] = t[k];
        }
        __syncthreads();
        unsigned my[8];
#pragma unroll
        for (int i = 0; i < 8; ++i) my[i] = keys[tid * 8 + i];
        unsigned T = 0u;
        {
            const unsigned cand = 1u << 30; int c = 0;
#pragma unroll
            for (int i = 0; i < 8; ++i) c += __popcll(__ballot(my[i] >= cand));
            if (lane == 0) red[wid] = (unsigned)c;
            __syncthreads();
            int tot = 0;
#pragma unroll
            for (int w = 0; w < 8; ++w) tot += (int)red[w];
            __syncthreads();
            if (tot >= cap) T = cand;
        }
        for (int bit = 28; bit >= 0; bit -= 2) {
            const unsigned c1 = T | (1u << bit), c2 = T | (2u << bit), c3 = T | (3u << bit);
            int n1 = 0, n2 = 0, n3 = 0;
#pragma unroll
            for (int i = 0; i < 8; ++i) { n1 += __popcll(__ballot(my[i] >= c1)); n2 += __popcll(__ballot(my[i] >= c2)); n3 += __popcll(__ballot(my[i] >= c3)); }
            if (lane == 0) { red[wid] = (unsigned)n1; red[16 + wid] = (unsigned)n2; red[24 + wid] = (unsigned)n3; }
            __syncthreads();
            int t1 = 0, t2 = 0, t3 = 0;
#pragma unroll
            for (int w = 0; w < 8; ++w) { t1 += (int)red[w]; t2 += (int)red[16 + w]; t3 += (int)red[24 + w]; }
            __syncthreads();
            T = t3 >= cap ? c3 : (t2 >= cap ? c2 : (t1 >= cap ? c1 : T));
        }
        int cg = 0, ce = 0;
#pragma unroll
        for (int i = 0; i < 8; ++i) { cg += (my[i] > T) ? 1 : 0; ce += (my[i] == T) ? 1 : 0; }
        unsigned pk = (unsigned)cg | ((unsigned)ce << 16), inc = pk;
#pragma unroll
        for (int o = 1; o < 64; o <<= 1) { const unsigned t = __shfl_up(inc, o); if (lane >= o) inc += t; }
        if (lane == 63) red[8 + wid] = inc;
        __syncthreads();
        unsigned base = 0u, totpk = 0u;
#pragma unroll
        for (int w = 0; w < 8; ++w) { const unsigned t = red[8 + w]; if (w < wid) base += t; totpk += t; }
        const unsigned ex = base + inc - pk;
        int rg = (int)(ex & 0xffffu), re = (int)(ex >> 16); const int G = (int)(totpk & 0xffffu);
        const int sbase = isctx ? LATS + (e * BG + bl) * CAPC : (e * BG + bl) * CAPL;
        int* sidx = wsp<int>(p, OFF_SIDX); float* sgv = wsp<float>(p, OFF_SGV); int* inv = wsp<int>(p, OFF_INV);
#pragma unroll
        for (int i = 0; i < 8; ++i) {
            const int tok = tid * 8 + i; int slot = -1;
            if (my[i] > T) slot = rg++;
            else if (my[i] == T) { if (G + re < cap) slot = G + re; re++; }
            if (slot >= 0 && tok < L) {
                const int r = bl * TT + (isctx ? tok : LC + tok);
                sidx[sbase + slot] = r; sgv[sbase + slot] = __uint_as_float(my[i]); inv[(size_t)r * NEXP + e] = sbase + slot;
            }
        }
    }
}

__device__ __forceinline__ void ph_moe1(const PV& p, int l, char* smem) {
    const bool last = l == NLAYER - 1;
    pg8::Gemm g; g.A = wsp<const bf16_t>(p, OFF_HX); g.Bt = wsp<const bf16_t>(p, OFF_BTW13) + (size_t)l * NEXP * 2048 * D; g.lda = D; g.ldb = D; g.K = D; g.bstride = (size_t)2048 * D; g.gidx = wsp<const int>(p, OFF_SIDX);
    SOrder S; S.init(last ? LATS / 256 : NSLOT / 256, 2048 / 256, 2);
    EpiSwiglu E; E.H = wsp<bf16_t>(p, OFF_BIG) + (size_t)NSLOT * D;
    __syncthreads();
    pg8::gemm_phase<EpiSwiglu, SOrder, true>((PG8_LAS unsigned char*)smem, g, S, E);
    __syncthreads();
}
__device__ __forceinline__ void ph_moe2(const PV& p, int l, char* smem) {
    const bool last = l == NLAYER - 1;
    pg8::Gemm g; g.A = wsp<const bf16_t>(p, OFF_BIG) + (size_t)NSLOT * D; g.Bt = wsp<const bf16_t>(p, OFF_BTW2) + (size_t)l * NEXP * D * D; g.lda = D; g.ldb = D; g.K = D; g.bstride = (size_t)D * D; g.gidx = nullptr;
    SOrder S; S.init(last ? LATS / 256 : NSLOT / 256, D / 256, 2);
    EpiStoreBf16 E; E.O = wsp<bf16_t>(p, OFF_BIG); E.ldc = D; E.rowscale = nullptr;
    __syncthreads();
    pg8::gemm_phase((PG8_LAS unsigned char*)smem, g, S, E);
    __syncthreads();
}

__device__ __forceinline__ void ph_combine(const PV& p, int l, int grp) {
    const int tid = TID(), lane = tid & 63, wid = tid >> 6;
    const bool last = l == NLAYER - 1;
    const bf16_t* Y = wsp<const bf16_t>(p, OFF_BIG); const int* inv = wsp<const int>(p, OFF_INV); const float* sgv = wsp<const float>(p, OFF_SGV);
    const int nrows = last ? BG * LQ : R, qstride = gridDim.x * 8;
    auto rowof = [&](int q) { return last ? (q / LQ) * TT + LC + (q % LQ) : q; };
    int invn = -1;
    { const int q0 = BID() * 8 + wid; if (q0 < nrows && lane < NEXP) invn = inv[(size_t)rowof(q0) * NEXP + lane]; }
    for (int q = BID() * 8 + wid; q < nrows; q += qstride) {
        const int r = rowof(q);
        const int bl = r / TT, pp = r % TT, b = grp * BG + bl;
        float* dst = stream_dst(p, b, pp);
        const float* mod = (pp < LC ? wsp<const float>(p, OFF_MODC) + (size_t)l * 6144 : wsp<const float>(p, OFF_MODX) + ((size_t)l * NB + b) * 6144) + 5 * D;
        const int myinv = invn;
        if (q + qstride < nrows && lane < NEXP) invn = inv[(size_t)rowof(q + qstride) * NEXP + lane];
        f32x4 xr[4];
        {
            const bf16_t* x1p = wsp<const bf16_t>(p, OFF_X1) + (size_t)r * D;
            const u32x4 a0 = *(const u32x4*)(x1p + lane * 8), a1 = *(const u32x4*)(x1p + 512 + lane * 8);
            xr[0] = (f32x4){__uint_as_float(a0[0] << 16), __uint_as_float(a0[0] & 0xffff0000u), __uint_as_float(a0[1] << 16), __uint_as_float(a0[1] & 0xffff0000u)};
            xr[1] = (f32x4){__uint_as_float(a0[2] << 16), __uint_as_float(a0[2] & 0xffff0000u), __uint_as_float(a0[3] << 16), __uint_as_float(a0[3] & 0xffff0000u)};
            xr[2] = (f32x4){__uint_as_float(a1[0] << 16), __uint_as_float(a1[0] & 0xffff0000u), __uint_as_float(a1[1] << 16), __uint_as_float(a1[1] & 0xffff0000u)};
            xr[3] = (f32x4){__uint_as_float(a1[2] << 16), __uint_as_float(a1[2] & 0xffff0000u), __uint_as_float(a1[3] << 16), __uint_as_float(a1[3] & 0xffff0000u)};
        }
        float acc[16];
#pragma unroll
        for (int i = 0; i < 16; ++i) acc[i] = 0.f;
        unsigned long long mask = __ballot(myinv >= 0);
        while (mask) {
            const int e0 = __builtin_ctzll(mask); mask &= mask - 1;
            const bool two = mask != 0ull; const int e1 = two ? __builtin_ctzll(mask) : e0; if (two) mask &= mask - 1;
            const int s0 = __builtin_amdgcn_readfirstlane(__shfl(myinv, e0)), s1 = __builtin_amdgcn_readfirstlane(__shfl(myinv, e1));
            const float g0 = sgv[s0], g1 = two ? sgv[s1] : 0.0f;
            u32x4 w0[2], w1[2];
#pragma unroll
            for (int i = 0; i < 2; ++i) { w0[i] = *(const u32x4*)(Y + (size_t)s0 * D + i * 512 + lane * 8); w1[i] = *(const u32x4*)(Y + (size_t)s1 * D + i * 512 + lane * 8); }
#pragma unroll
            for (int i = 0; i < 2; ++i)
#pragma unroll
                for (int j = 0; j < 4; ++j) {
                    acc[i * 8 + 2 * j] += g0 * __uint_as_float(w0[i][j] << 16) + g1 * __uint_as_float(w1[i][j] << 16);
                    acc[i * 8 + 2 * j + 1] += g0 * __uint_as_float(w0[i][j] & 0xffff0000u) + g1 * __uint_as_float(w1[i][j] & 0xffff0000u);
                }
        }
        float ss = 0.f;
#pragma unroll
        for (int i = 0; i < 2; ++i)
#pragma unroll
            for (int j = 0; j < 2; ++j) {
                const int c = i * 512 + lane * 8 + j * 4;
                f32x4 x = xr[i * 2 + j]; const f32x4 md = *(const f32x4*)(mod + c);
#pragma unroll
                for (int q = 0; q < 4; ++q) { x[q] += md[q] * acc[i * 8 + j * 4 + q]; acc[i * 8 + j * 4 + q] = x[q]; ss += x[q] * x[q]; }
                *(f32x4*)(dst + c) = x;
            }
        if (!last) {
            ss = wave_sum(ss);
            const float rs = rsqrtf(ss * (1.0f / D) + 1e-6f);
            const float* gain = p.in(6) + (size_t)(l + 1) * D;
            const float* m1 = (pp < LC ? wsp<const float>(p, OFF_MODC) + (size_t)(l + 1) * 6144 : wsp<const float>(p, OFF_MODX) + ((size_t)(l + 1) * NB + b) * 6144);
            bf16_t* hx = wsp<bf16_t>(p, OFF_HX) + (size_t)r * D;
#pragma unroll
            for (int i = 0; i < 2; ++i) {
                const int c = i * 512 + lane * 8;
                float y[8];
#pragma unroll
                for (int j = 0; j < 2; ++j) {
                    const f32x4 g = *(const f32x4*)(gain + c + j * 4), sh = *(const f32x4*)(m1 + c + j * 4), sc = *(const f32x4*)(m1 + D + c + j * 4);
#pragma unroll
                    for (int q = 0; q < 4; ++q) y[j * 4 + q] = acc[i * 8 + j * 4 + q] * rs * g[q] * (1.0f + sc[q]) + sh[q];
                }
                u32x4 w; w[0] = pack2(y[0], y[1]); w[1] = pack2(y[2], y[3]); w[2] = pack2(y[4], y[5]); w[3] = pack2(y[6], y[7]);
                *(u32x4*)(hx + c) = w;
                int q0 = 0, q1 = 0;
                q0 = __builtin_amdgcn_cvt_pk_fp8_f32(y[0], y[1], q0, false); q0 = __builtin_amdgcn_cvt_pk_fp8_f32(y[2], y[3], q0, true);
                q1 = __builtin_amdgcn_cvt_pk_fp8_f32(y[4], y[5], q1, false); q1 = __builtin_amdgcn_cvt_pk_fp8_f32(y[6], y[7], q1, true);
                *(u32x2*)(wsp<unsigned char>(p, OFF_HX8) + (size_t)r * D + c) = (u32x2){(unsigned)q0, (unsigned)q1};
            }
        }
    }
}

#define XB_TMO      128
#define XB_XCNT(j)  (256  + 64 * (j))
#define XB_XSUB(j)  (1280 + 64 * (j))
#define XB_XGEN(j)  (2304 + 64 * (j))
#define XB_TOP      3328
#define XB_TOPGEN   3392
#define XCD_BAR_WORDS 3456
#define XB_SPIN_CAP (1u << 18)
#define LAS __attribute__((address_space(3)))

__device__ __forceinline__ unsigned xb_ld(unsigned* p)              { return __hip_atomic_load(p, __ATOMIC_RELAXED, __HIP_MEMORY_SCOPE_AGENT); }
__device__ __forceinline__ unsigned xb_add(unsigned* p, unsigned v) { return __hip_atomic_fetch_add(p, v, __ATOMIC_RELAXED, __HIP_MEMORY_SCOPE_AGENT); }
__device__ __forceinline__ unsigned xb_xcc_id() { return (unsigned)__builtin_amdgcn_s_getreg((3 << 11) | 20) & 0xFu; }
#define XB_SPIN(cond, bar) do { unsigned _sp = 0; while (cond) { __builtin_amdgcn_s_sleep(1); \
    if ((++_sp & 255u) == 0u) { if (xb_ld(&(bar)[XB_TMO])) break; if (_sp > XB_SPIN_CAP) { atomicAdd(&(bar)[XB_TMO], 1u); break; } } } } while (0)

struct XcdBarrier {
    unsigned* bar; unsigned x;
    volatile LAS unsigned* st;
};

__device__ __forceinline__ XcdBarrier xcd_barrier_post(unsigned* bar, volatile LAS unsigned* st) {
    XcdBarrier b; b.bar = bar; b.x = xb_xcc_id(); b.st = st;
    if (threadIdx.x == 0) (void)xb_add(&bar[XB_XCNT(b.x)], 1u);
    return b;
}
__device__ __forceinline__ void xcd_barrier_complete(unsigned* bar, unsigned x, unsigned& nloc, unsigned& nx) {
    const unsigned G = gridDim.x * gridDim.y * gridDim.z;
    unsigned sum, cnt, mine, sp = 0u;
    for (;;) {
        sum = 0u; cnt = 0u; mine = 0u;
#pragma unroll
        for (unsigned j = 0; j < 16; ++j) { const unsigned c = xb_ld(&bar[XB_XCNT(j)]); sum += c; cnt += (c > 0u) ? 1u : 0u; mine = (j == x) ? c : mine; }
        if (sum == G) break;
        __builtin_amdgcn_s_sleep(1);
        if ((++sp & 255u) == 0u) { if (xb_ld(&bar[XB_TMO])) break; if (sp > XB_SPIN_CAP) { atomicAdd(&bar[XB_TMO], 1u); break; } }
    }
    nloc = mine > 0u ? mine : 1u; nx = cnt > 0u ? cnt : 1u;
}

__device__ __forceinline__ void xcd_barrier(const XcdBarrier& b) {
    asm volatile("s_waitcnt vmcnt(0)" ::: "memory");
    __syncthreads();
    if (threadIdx.x == 0) {
        unsigned* bar = b.bar;
        unsigned bx = b.x; asm volatile("" : "+s"(bx));
        __builtin_amdgcn_s_waitcnt(0);
        unsigned nloc = b.st[0], nx = b.st[1];
        if (nloc == 0u) { xcd_barrier_complete(bar, bx, nloc, nx); b.st[0] = nloc; b.st[1] = nx; }
        const unsigned old = xb_add(&bar[XB_XSUB(bx)], 1u);
        const unsigned gen = old / nloc;
        if (old + 1u == (gen + 1u) * nloc) {
            __builtin_amdgcn_fence(__ATOMIC_RELEASE, "agent");
            asm volatile("s_waitcnt vmcnt(0)" ::: "memory");
            const unsigned og = xb_add(&bar[XB_TOP], 1u);
            const unsigned tg = og / nx;
            if (og + 1u == (tg + 1u) * nx) xb_add(&bar[XB_TOPGEN], 1u);
            else XB_SPIN(xb_ld(&bar[XB_TOPGEN]) == tg, bar);
            __builtin_amdgcn_fence(__ATOMIC_ACQUIRE, "agent");
            xb_add(&bar[XB_XGEN(bx)], 1u);
            asm volatile("s_waitcnt vmcnt(0)" ::: "memory");
        } else {
            XB_SPIN(xb_ld(&bar[XB_XGEN(bx)]) == gen, bar);
            __builtin_amdgcn_fence(__ATOMIC_ACQUIRE, "agent");
            asm volatile("s_waitcnt vmcnt(0)" ::: "memory");
        }
    }
    __syncthreads();
}


#define GRID_SYNC() xcd_barrier(bar)
__global__ void __launch_bounds__(NTHR, 2) k_fused(P pk) {
    extern __shared__ __attribute__((aligned(16))) char smem[];
    volatile LAS unsigned* xbw = (volatile LAS unsigned*)(smem + SMEM_BYTES);
    if (threadIdx.x == 0) { xbw[0] = 0u; xbw[1] = 0u; xbw[2] = 0u; xbw[3] = 0u; }
    {
        LAS unsigned* tab = (LAS unsigned*)(smem + SMEM_BYTES + 16);
        if (threadIdx.x == 0) {
#pragma unroll
            for (int i = 0; i < 35; ++i) {
                const unsigned long long v = i < 33 ? (unsigned long long)pk.in[i < 33 ? i : 0] : (i == 33 ? (unsigned long long)pk.out : (unsigned long long)pk.ws);
                tab[2 * i] = (unsigned)v; tab[2 * i + 1] = (unsigned)(v >> 32);
            }
        }
    }
    __syncthreads();
    PV p; p.tab = (const LAS unsigned*)(smem + SMEM_BYTES + 16);
    XcdBarrier bar = xcd_barrier_post(wsp<unsigned>(p, OFF_BAR), xbw);
    ph_mod(p, smem);
    ph_hfilt(p, smem);
    ph_weights(p, smem);
    GRID_SYNC();
    ph_hcopies(p);
#pragma unroll 1
    for (int grp = 0; grp < NGRP; ++grp) {
#pragma unroll 1
        for (int l = 0; l < NLAYER; ++l) {
            if (l == 0 && grp == 0) { ph_norm<0>(p, l, grp, smem); GRID_SYNC(); }
            ph_g1(p, l, smem); GRID_SYNC();
            ph_attn_prep(p, l, smem); ph_v_prep(p, smem); ph_hy_prep(p, l, smem); GRID_SYNC();
            ph_branches(p, l, grp * NLAYER + l, smem); GRID_SYNC();
            ph_gated(p, l); ph_hy_unprep(p, smem); GRID_SYNC();
            ph_branchmm(p, l, smem); GRID_SYNC();
            ph_merge(p, l, smem); GRID_SYNC();
            ph_wout(p, l, grp, smem); GRID_SYNC();
            ph_norm2(p, l, grp, smem); GRID_SYNC();
            ph_topk(p, l, smem); GRID_SYNC();
            ph_moe1(p, l, smem); GRID_SYNC();
            ph_moe2(p, l, smem); GRID_SYNC();
            ph_combine(p, l, grp);
            if (l == NLAYER - 1 && grp + 1 < NGRP) ph_norm<0>(p, 0, grp + 1, smem);
            GRID_SYNC();
        }
    }
}

extern "C" void kernel_launch(void* const* d_in, const int* in_sizes, int n_in, void* d_out, int out_size, void* d_ws, size_t ws_size, hipStream_t stream) {
    P p{};
    for (int i = 0; i < 33; ++i) p.in[i] = (const float*)d_in[i];
    p.out = (float*)d_out; p.ws = (char*)d_ws;
    static int grid = 0;
    if (!grid) {
        int dev = 0, cus = 0, per_cu = 0;
        (void)hipGetDevice(&dev);
        (void)hipDeviceGetAttribute(&cus, hipDeviceAttributeMultiprocessorCount, dev);
        (void)hipFuncSetAttribute((const void*)k_fused, hipFuncAttributeMaxDynamicSharedMemorySize, SMEM_TOTAL);
        (void)hipOccupancyMaxActiveBlocksPerMultiprocessor(&per_cu, k_fused, NTHR, SMEM_TOTAL);
        grid = cus * (per_cu < 1 ? per_cu : 1);
        if (grid <= 0) grid = 256;
    }
    (void)hipMemsetAsync(d_ws, 0, 16384, stream);
    k_fused<<<grid, NTHR, SMEM_TOTAL, stream>>>(p);
}
```

```cpp
#include <hip/hip_runtime.h>
#include <stdint.h>


typedef unsigned short bf16_t;
typedef short bf16x8 __attribute__((ext_vector_type(8)));
typedef float f32x4 __attribute__((ext_vector_type(4)));
typedef unsigned u32x4 __attribute__((ext_vector_type(4)));
typedef unsigned u32x2 __attribute__((ext_vector_type(2)));

#define NTHR 512
constexpr int D = 1024, NB = 16, LQ = 4096, LC = 256, TT = 4352, NLAYER = 2;
constexpr int BG = 8, NGRP = NB / BG, R = BG * TT;
constexpr int NP1 = 3840;
constexpr int C_GQ = 0, C_GK = 128, C_GV = 256, C_GAF = 512, C_GAB = 528, C_GG = 544, C_HY = 800, C_HQ = 1568, C_HFF = 1824, C_HFB = 2080,
              C_HI = 2336, C_HGG = 2592, C_DQ = 2848, C_DK = 3104, C_DV = 3360, C_MG = 3616, N_IN = 7712;
constexpr int NEXP = 16, CAPL = 512, CAPC = 32, LATS = BG * NEXP * CAPL, NSLOT = LATS + BG * NEXP * CAPC;
constexpr int SMEM_BYTES = 132096;
constexpr int SMEM_TOTAL = SMEM_BYTES + 16 + 288;
constexpr int HY_UB = 8224, HY_HSTR = 8256, HY_NS = 515, HY_U_BYTES = 8 * HY_UB, HY_Z_OFF = HY_U_BYTES + 8 * HY_HSTR;
static_assert(HY_Z_OFF + 64 <= SMEM_BYTES, "hyena lds");

constexpr size_t al256(size_t x) { return (x + 255) & ~(size_t)255; }
constexpr size_t OFF_BAR = 0;
constexpr size_t OFF_BTIN1 = 65536;
constexpr size_t OFF_BTGATE = OFF_BTIN1 + (size_t)NLAYER * NP1 * D * 2;
constexpr size_t OFF_BTBR = OFF_BTGATE + (size_t)NLAYER * 4096 * D * 2;
constexpr size_t OFF_BTOUT = OFF_BTBR + (size_t)NLAYER * 4 * 1024 * 256 * 2;
constexpr size_t OFF_BTW13 = OFF_BTOUT + (size_t)NLAYER * D * D * 2;
constexpr size_t OFF_BTW2 = OFF_BTW13 + (size_t)NLAYER * NEXP * 2048 * D * 2;
constexpr size_t OFF_MODX = OFF_BTW2 + (size_t)NLAYER * NEXP * D * D * 2;
constexpr size_t OFF_MODC = OFF_MODX + (size_t)NLAYER * NB * 6144 * 4;
constexpr size_t OFF_HRAW = OFF_MODC + (size_t)NLAYER * 6144 * 4;
constexpr size_t HRAW_L = (size_t)512 * (LQ + LC);
constexpr size_t OFF_PSUM = OFF_HRAW + (size_t)NLAYER * HRAW_L * 4;
constexpr size_t OFF_XC = OFF_PSUM + (size_t)NLAYER * 68 * 512 * 4;
constexpr size_t OFF_HX = OFF_XC + (size_t)NB * LC * D * 4;
constexpr size_t OFF_BIG = OFF_HX + (size_t)R * D * 2;
constexpr size_t BIG_BYTES = (size_t)2 * NSLOT * D * 2;
constexpr size_t OFF_OUTS = OFF_BIG + BIG_BYTES;
constexpr size_t OFF_QA = OFF_OUTS + (size_t)R * D * 2;
constexpr size_t OFF_KA = OFF_QA + (size_t)BG * 4 * TT * 64 * 2;
constexpr size_t OFF_VA = OFF_KA + (size_t)BG * 4 * TT * 64 * 2;
constexpr size_t OFF_OBUF = OFF_VA + (size_t)BG * 4 * TT * 64 * 2;
constexpr size_t OFF_X1 = OFF_OBUF;
constexpr size_t OFF_HYT = OFF_OBUF + (size_t)4 * R * 256 * 2;
constexpr size_t OFF_AFF = OFF_HYT + (size_t)BG * 768 * TT * 2;
constexpr size_t OFF_INV = OFF_AFF + (size_t)BG * NEXP * TT * 4;
constexpr size_t OFF_SIDX = OFF_INV + (size_t)R * NEXP * 4;
constexpr size_t OFF_SGV = OFF_SIDX + (size_t)NSLOT * 4;
constexpr size_t OFF_HCOP = OFF_SGV + (size_t)NSLOT * 4;
constexpr size_t OFF_HYO = OFF_HCOP + (size_t)NLAYER * 512 * 8 * HY_HSTR;
constexpr size_t OFF_HX8 = OFF_HYO + (size_t)BG * 256 * LQ * 2;
constexpr size_t WS_END = OFF_HX8 + (size_t)R * D;
static_assert(WS_END < (size_t)1020 * 1024 * 1024, "workspace too big");
static_assert(BIG_BYTES >= (size_t)R * NP1 * 2, "big region");

struct P {
    const float* in[33];
    float* out;
    char* ws;
};
struct PV {
    const __attribute__((address_space(3))) unsigned* tab;
    __device__ __forceinline__ unsigned long long ptr(int i) const {
        const unsigned lo = __builtin_amdgcn_readfirstlane(tab[2 * i]), hi = __builtin_amdgcn_readfirstlane(tab[2 * i + 1]);
        return ((unsigned long long)hi << 32) | lo;
    }
    __device__ __forceinline__ const float* in(int i) const { return (const float*)(const __attribute__((address_space(1))) float*)ptr(i); }
    __device__ __forceinline__ float* out() const { return (float*)(__attribute__((address_space(1))) float*)ptr(33); }
    __device__ __forceinline__ char* ws() const { return (char*)(__attribute__((address_space(1))) char*)ptr(34); }
};

__device__ __forceinline__ bf16_t f2bf(float f) { unsigned u = __float_as_uint(f); u += 0x7fffu + ((u >> 16) & 1u); return (bf16_t)(u >> 16); }
__device__ __forceinline__ float bf2f(bf16_t h) { return __uint_as_float((unsigned)h << 16); }
typedef float f32x2 __attribute__((ext_vector_type(2)));
typedef __bf16 bf16x2_t __attribute__((ext_vector_type(2)));
__device__ __forceinline__ unsigned cvt_pk_bf16(float lo, float hi) { const f32x2 v = {lo, hi}; return __builtin_bit_cast(unsigned, __builtin_convertvector(v, bf16x2_t)); }
__device__ __forceinline__ unsigned pack2(float a, float b) { return cvt_pk_bf16(a, b); }
__device__ __forceinline__ float sigmoidf_(float x) { return __builtin_amdgcn_rcpf(1.0f + __expf(-x)); }
__device__ __forceinline__ float siluf_(float x) { return x * __builtin_amdgcn_rcpf(1.0f + __expf(-x)); }
__device__ __forceinline__ float wave_sum(float v) {
#pragma unroll
    for (int o = 32; o > 0; o >>= 1) v += __shfl_xor(v, o);
    return v;
}

template <class T> __device__ __forceinline__ T* wsp(const PV& p, size_t off) { return (T*)(p.ws() + off); }

__device__ __forceinline__ const float* stream_src(const PV& p, int l, int b, int pp) {
    if (pp < LC) return (l == 0 ? p.in(2) : wsp<const float>(p, OFF_XC)) + ((size_t)b * LC + pp) * D;
    return (l == 0 ? p.in(0) : (const float*)p.out()) + ((size_t)b * LQ + (pp - LC)) * D;
}
__device__ __forceinline__ float* stream_dst(const PV& p, int b, int pp) {
    if (pp < LC) return wsp<float>(p, OFF_XC) + ((size_t)b * LC + pp) * D;
    return p.out() + ((size_t)b * LQ + (pp - LC)) * D;
}

__device__ __forceinline__ int TID() { int t = threadIdx.x; asm volatile("" : "+v"(t)); return t; }
__device__ __forceinline__ int BID() { int t = blockIdx.x; asm volatile("" : "+s"(t)); return t; }

namespace pg8 {
#define PG8_LAS __attribute__((address_space(3)))
typedef unsigned short bf16_t;
typedef short bf16x8 __attribute__((ext_vector_type(8)));
typedef float f32x4 __attribute__((ext_vector_type(4)));
typedef unsigned u32x4 __attribute__((ext_vector_type(4)));
constexpr int BM = 256, BK = 64, HALF = 128, HTB = HALF * BK * 2  , STAGE_BYTES = 8 * HTB, NXCD = 8, WGM = 4;

__host__ __device__ __forceinline__ int lds_byte(int r, int c) { const int st = (r >> 4) * 2 + (c >> 5), rr = r & 15, cc = c & 31, ob = rr * 64 + cc * 2; return st * 1024 + (ob ^ (((ob >> 9) & 1) << 5)); }
__host__ __device__ __forceinline__ void stage_rc(int b, int& R, int& C) { const int st = b / 1024, sb = b % 1024, swz = sb ^ (((sb >> 9) & 1) << 5); R = (st >> 1) * 16 + swz / 64; C = (st & 1) * 32 + (swz % 64) / 2; }
__host__ __device__ __forceinline__ int perm32(int rho) { const int n = rho >> 4, i = rho & 15; return 8 * (i >> 2) + 4 * n + (i & 3); }

struct Unit { int pm, pn; unsigned bexp; int aofs; };
struct Gemm { const bf16_t* A; const bf16_t* Bt; int lda, ldb, K; size_t bstride; const int* gidx; };
template <class Epi, class Sched, bool GATHER = false, bool FP8 = false>
__device__ __forceinline__ void gemm_phase(PG8_LAS unsigned char* lds, const Gemm g, const Sched& S, const Epi& E) {
    constexpr bool STAMP = false; unsigned long long* stamps = nullptr;
    const int tid = TID(), wid = __builtin_amdgcn_readfirstlane(tid >> 6), lane = tid & 63, wr = wid >> 2, wc = wid & 3, fr = lane & 15, fq = lane >> 4;
    const int K = g.K, nt = K / BK;
    int ts_lo = 0, ts_hi = 0, nts = 0; const unsigned long long rt_entry = STAMP ? (unsigned long long)wall_clock64() : 0ull;
#define PG8_STAMP() do { if (STAMP && wid == 0 && nts < 64) { const unsigned long long _c = (unsigned long long)clock64(); \
        ts_lo = (lane == nts) ? (int)(unsigned)_c : ts_lo; ts_hi = (lane == nts) ? (int)(unsigned)(_c >> 32) : ts_hi; ++nts; } } while (0)
    PG8_STAMP();
    unsigned voffA[2], voffB[2]; int RA[2]; unsigned cofA[2];
#pragma unroll
    for (int i = 0; i < 2; ++i) { int R, C; stage_rc(tid * 16 + i * 8192, R, C); const int Rb = Epi::PERM ? ((R & ~31) + perm32(R & 31)) : R;
        voffA[i] = (unsigned)(R * g.lda + C) * 2u; voffB[i] = (unsigned)(Rb * g.ldb + C) * 2u; RA[i] = R; cofA[i] = (unsigned)C * 2u; }
    unsigned gofs[2], gnx[2], gsel[2];
    auto ldg = [&](const Unit& u, unsigned (&o)[2]) {
#pragma unroll
        for (int h = 0; h < 2; ++h) o[h] = (unsigned)g.gidx[u.pm * 256 + h * HALF + RA[0]] | ((unsigned)g.gidx[u.pm * 256 + h * HALF + RA[1]] << 16); };
    const unsigned rowb = (unsigned)(g.lda * 2);
#define PG8_STAGEA(bufoff, gbase, pk) do { if (GATHER) { const unsigned _o[2] = {((pk) & 0xffffu) * rowb + cofA[0], ((pk) >> 16) * rowb + cofA[1]}; PG8_STAGE(bufoff, gbase, _o); } else PG8_STAGE(bufoff, gbase, voffA); } while (0)
    const size_t kstep = (size_t)(BK * 2);
    const size_t hstepA = (size_t)HALF * g.lda * 2, hstepB = (size_t)HALF * g.ldb * 2;
    const size_t tstepA = 2 * hstepA, tstepB = 2 * hstepB; const size_t hsA = GATHER ? 0 : hstepA, tsA = GATHER ? 0 : tstepA;
    const unsigned ldsw = (unsigned)wid * 1024u;
    const int aoff = lds_byte(wr * 64 + fr, fq * 8), boff = lds_byte(wc * 32 + fr, fq * 8);
#define PG8_SA(b, h) (((b) * 2 + (h)) * HTB)
#define PG8_SB(b, h) ((4 + (b) * 2 + (h)) * HTB)
#define PG8_STAGE(bufoff, gbase, voff) do { _Pragma("unroll") for (int _i = 0; _i < 2; ++_i) \
        __builtin_amdgcn_global_load_lds((const unsigned*)((const char*)(gbase) + (voff)[_i]), (PG8_LAS unsigned*)(lds + (bufoff) + ldsw + _i * 8192), 16, 0, 0); } while (0)
    typedef int v4i_t __attribute__((ext_vector_type(4))); typedef int v8i_t __attribute__((ext_vector_type(8)));
#define PG8_CAT8(x0, x1) __builtin_shufflevector(x0, x1, 0, 1, 2, 3, 4, 5, 6, 7)
#define PG8_LDA(dst, b, h) do { if constexpr (FP8) { _Pragma("unroll") for (int m = 0; m < 4; ++m) dst##8[m] = PG8_CAT8(*(const PG8_LAS v4i_t*)(lds + PG8_SA(b, h) + aoff + m * 2048), *(const PG8_LAS v4i_t*)(lds + PG8_SA(b, h) + aoff + m * 2048 + 1024)); } \
        else { _Pragma("unroll") for (int m = 0; m < 4; ++m) _Pragma("unroll") for (int k = 0; k < 2; ++k) dst[m][k] = *(const PG8_LAS bf16x8*)(lds + PG8_SA(b, h) + aoff + m * 2048 + k * 1024); } } while (0)
#define PG8_LDB(dst, b, h) do { if constexpr (FP8) { _Pragma("unroll") for (int n = 0; n < 2; ++n) dst##8[n] = PG8_CAT8(*(const PG8_LAS v4i_t*)(lds + PG8_SB(b, h) + boff + n * 2048), *(const PG8_LAS v4i_t*)(lds + PG8_SB(b, h) + boff + n * 2048 + 1024)); } \
        else { _Pragma("unroll") for (int n = 0; n < 2; ++n) _Pragma("unroll") for (int k = 0; k < 2; ++k) dst[n][k] = *(const PG8_LAS bf16x8*)(lds + PG8_SB(b, h) + boff + n * 2048 + k * 1024); } } while (0)
#define PG8_MMA16(ai, bj, At, Bt) do { __builtin_amdgcn_s_setprio(1); _Pragma("unroll") for (int m = 0; m < 4; ++m) _Pragma("unroll") for (int n = 0; n < 2; ++n) _Pragma("unroll") for (int k = 0; k < 2; ++k) \
        acc[ai][bj][m][n] = __builtin_amdgcn_mfma_f32_16x16x32_bf16(Bt[n][k], At[m][k], acc[ai][bj][m][n], 0, 0, 0); __builtin_amdgcn_s_setprio(0); } while (0)
#define PG8_MMA8(ai, bj, At, Bt) do { __builtin_amdgcn_s_setprio(1); _Pragma("unroll") for (int m = 0; m < 4; ++m) _Pragma("unroll") for (int n = 0; n < 2; ++n) \
        asm volatile("v_mfma_scale_f32_16x16x128_f8f6f4 %0, %1, %2, %0, %3, %3 op_sel_hi:[0,0,0]" : "+v"(acc[ai][bj][m][n]) : "v"(Bt##8[n]), "v"(At##8[m]), "v"(sc127)); \
        __builtin_amdgcn_s_setprio(0); } while (0)
#define PG8_MMA(ai, bj, At, Bt) do { if constexpr (FP8) PG8_MMA8(ai, bj, At, Bt); else PG8_MMA16(ai, bj, At, Bt); } while (0)
#define PG8_WAIT_V(n) asm volatile("s_waitcnt vmcnt(" #n ")" ::: "memory")
#define PG8_WAIT_L(n) asm volatile("s_waitcnt lgkmcnt(" #n ")" ::: "memory")
#define PG8_BAR __builtin_amdgcn_s_barrier()
#define PG8_SCHED __builtin_amdgcn_sched_barrier(0)
    Unit cur, nxt; int ui = 0;
    if (!S.next(0, cur)) return;
    f32x4 acc[2][2][4][2];
#pragma unroll
    for (int a = 0; a < 2; ++a)
#pragma unroll
        for (int b = 0; b < 2; ++b)
#pragma unroll
            for (int m = 0; m < 4; ++m)
#pragma unroll
                for (int n = 0; n < 2; ++n) acc[a][b][m][n] = (f32x4){0.f, 0.f, 0.f, 0.f};
    bf16x8 At[4][2], B0[2][2], B1[2][2];
    v8i_t At8[4], B08[2], B18[2];
    int sc127 = 127; asm volatile("" : "+v"(sc127));
    const char* cA = (const char*)g.A + (size_t)cur.pm * tsA + (size_t)cur.aofs * 2; const char* cB = (const char*)g.Bt + ((size_t)cur.bexp * g.bstride) * 2 + (size_t)cur.pn * tstepB;
    S.a_ready(cur);
    if (GATHER) ldg(cur, gofs);
    PG8_STAGE(PG8_SB(0, 0), cB, voffB); PG8_STAGEA(PG8_SA(0, 0), cA, gofs[0]); PG8_STAGE(PG8_SB(0, 1), cB + hstepB, voffB); PG8_STAGEA(PG8_SA(0, 1), cA + hsA, gofs[1]);
    if (wr == 1) PG8_BAR;
    PG8_WAIT_V(4); PG8_BAR;
    PG8_STAGE(PG8_SB(1, 0), cB + kstep, voffB); PG8_STAGEA(PG8_SA(1, 0), cA + kstep, gofs[0]); PG8_STAGE(PG8_SB(1, 1), cB + hstepB + kstep, voffB);
    PG8_WAIT_V(6); PG8_BAR;
    PG8_STAMP();
    for (;;) {
        const bool has_next = S.next(ui + 1, nxt);
        if (GATHER) { if (has_next) ldg(nxt, gnx); else { gnx[0] = gofs[0]; gnx[1] = gofs[1]; } }
        const char* nA = has_next ? (const char*)g.A + (size_t)nxt.pm * tsA + (size_t)nxt.aofs * 2 : cA; const char* nB = has_next ? (const char*)g.Bt + ((size_t)nxt.bexp * g.bstride) * 2 + (size_t)nxt.pn * tstepB : cB;
#pragma unroll 1
        for (int t = 0; t < nt; t += 2) {
            const bool last = (t == nt - 2);
            if (GATHER) { gsel[0] = last ? gnx[0] : gofs[0]; gsel[1] = last ? gnx[1] : gofs[1]; }
            const char* a1 = cA + (size_t)(t + 1) * kstep;
            const char* a2 = last ? nA : cA + (size_t)(t + 2) * kstep; const char* b2 = last ? nB : cB + (size_t)(t + 2) * kstep;
            const char* a3 = a2 + kstep; const char* b3 = b2 + kstep;
            if (last && has_next) S.a_ready(nxt);
            PG8_LDB(B0, 0, 0); PG8_SCHED; PG8_LDA(At, 0, 0); PG8_STAGEA(PG8_SA(1, 1), a1 + hsA, gofs[1]);
            PG8_WAIT_L(8); PG8_BAR; PG8_WAIT_L(0); PG8_MMA(0, 0, At, B0); PG8_BAR; PG8_SCHED;
            PG8_LDB(B1, 0, 1); PG8_STAGE(PG8_SB(0, 0), b2, voffB);
            PG8_BAR; PG8_WAIT_L(0); PG8_MMA(0, 1, At, B1); PG8_BAR;
            PG8_LDA(At, 0, 1); PG8_STAGEA(PG8_SA(0, 0), a2, gsel[0]);
            PG8_BAR; PG8_WAIT_L(0); PG8_MMA(1, 0, At, B0); PG8_BAR; PG8_SCHED;
            PG8_STAGE(PG8_SB(0, 1), b2 + hstepB, voffB);
            PG8_WAIT_V(6); PG8_BAR; PG8_MMA(1, 1, At, B1); PG8_BAR;
            PG8_LDB(B0, 1, 0); PG8_SCHED; PG8_LDA(At, 1, 0); PG8_STAGEA(PG8_SA(0, 1), a2 + hsA, gsel[1]);
            PG8_WAIT_L(8); PG8_BAR; PG8_WAIT_L(0); PG8_MMA(0, 0, At, B0); PG8_BAR; PG8_SCHED;
            PG8_LDB(B1, 1, 1); PG8_STAGE(PG8_SB(1, 0), b3, voffB);
            PG8_BAR; PG8_WAIT_L(0); PG8_MMA(0, 1, At, B1); PG8_BAR;
            PG8_LDA(At, 1, 1); PG8_STAGEA(PG8_SA(1, 0), a3, gsel[0]);
            PG8_BAR; PG8_WAIT_L(0); PG8_MMA(1, 0, At, B0); PG8_BAR; PG8_SCHED;
            PG8_STAGE(PG8_SB(1, 1), b3 + hstepB, voffB);
            PG8_WAIT_V(6); PG8_BAR; PG8_MMA(1, 1, At, B1); PG8_BAR;
        }
        PG8_STAMP();
        if constexpr (FP8) asm volatile("s_nop 15\n\ts_nop 15" ::: "memory");
        if constexpr (!Epi::AFTER_DRAIN) { E(acc, cur, wr, wc, fr, fq); S.done(cur); }
        PG8_STAMP();
        if (!has_next) break;
#pragma unroll
        for (int a = 0; a < 2; ++a)
#pragma unroll
            for (int b = 0; b < 2; ++b)
#pragma unroll
                for (int m = 0; m < 4; ++m)
#pragma unroll
                    for (int n = 0; n < 2; ++n) acc[a][b][m][n] = (f32x4){0.f, 0.f, 0.f, 0.f};
        cur = nxt; cA = nA; cB = nB; ++ui;
        if (GATHER) { gofs[0] = gnx[0]; gofs[1] = gnx[1]; }
    }
    PG8_WAIT_V(0);
    if (wr == 0) PG8_BAR;
    PG8_BAR;
    if constexpr (Epi::AFTER_DRAIN) { E.fused(acc, cur, wr, wc, fr, fq, lds, wid, lane); S.done(cur); }
    PG8_STAMP();
    if (STAMP && wid == 0) { stamps[lane] = lane < nts ? (((unsigned long long)(unsigned)ts_hi << 32) | (unsigned)ts_lo) : 0ull;
        if (lane == 62) stamps[62] = rt_entry; if (lane == 63) stamps[63] = (unsigned long long)wall_clock64(); }
#undef PG8_STAMP
#undef PG8_SA
#undef PG8_SB
#undef PG8_STAGE
#undef PG8_LDA
#undef PG8_LDB
#undef PG8_MMA
#undef PG8_MMA8
#undef PG8_MMA16
#undef PG8_CAT8
#undef PG8_WAIT_V
#undef PG8_WAIT_L
#undef PG8_BAR
#undef PG8_SCHED
#undef PG8_STAGEA
}
}

struct WTile { const float* src; bf16_t* dst; int ldS, K, N, k0, n0, mode, which; };
constexpr int WT_L = 912 + 1024 + 256 + 256 + NEXP * 3 * 256;
__device__ __forceinline__ void wtile_decode(const PV& p, int t, WTile& d) {
    const int l = t / WT_L; int r = t % WT_L;
    d.mode = 0; d.which = 0; d.ldS = D; d.K = D; d.N = D;
    if (r < 1936) {
        const float* win = p.in(8) + (size_t)l * D * N_IN;
        d.ldS = N_IN;
        if (r < 912) { d.src = win; d.N = C_MG; d.dst = wsp<bf16_t>(p, OFF_BTIN1) + (size_t)l * NP1 * D; }
        else { r -= 912; d.src = win + C_MG; d.N = 4096; d.dst = wsp<bf16_t>(p, OFF_BTGATE) + (size_t)l * 4096 * D / 2; d.mode = 3;     }
        if (d.mode == 3) { d.n0 = (r & 63) * 64; d.k0 = (r >> 6) * 64; } else { d.n0 = (r % 57) * 64; d.k0 = (r / 57) * 64; }
    } else if (r < 2192) {
        r -= 1936; const int i = r >> 6, q = r & 63;
        d.src = p.in(27) + ((size_t)l * 4 + i) * 256 * D; d.K = 256; d.dst = wsp<bf16_t>(p, OFF_BTBR) + ((size_t)l * 4 + i) * 1024 * 256;
        d.n0 = (q & 15) * 64; d.k0 = (q >> 4) * 64;
    } else if (r < 2448) {
        r -= 2192; d.src = p.in(28) + (size_t)l * D * D; d.dst = wsp<bf16_t>(p, OFF_BTOUT) + (size_t)l * D * D;
        d.n0 = (r & 15) * 64; d.k0 = (r >> 4) * 64;
    } else {
        r -= 2448; const int e = r / 768, q = r % 768, mat = q >> 8, tq = q & 255; const size_t le = (size_t)l * NEXP + e;
        if (mat == 2) { d.src = p.in(32) + le * D * D; d.dst = wsp<bf16_t>(p, OFF_BTW2) + le * D * D; }
        else { d.src = p.in(mat == 0 ? 30 : 31) + le * D * D; d.dst = wsp<bf16_t>(p, OFF_BTW13) + le * 2048 * D; d.mode = 1; d.which = mat; }
        d.n0 = (tq & 15) * 64; d.k0 = (tq >> 4) * 64;
    }
}
constexpr int WQ_WORD = 3520;
__device__ __forceinline__ void ph_weights(const PV& p, char* smem) {
    float* tiles = (float*)smem;
    const int tid = TID();
    for (int l = 0; l < NLAYER; ++l) {
        bf16_t* bt1 = wsp<bf16_t>(p, OFF_BTIN1) + (size_t)l * NP1 * D;
        for (size_t i = (size_t)BID() * NTHR + tid; i < (size_t)(NP1 - C_MG) * D / 8; i += (size_t)gridDim.x * NTHR)
            *(u32x4*)(bt1 + (size_t)C_MG * D + i * 8) = (u32x4){0u, 0u, 0u, 0u};
    }
    constexpr int nchunk = NLAYER * WT_L / 4;
    static_assert(WT_L % 4 == 0, "chunking");
    unsigned* ctr = wsp<unsigned>(p, OFF_BAR) + WQ_WORD;
    volatile __attribute__((address_space(3))) unsigned* qw = (volatile __attribute__((address_space(3))) unsigned*)(smem + SMEM_BYTES + 16 + 280);
    const int li = tid >> 4, lj4 = (tid & 15) * 4;
    auto issue = [&](int c, f32x4 (&v)[4][2]) {
#pragma unroll
        for (int q = 0; q < 4; ++q) {
            WTile d; wtile_decode(p, c * 4 + q, d);
#pragma unroll
            for (int ps = 0; ps < 2; ++ps) {
                v[q][ps] = (f32x4){0.f, 0.f, 0.f, 0.f};
                if (d.n0 + lj4 < d.N) v[q][ps] = *(const f32x4*)(d.src + (size_t)(d.k0 + li + 32 * ps) * d.ldS + d.n0 + lj4);
            }
        }
    };
    __syncthreads();
    if (tid == 0) *qw = __hip_atomic_fetch_add(ctr, 2u, __ATOMIC_RELAXED, __HIP_MEMORY_SCOPE_AGENT);
    __syncthreads();
    int c0 = (int)__builtin_amdgcn_readfirstlane(*qw), c1 = c0 + 1;
    f32x4 cur[4][2], nxt[4][2];
#pragma unroll
    for (int q = 0; q < 4; ++q) { cur[q][0] = cur[q][1] = nxt[q][0] = nxt[q][1] = (f32x4){0.f, 0.f, 0.f, 0.f}; }
    if (c0 < nchunk) issue(c0, cur);
    if (c1 < nchunk) issue(c1, nxt);
    while (c0 < nchunk) {
        unsigned c2r = 0u;
        if (tid == 0) c2r = __hip_atomic_fetch_add(ctr, 1u, __ATOMIC_RELAXED, __HIP_MEMORY_SCOPE_AGENT);
        __syncthreads();
#pragma unroll
        for (int q = 0; q < 4; ++q)
#pragma unroll
            for (int ps = 0; ps < 2; ++ps) { const int i = li + 32 * ps; float* tile = tiles + q * (64 * 65);
                tile[i * 65 + lj4 + 0] = cur[q][ps][0]; tile[i * 65 + lj4 + 1] = cur[q][ps][1]; tile[i * 65 + lj4 + 2] = cur[q][ps][2]; tile[i * 65 + lj4 + 3] = cur[q][ps][3]; }
        __syncthreads();
#pragma unroll 1
        for (int q = 0; q < 4; ++q) {
            WTile d; wtile_decode(p, c0 * 4 + q, d);
            const float* tile = tiles + q * (64 * 65);
            const int n = tid >> 3, kc = (tid & 7) * 8;
            if (d.n0 + n < d.N) {
                const int ng = d.n0 + n;
                int drow = ng;
                if (d.mode == 1) drow = (ng >> 7) * 256 + d.which * 128 + (ng & 127);
                if (d.mode == 3) { const int i = ng >> 10, mc = ng & 1023; drow = (mc >> 6) * 256 + 128 * (i >> 1) + 32 * ((mc & 63) >> 4) + 16 * (i & 1) + (mc & 15); }
                if (d.mode == 3) {
                    int q0 = 0, q1 = 0;
                    q0 = __builtin_amdgcn_cvt_pk_fp8_f32(tile[(kc + 0) * 65 + n] * 32.f, tile[(kc + 1) * 65 + n] * 32.f, q0, false);
                    q0 = __builtin_amdgcn_cvt_pk_fp8_f32(tile[(kc + 2) * 65 + n] * 32.f, tile[(kc + 3) * 65 + n] * 32.f, q0, true);
                    q1 = __builtin_amdgcn_cvt_pk_fp8_f32(tile[(kc + 4) * 65 + n] * 32.f, tile[(kc + 5) * 65 + n] * 32.f, q1, false);
                    q1 = __builtin_amdgcn_cvt_pk_fp8_f32(tile[(kc + 6) * 65 + n] * 32.f, tile[(kc + 7) * 65 + n] * 32.f, q1, true);
                    *(u32x2*)((unsigned char*)d.dst + (size_t)drow * d.K + d.k0 + kc) = (u32x2){(unsigned)q0, (unsigned)q1};
                } else {
                    u32x4 w;
                    w[0] = pack2(tile[(kc + 0) * 65 + n], tile[(kc + 1) * 65 + n]);
                    w[1] = pack2(tile[(kc + 2) * 65 + n], tile[(kc + 3) * 65 + n]);
                    w[2] = pack2(tile[(kc + 4) * 65 + n], tile[(kc + 5) * 65 + n]);
                    w[3] = pack2(tile[(kc + 6) * 65 + n], tile[(kc + 7) * 65 + n]);
                    *(u32x4*)(d.dst + (size_t)drow * d.K + d.k0 + kc) = w;
                }
            }
        }
        if (tid == 0) *qw = c2r;
        __syncthreads();
        const int c2 = (int)__builtin_amdgcn_readfirstlane(*qw);
#pragma unroll
        for (int q = 0; q < 4; ++q) { cur[q][0] = nxt[q][0]; cur[q][1] = nxt[q][1]; }
        c0 = c1; c1 = c2;
        if (c1 < nchunk) issue(c1, nxt);
    }
    __syncthreads();
}

__device__ __forceinline__ void ph_mod(const PV& p, char* smem) {
    float* s = (float*)smem;
    float* red = s + 17 * 1024;
    const int tid = TID();
    for (int i = tid; i < 17 * 1024; i += NTHR) { const float v = i < 16384 ? p.in(1)[i] : p.in(3)[i - 16384]; s[i] = siluf_(v); }
    __syncthreads();
    for (int u = gridDim.x - 1 - BID(); u < NLAYER * 96; u += gridDim.x) {
        const int l = u / 96, col = (u % 96) * 64 + (tid & 63), ks = tid >> 6;
        const float* w = p.in(4) + (size_t)l * D * 6144 + col;
        float acc[17];
#pragma unroll
        for (int r = 0; r < 17; ++r) acc[r] = 0.f;
        for (int k0 = ks * 128; k0 < ks * 128 + 128; k0 += 16) {
            float wv[16];
#pragma unroll
            for (int q = 0; q < 16; ++q) wv[q] = w[(size_t)(k0 + q) * 6144];
#pragma unroll
            for (int q = 0; q < 16; ++q)
#pragma unroll
                for (int r = 0; r < 17; ++r) acc[r] += s[r * 1024 + k0 + q] * wv[q];
        }
#pragma unroll
        for (int r = 0; r < 17; ++r) red[(ks * 17 + r) * 64 + (tid & 63)] = acc[r];
        __syncthreads();
        for (int i = tid; i < 17 * 64; i += NTHR) {
            const int r = i / 64, c = i % 64, cg = (u % 96) * 64 + c;
            float v = p.in(5)[(size_t)l * 6144 + cg];
#pragma unroll
            for (int q = 0; q < 8; ++q) v += red[(q * 17 + r) * 64 + c];
            if (r < 16) wsp<float>(p, OFF_MODX)[((size_t)l * NB + r) * 6144 + cg] = v;
            else wsp<float>(p, OFF_MODC)[(size_t)l * 6144 + cg] = v;
        }
        __syncthreads();
    }
}

__device__ __forceinline__ void ph_hfilt(const PV& p, char* smem) {
    float* feats = (float*)smem;
    float* h1 = feats + 64 * 33;
    float* h2 = h1 + 64 * 64;
    const int tid = TID();
    for (int u = BID(); u < NLAYER * 68; u += gridDim.x) {
        const int l = u / 68, ub = u % 68, w = ub >= 64 ? 1 : 0, jb = w ? ub - 64 : ub, L = w ? LC : LQ;
        __syncthreads();
        for (int i = tid; i < 64 * 33; i += NTHR) {
            const int pos = i / 33, fi = i % 33; const float j = (float)(jb * 64 + pos);
            float v;
            if (fi == 0) v = j / (float)(L - 1);
            else {
                const int k = (fi - 1) & 15; const float f = 1e-4f + (float)k * ((15.0f - 1e-4f) / 15.0f);
                const float wv = 6.283185307179586f * j / (float)L;
                v = fi <= 16 ? cosf(wv * f) : -sinf(wv * f);
            }
            feats[i] = v;
        }
        __syncthreads();
        const float* w1 = p.in(13) + (size_t)l * 33 * 64; const float* b1 = p.in(14) + l * 64;
        const float* w2 = p.in(15) + (size_t)l * 64 * 64; const float* b2 = p.in(16) + l * 64;
        const float* w3 = p.in(17) + (size_t)l * 64 * 512; const float* fr = p.in(18) + l * 128;
        for (int i = tid; i < 64 * 64; i += NTHR) {
            const int pos = i >> 6, k = i & 63; float a = b1[k];
            float wq[33];
#pragma unroll
            for (int f = 0; f < 33; ++f) wq[f] = w1[f * 64 + k];
#pragma unroll
            for (int f = 0; f < 33; ++f) a += feats[pos * 33 + f] * wq[f];
            h1[i] = sinf(fr[k] * a);
        }
        __syncthreads();
        for (int i = tid; i < 64 * 64; i += NTHR) {
            const int pos = i >> 6, k = i & 63; float a = b2[k];
#pragma unroll
            for (int f0 = 0; f0 < 64; f0 += 16) {
                float wq[16];
#pragma unroll
                for (int f = 0; f < 16; ++f) wq[f] = w2[(f0 + f) * 64 + k];
#pragma unroll
                for (int f = 0; f < 16; ++f) a += h1[pos * 64 + f0 + f] * wq[f];
            }
            h2[i] = sinf(fr[64 + k] * a);
        }
        __syncthreads();
        {
            const int n = tid; float asum = 0.f;
            const float dec = fabsf(p.in(19)[(size_t)l * 512 + n]);
            float* hr = wsp<float>(p, OFF_HRAW) + (size_t)l * HRAW_L + (w ? (size_t)512 * LQ : 0) + (size_t)n * L + jb * 64;
            float w3c[64];
#pragma unroll
            for (int k = 0; k < 64; ++k) w3c[k] = w3[k * 512 + n];
            for (int pos = 0; pos < 64; ++pos) {
                float a = 0.f;
#pragma unroll
                for (int k = 0; k < 64; ++k) a += h2[pos * 64 + k] * w3c[k];
                const int j = jb * 64 + pos; const float dist = fabsf((float)(j - L / 2)) / (float)(L / 2);
                a *= __expf(-dist * dec) + 0.05f;
                hr[pos] = a; asum += fabsf(a);
            }
            wsp<float>(p, OFF_PSUM)[((size_t)l * 68 + ub) * 512 + n] = asum;
        }
    }
}

__device__ __forceinline__ int row_chunk_id() { const int b = BID(), G = gridDim.x; return (G % 8 == 0) ? (b % 8) * (G / 8) + b / 8 : b; }
__device__ __forceinline__ void ph_norm1(const PV& p, int l, int grp) {
    const int tid = TID(), lane = tid & 63, wid = tid >> 6;
    const float* gain = p.in(6) + (size_t)l * D;
    bf16_t* hx = wsp<bf16_t>(p, OFF_HX);
    const int G = gridDim.x, rpc = (R + G - 1) / G, j0 = row_chunk_id() * rpc, j1 = (j0 + rpc < R) ? j0 + rpc : R;
    auto rowsrc = [&](int r) { const int bl = r / TT, pp = r % TT, b = grp * BG + bl; return stream_src(p, l, b, pp) + lane * 4; };
    f32x4 xa[4], xb[4];
#pragma unroll
    for (int i = 0; i < 4; ++i) { xa[i] = (f32x4){0.f, 0.f, 0.f, 0.f}; xb[i] = xa[i]; }
    if (j0 + wid < j1) { const float* s0 = rowsrc(j0 + wid);
#pragma unroll
        for (int i = 0; i < 4; ++i) xa[i] = *(const f32x4*)(s0 + i * 256); }
    if (j0 + wid + 8 < j1) { const float* s0 = rowsrc(j0 + wid + 8);
#pragma unroll
        for (int i = 0; i < 4; ++i) xb[i] = *(const f32x4*)(s0 + i * 256); }
    int curkey = -1; f32x4 gsc[4], shv[4];
#pragma unroll
    for (int i = 0; i < 4; ++i) { gsc[i] = (f32x4){0.f, 0.f, 0.f, 0.f}; shv[i] = gsc[i]; }
    for (int r = j0 + wid; r < j1; r += 8) {
        const int bl = r / TT, pp = r % TT, key = bl * 2 + (pp < LC ? 1 : 0);
        if (key != curkey) {
            const int b = grp * BG + bl;
            const float* mod = pp < LC ? wsp<const float>(p, OFF_MODC) + (size_t)l * 6144 : wsp<const float>(p, OFF_MODX) + ((size_t)l * NB + b) * 6144;
#pragma unroll
            for (int i = 0; i < 4; ++i) { const int c = i * 256 + lane * 4;
                const f32x4 g = *(const f32x4*)(gain + c), sc = *(const f32x4*)(mod + D + c); shv[i] = *(const f32x4*)(mod + c);
#pragma unroll
                for (int k = 0; k < 4; ++k) gsc[i][k] = g[k] * (1.0f + sc[k]); }
            curkey = key;
        }
        f32x4 x[4]; float ss = 0.f;
#pragma unroll
        for (int i = 0; i < 4; ++i) { x[i] = xa[i]; xa[i] = xb[i]; ss += x[i][0] * x[i][0] + x[i][1] * x[i][1] + x[i][2] * x[i][2] + x[i][3] * x[i][3]; }
        if (r + 16 < j1) { const float* s0 = rowsrc(r + 16);
#pragma unroll
            for (int i = 0; i < 4; ++i) xb[i] = *(const f32x4*)(s0 + i * 256); }
        ss = wave_sum(ss);
        const float rs = rsqrtf(ss * (1.0f / D) + 1e-6f);
#pragma unroll
        for (int i = 0; i < 4; ++i) {
            const int c = i * 256 + lane * 4;
            f32x4 y;
#pragma unroll
            for (int k = 0; k < 4; ++k) y[k] = (x[i][k] * rs) * gsc[i][k] + shv[i][k];
            u32x2 w; w[0] = pack2(y[0], y[1]); w[1] = pack2(y[2], y[3]);
            *(u32x2*)(hx + (size_t)r * D + c) = w;
            int q8 = 0; q8 = __builtin_amdgcn_cvt_pk_fp8_f32(y[0], y[1], q8, false); q8 = __builtin_amdgcn_cvt_pk_fp8_f32(y[2], y[3], q8, true);
            *(unsigned*)(wsp<unsigned char>(p, OFF_HX8) + (size_t)r * D + c) = (unsigned)q8;
        }
    }
}

__device__ __forceinline__ void ph_norm2(const PV& p, int l, int grp, char* smem) {
    const int tid = TID(), lane = tid & 63, wid = tid >> 6;
    float* rt = (float*)smem;
    {
        const float* rsrc = p.in(29) + (size_t)l * D * NEXP;
#pragma unroll
        for (int i0 = 0; i0 < D * NEXP; i0 += NTHR * 8) {
            float t[8];
#pragma unroll
            for (int k = 0; k < 8; ++k) t[k] = rsrc[i0 + k * NTHR + tid];
#pragma unroll
            for (int k = 0; k < 8; ++k) { const int i = i0 + k * NTHR + tid; rt[(i & 15) * D + (i >> 4)] = t[k]; }
        }
        __syncthreads();
    }
    const float* gain = p.in(7) + (size_t)l * D;
    bf16_t* hx = wsp<bf16_t>(p, OFF_HX);
    const bf16_t* X1 = wsp<const bf16_t>(p, OFF_X1);
    const bool compact = l == NLAYER - 1; const int npairs = (compact ? BG * LQ : R) / 2, G = gridDim.x, ppc = (npairs + G - 1) / G;
    const int j0 = row_chunk_id() * ppc, j1 = (j0 + ppc < npairs) ? j0 + ppc : npairs;
    auto rowof = [&](int q) { return compact ? (q / LQ) * TT + LC + (q % LQ) : q; };
    u32x2 xa[4], xb[4], xa2[4], xb2[4];
#pragma unroll
    for (int i = 0; i < 4; ++i) { xa[i] = (u32x2){0u, 0u}; xb[i] = (u32x2){0u, 0u}; xa2[i] = (u32x2){0u, 0u}; xb2[i] = (u32x2){0u, 0u}; }
    if (j0 + wid < j1) { const bf16_t* s0 = X1 + (size_t)rowof(2 * (j0 + wid)) * D + lane * 4;
#pragma unroll
        for (int i = 0; i < 4; ++i) { xa[i] = *(const u32x2*)(s0 + i * 256); xb[i] = *(const u32x2*)(s0 + D + i * 256); } }
    if (j0 + wid + 8 < j1) { const bf16_t* s0 = X1 + (size_t)rowof(2 * (j0 + wid + 8)) * D + lane * 4;
#pragma unroll
        for (int i = 0; i < 4; ++i) { xa2[i] = *(const u32x2*)(s0 + i * 256); xb2[i] = *(const u32x2*)(s0 + D + i * 256); } }
    int curkey = -1; f32x4 gsc[4], shv[4];
#pragma unroll
    for (int i = 0; i < 4; ++i) { gsc[i] = (f32x4){0.f, 0.f, 0.f, 0.f}; shv[i] = (f32x4){0.f, 0.f, 0.f, 0.f}; }
    for (int j = j0 + wid; j < j1; j += 8) {
        asm volatile("" ::: "memory");
        const int rA = rowof(2 * j), bl = rA / TT, pp = rA % TT, key = bl * 2 + (pp < LC ? 1 : 0);
        if (key != curkey) {
            const int b = grp * BG + bl;
            const float* mod = pp < LC ? wsp<const float>(p, OFF_MODC) + (size_t)l * 6144 : wsp<const float>(p, OFF_MODX) + ((size_t)l * NB + b) * 6144;
#pragma unroll
            for (int i = 0; i < 4; ++i) { const int c = i * 256 + lane * 4;
                const f32x4 g = *(const f32x4*)(gain + c), sc = *(const f32x4*)(mod + 4 * D + c); shv[i] = *(const f32x4*)(mod + 3 * D + c);
#pragma unroll
                for (int q = 0; q < 4; ++q) gsc[i][q] = g[q] * (1.0f + sc[q]); }
            curkey = key;
        }
        f32x4 x[2][4]; float ss[2] = {0.f, 0.f};
#pragma unroll
        for (int i = 0; i < 4; ++i) {
            x[0][i] = (f32x4){__uint_as_float(xa[i][0] << 16), __uint_as_float(xa[i][0] & 0xffff0000u), __uint_as_float(xa[i][1] << 16), __uint_as_float(xa[i][1] & 0xffff0000u)};
            x[1][i] = (f32x4){__uint_as_float(xb[i][0] << 16), __uint_as_float(xb[i][0] & 0xffff0000u), __uint_as_float(xb[i][1] << 16), __uint_as_float(xb[i][1] & 0xffff0000u)};
#pragma unroll
            for (int q = 0; q < 4; ++q) { ss[0] += x[0][i][q] * x[0][i][q]; ss[1] += x[1][i][q] * x[1][i][q]; }
        }
#pragma unroll
        for (int i = 0; i < 4; ++i) { xa[i] = xa2[i]; xb[i] = xb2[i]; }
        if (j + 16 < j1) { const bf16_t* s0 = X1 + (size_t)rowof(2 * (j + 16)) * D + lane * 4;
#pragma unroll
            for (int i = 0; i < 4; ++i) { xa2[i] = *(const u32x2*)(s0 + i * 256); xb2[i] = *(const u32x2*)(s0 + D + i * 256); } }
#pragma unroll
        for (int o = 32; o > 0; o >>= 1) { ss[0] += __shfl_xor(ss[0], o); ss[1] += __shfl_xor(ss[1], o); }
        const float rs[2] = {rsqrtf(ss[0] * (1.0f / D) + 1e-6f), rsqrtf(ss[1] * (1.0f / D) + 1e-6f)};
        f32x2 lgp[NEXP];
#pragma unroll
        for (int e = 0; e < NEXP; ++e) lgp[e] = (f32x2){0.f, 0.f};
        bf16_t* hrow = hx + (size_t)rA * D + lane * 4;
#pragma unroll
        for (int i = 0; i < 4; ++i) {
            asm volatile("" ::: "memory");
            const int c = i * 256 + lane * 4;
            f32x4 y[2];
#pragma unroll
            for (int k = 0; k < 2; ++k)
#pragma unroll
                for (int q = 0; q < 4; ++q) y[k][q] = (x[k][i][q] * rs[k]) * gsc[i][q] + shv[i][q];
            { u32x2 w; w[0] = pack2(y[0][0], y[0][1]); w[1] = pack2(y[0][2], y[0][3]); *(u32x2*)(hrow + i * 256) = w; }
            { u32x2 w; w[0] = pack2(y[1][0], y[1][1]); w[1] = pack2(y[1][2], y[1][3]); *(u32x2*)(hrow + D + i * 256) = w; }
            const f32x2 yp0 = {y[0][0], y[1][0]}, yp1 = {y[0][1], y[1][1]}, yp2 = {y[0][2], y[1][2]}, yp3 = {y[0][3], y[1][3]};
#pragma unroll
            for (int e = 0; e < NEXP; ++e) { const f32x4 rv = *(const f32x4*)(rt + e * D + c);
                lgp[e] += yp0 * rv[0]; lgp[e] += yp1 * rv[1]; lgp[e] += yp2 * rv[2]; lgp[e] += yp3 * rv[3]; }
        }
        float lg[2][NEXP];
#pragma unroll
        for (int e = 0; e < NEXP; ++e) { lg[0][e] = lgp[e][0]; lg[1][e] = lgp[e][1]; }
        float v8[2][8], v4[2][4], v2[2][2], v1[2];
        { const bool hi = (lane & 32) != 0;
#pragma unroll
          for (int k = 0; k < 2; ++k)
#pragma unroll
            for (int i = 0; i < 8; ++i) { const float keep = hi ? lg[k][i + 8] : lg[k][i], send = hi ? lg[k][i] : lg[k][i + 8]; v8[k][i] = keep + __shfl_xor(send, 32); } }
        { const bool hi = (lane & 16) != 0;
#pragma unroll
          for (int k = 0; k < 2; ++k)
#pragma unroll
            for (int i = 0; i < 4; ++i) { const float keep = hi ? v8[k][i + 4] : v8[k][i], send = hi ? v8[k][i] : v8[k][i + 4]; v4[k][i] = keep + __shfl_xor(send, 16); } }
        { const bool hi = (lane & 8) != 0;
#pragma unroll
          for (int k = 0; k < 2; ++k)
#pragma unroll
            for (int i = 0; i < 2; ++i) { const float keep = hi ? v4[k][i + 2] : v4[k][i], send = hi ? v4[k][i] : v4[k][i + 2]; v2[k][i] = keep + __shfl_xor(send, 8); } }
        { const bool hi = (lane & 4) != 0;
#pragma unroll
          for (int k = 0; k < 2; ++k) { const float keep = hi ? v2[k][1] : v2[k][0], send = hi ? v2[k][0] : v2[k][1]; v1[k] = keep + __shfl_xor(send, 4); } }
#pragma unroll
        for (int k = 0; k < 2; ++k) { v1[k] += __shfl_xor(v1[k], 2); }
#pragma unroll
        for (int k = 0; k < 2; ++k) { v1[k] += __shfl_xor(v1[k], 1); }
        const int myexp = ((lane >> 5) & 1) * 8 + ((lane >> 4) & 1) * 4 + ((lane >> 3) & 1) * 2 + ((lane >> 2) & 1);
        float mx[2] = {v1[0], v1[1]};
#pragma unroll
        for (int o = 4; o < 64; o <<= 1) { mx[0] = fmaxf(mx[0], __shfl_xor(mx[0], o)); mx[1] = fmaxf(mx[1], __shfl_xor(mx[1], o)); }
        const float ev[2] = {__expf(v1[0] - mx[0]), __expf(v1[1] - mx[1])}; float sum[2] = {ev[0], ev[1]};
#pragma unroll
        for (int o = 4; o < 64; o <<= 1) { sum[0] += __shfl_xor(sum[0], o); sum[1] += __shfl_xor(sum[1], o); }
        if ((lane & 3) == 0) {
            float* aff = wsp<float>(p, OFF_AFF);
            const f32x2 a2 = {ev[0] * __builtin_amdgcn_rcpf(sum[0]), ev[1] * __builtin_amdgcn_rcpf(sum[1])};
            if (pp < LC) *(f32x2*)(aff + (size_t)BG * NEXP * LQ + ((size_t)bl * NEXP + myexp) * LC + pp) = a2;
            else *(f32x2*)(aff + ((size_t)bl * NEXP + myexp) * LQ + (pp - LC)) = a2;
            int* inv = wsp<int>(p, OFF_INV) + (size_t)rA * NEXP + myexp;
            inv[0] = -1; inv[NEXP] = -1;
        }
    }
}

__device__ __forceinline__ int mtile_expert(int mt) { return mt < LATS / 256 ? mt / (2 * BG) : mt - LATS / 256; }
struct SOrder {
    int nM, nN, nwg, G, c, mode, wgm;
    __device__ void init(int nM_, int nN_, int mode_) { nM = nM_; nN = nN_; nwg = nM * nN; G = gridDim.x; c = BID(); mode = mode_; wgm = pg8::WGM; }
    __device__ bool next(int i, pg8::Unit& u) const {
        const long L = (long)i * G + c; if (L >= nwg) return false;
        int wgid = (int)L; { const int q = nwg / pg8::NXCD, r = nwg % pg8::NXCD, xcd = wgid % pg8::NXCD, off = wgid / pg8::NXCD; wgid = (xcd < r ? xcd * (q + 1) : r * (q + 1) + (xcd - r) * q) + off; }
        const int nig = wgm * nN, gid = wgid / nig, fm = gid * wgm, gsz = (nM - fm) < wgm ? (nM - fm) : wgm;
        int pm = fm + ((wgid % nig) % gsz); u.pn = (wgid % nig) / gsz;
        if (mode & 8) pm = nM - 1 - pm;
        if (mode & 1) pm = (pm >> 4) * 17 + 1 + (pm & 15);
        u.pm = pm; u.bexp = (mode & 2) ? (unsigned)mtile_expert(pm) : 0u; u.aofs = (mode & 4) ? (u.pn >> 2) * 256 : 0;
        return true;
    }
    __device__ __forceinline__ void a_ready(const pg8::Unit&) const {}
    __device__ __forceinline__ void done(const pg8::Unit&) const {}
};
struct EpiStoreBf16 {
    static constexpr bool PERM = true, AFTER_DRAIN = false;
    bf16_t* O; int ldc; const float* rowscale;
    __device__ __forceinline__ void operator()(const f32x4 (&acc)[2][2][4][2], const pg8::Unit& u, int wr, int wc, int fr, int fq) const {
        const int row0 = u.pm * 256 + wr * 64 + fr, col0 = u.pn * 256 + wc * 32 + 8 * fq;
#pragma unroll
        for (int ai = 0; ai < 2; ++ai)
#pragma unroll
            for (int m = 0; m < 4; ++m) {
                const int row = row0 + ai * 128 + m * 16; const float s = rowscale ? rowscale[row] : 1.0f;
                bf16_t* rowp = O + (size_t)row * ldc + col0;
#pragma unroll
                for (int bj = 0; bj < 2; ++bj) { const f32x4 v0 = acc[ai][bj][m][0] * s, v1 = acc[ai][bj][m][1] * s;
                    u32x4 w; w[0] = pack2(v0[0], v0[1]); w[1] = pack2(v0[2], v0[3]); w[2] = pack2(v1[0], v1[1]); w[3] = pack2(v1[2], v1[3]);
                    *(u32x4*)(rowp + bj * 128) = w; }
            }
    }
};
struct EpiSwiglu {
    static constexpr bool PERM = true, AFTER_DRAIN = false;
    bf16_t* H;
    __device__ __forceinline__ void operator()(const f32x4 (&acc)[2][2][4][2], const pg8::Unit& u, int wr, int wc, int fr, int fq) const {
        const int row0 = u.pm * 256 + wr * 64 + fr, col0 = u.pn * 128 + wc * 32 + 8 * fq;
#pragma unroll
        for (int ai = 0; ai < 2; ++ai)
#pragma unroll
            for (int m = 0; m < 4; ++m) {
                float hv[8];
#pragma unroll
                for (int n = 0; n < 2; ++n)
#pragma unroll
                    for (int j = 0; j < 4; ++j) hv[n * 4 + j] = siluf_(acc[ai][0][m][n][j]) * acc[ai][1][m][n][j];
                u32x4 w; w[0] = pack2(hv[0], hv[1]); w[1] = pack2(hv[2], hv[3]); w[2] = pack2(hv[4], hv[5]); w[3] = pack2(hv[6], hv[7]);
                *(u32x4*)(H + (size_t)(row0 + ai * 128 + m * 16) * D + col0) = w;
            }
    }
};
struct EpiResid {
    static constexpr bool PERM = true, AFTER_DRAIN = false;
    const PV* pp; int l, grp;
    __device__ __forceinline__ void operator()(const f32x4 (&acc)[2][2][4][2], const pg8::Unit& u, int wr, int wc, int fr, int fq) const {
        const PV& p = *pp;
        const int bl = u.pm / 17, p0 = (u.pm % 17) * 256, b = grp * BG + bl;
        const float* mod = (p0 < LC ? wsp<const float>(p, OFF_MODC) + (size_t)l * 6144 : wsp<const float>(p, OFF_MODX) + ((size_t)l * NB + b) * 6144) + 2 * D;
        const int col0 = u.pn * 256 + wc * 32 + 8 * fq;
        bf16_t* X1 = wsp<bf16_t>(p, OFF_X1);
        f32x4 mv[2][2];
#pragma unroll
        for (int bj = 0; bj < 2; ++bj)
#pragma unroll
            for (int n = 0; n < 2; ++n) mv[bj][n] = *(const f32x4*)(mod + col0 + bj * 128 + n * 4);
        f32x4 sc[4], sn[4];
        { const float* s0 = stream_src(p, l, b, p0 + wr * 64 + fr) + col0;
#pragma unroll
          for (int q = 0; q < 4; ++q) sc[q] = *(const f32x4*)(s0 + (q >> 1) * 128 + (q & 1) * 4); }
#pragma unroll
        for (int g = 0; g < 8; ++g) {
            const int ai = g >> 2, m = g & 3;
            const int pq = p0 + ai * 128 + wr * 64 + m * 16 + fr;
            if (g + 1 < 8) { const float* s1 = stream_src(p, l, b, p0 + ((g + 1) >> 2) * 128 + wr * 64 + ((g + 1) & 3) * 16 + fr) + col0;
#pragma unroll
                for (int q = 0; q < 4; ++q) sn[q] = *(const f32x4*)(s1 + (q >> 1) * 128 + (q & 1) * 4); }
            asm volatile("" ::: "memory");
            bf16_t* dst = X1 + (size_t)(bl * TT + pq) * D + col0;
#pragma unroll
            for (int bj = 0; bj < 2; ++bj) {
                const f32x4 v0 = sc[bj * 2] + mv[bj][0] * acc[ai][bj][m][0], v1 = sc[bj * 2 + 1] + mv[bj][1] * acc[ai][bj][m][1];
                u32x4 w; w[0] = pack2(v0[0], v0[1]); w[1] = pack2(v0[2], v0[3]); w[2] = pack2(v1[0], v1[1]); w[3] = pack2(v1[2], v1[3]);
                *(u32x4*)(dst + bj * 128) = w;
            }
#pragma unroll
            for (int q = 0; q < 4; ++q) sc[q] = sn[q];
        }
    }
};

__device__ __forceinline__ void ph_g1(const PV& p, int l, char* smem) {
    pg8::Gemm g; g.A = wsp<const bf16_t>(p, OFF_HX); g.Bt = wsp<const bf16_t>(p, OFF_BTIN1) + (size_t)l * NP1 * D; g.lda = D; g.ldb = D; g.K = D; g.bstride = 0; g.gidx = nullptr;
    SOrder S; S.init(R / 256, NP1 / 256, 0); S.wgm = 2;
    EpiStoreBf16 E; E.O = wsp<bf16_t>(p, OFF_BIG); E.ldc = NP1; E.rowscale = nullptr;
    __syncthreads();
    pg8::gemm_phase(( PG8_LAS unsigned char*)smem, g, S, E);
    __syncthreads();
}

__device__ __forceinline__ void ph_attn_prep(const PV& p, int l, char* smem) {
    const int tid = TID(), lane = tid & 63, wid = tid >> 6;
    float* rt = (float*)smem;
    __syncthreads();
    { const int pos = tid >> 3, i = tid & 7; float sn, cs; sincosf((float)pos * exp2f(-(float)i * (13.287712379549449f / 8.0f)), &sn, &cs); rt[tid * 2] = cs; rt[tid * 2 + 1] = sn; }
    __syncthreads();
    const bf16_t* proj = wsp<const bf16_t>(p, OFF_BIG);
    bf16_t* Qa = wsp<bf16_t>(p, OFF_QA); bf16_t* Ka = wsp<bf16_t>(p, OFF_KA);
    const int j = lane & 7, d0 = j * 4;
    const float* gq = p.in(23) + l * 32; const float* gk = p.in(24) + l * 32;
    const f32x4 gqv = *(const f32x4*)(gq + d0), gkv = *(const f32x4*)(gk + d0);
    u32x2 nq = {0u, 0u}, nk = {0u, 0u};
    { const int r0 = BID() * 8 + wid; if (r0 < R) { nq = *(const u32x2*)(proj + (size_t)r0 * NP1 + C_DQ + lane * 4); nk = *(const u32x2*)(proj + (size_t)r0 * NP1 + C_DK + lane * 4); } }
    for (int r = BID() * 8 + wid; r < R; r += gridDim.x * 8) {
        const u32x2 cq = nq, ck = nk;
        { const int r1 = r + gridDim.x * 8; if (r1 < R) { nq = *(const u32x2*)(proj + (size_t)r1 * NP1 + C_DQ + lane * 4); nk = *(const u32x2*)(proj + (size_t)r1 * NP1 + C_DK + lane * 4); } }
        const int bl = r / TT, pp = r % TT; const bool lat = pp >= LC; const int t = pp - LC;
        const int h = lane >> 4;
        float cs[4], sn[4];
        if (lat) {
            const int pos = (j < 4) ? (t >> 6) : (t & 63);
            const f32x4 a = *(const f32x4*)(rt + (pos * 8 + (j & 1) * 4) * 2), b = *(const f32x4*)(rt + (pos * 8 + (j & 1) * 4) * 2 + 4);
            cs[0] = a[0]; sn[0] = a[1]; cs[1] = a[2]; sn[1] = a[3]; cs[2] = b[0]; sn[2] = b[1]; cs[3] = b[2]; sn[3] = b[3];
        }
#pragma unroll
        for (int which = 0; which < 2; ++which) {
            const u32x2 raw = which ? ck : cq;
            float v[4] = {bf2f((bf16_t)(raw[0] & 0xffff)), bf2f((bf16_t)(raw[0] >> 16)), bf2f((bf16_t)(raw[1] & 0xffff)), bf2f((bf16_t)(raw[1] >> 16))};
            float ss = v[0] * v[0] + v[1] * v[1] + v[2] * v[2] + v[3] * v[3];
            ss += __shfl_xor(ss, 1); ss += __shfl_xor(ss, 2); ss += __shfl_xor(ss, 4);
            const float rs = rsqrtf(ss * (1.0f / 32.0f) + 1e-6f);
            const f32x4 g = which ? gkv : gqv;
#pragma unroll
            for (int c = 0; c < 4; ++c) v[c] = v[c] * rs * g[c];
            if (lat) {
#pragma unroll
                for (int c = 0; c < 4; ++c) {
                    const float o = __shfl_xor(v[c], 2);
                    v[c] = (j & 2) ? (o * sn[c] + v[c] * cs[c]) : (v[c] * cs[c] - o * sn[c]);
                }
            }
            if (!which) {
#pragma unroll
                for (int c = 0; c < 4; ++c) v[c] *= 0.17677669529663687f * 1.4426950408889634f;
            }
            u32x2 w; w[0] = pack2(v[0], v[1]); w[1] = pack2(v[2], v[3]);
            *(u32x2*)((which ? Ka : Qa) + (((size_t)bl * 4 + h) * TT + pp) * 64 + (lane & 15) * 4) = w;
        }
    }
}

__device__ __forceinline__ void ph_hy_prep(const PV& p, int l, char* smem) {
    float* tile = (float*)smem;
    const int tid = TID();
    const bf16_t* proj = wsp<const bf16_t>(p, OFF_BIG);
    bf16_t* hyT = wsp<bf16_t>(p, OFF_HYT);
    const float* cw = p.in(12) + (size_t)l * 3 * 768;
    constexpr int NTT = TT / 64;
    const int total = BG * NTT * 12, G = gridDim.x;
    u32x2 c0 = {0u, 0u}, c1 = {0u, 0u}, c2 = {0u, 0u}, n0 = {0u, 0u}, n1 = {0u, 0u}, n2 = {0u, 0u}, m0 = {0u, 0u}, m1 = {0u, 0u}, m2 = {0u, 0u};
#define HYP_LOAD(uu, r0, r1, r2) do { const int _ct = (uu) % 12, _tt = ((uu) / 12) % NTT, _bl = (uu) / (12 * NTT), _p0 = _tt * 64; \
        const int _s0 = _p0 >= LC ? LC : 0, _sl = _p0 >= LC ? LQ : LC; \
        { const int i = tid, rr = i >> 4, c4 = (i & 15) * 4, pp = _p0 - 1 + rr; r0 = (u32x2){0u, 0u}; if (pp >= _s0 && pp < _s0 + _sl) r0 = *(const u32x2*)(proj + (size_t)(_bl * TT + pp) * NP1 + C_HY + _ct * 64 + c4); } \
        { const int i = tid + 512, rr = i >> 4, c4 = (i & 15) * 4, pp = _p0 - 1 + rr; r1 = (u32x2){0u, 0u}; if (pp >= _s0 && pp < _s0 + _sl) r1 = *(const u32x2*)(proj + (size_t)(_bl * TT + pp) * NP1 + C_HY + _ct * 64 + c4); } \
        { const int i = tid + 1024, rr = i >> 4, c4 = (i & 15) * 4, pp = _p0 - 1 + rr; r2 = (u32x2){0u, 0u}; if (i < 66 * 16 && pp >= _s0 && pp < _s0 + _sl) r2 = *(const u32x2*)(proj + (size_t)(_bl * TT + pp) * NP1 + C_HY + _ct * 64 + c4); } } while (0)
#define HYP_PUT(i, r) do { const int rr = (i) >> 4, c4 = ((i) & 15) * 4; tile[rr * 65 + c4] = __uint_as_float(r[0] << 16); tile[rr * 65 + c4 + 1] = __uint_as_float(r[0] & 0xffff0000u); \
        tile[rr * 65 + c4 + 2] = __uint_as_float(r[1] << 16); tile[rr * 65 + c4 + 3] = __uint_as_float(r[1] & 0xffff0000u); } while (0)
    int u = BID();
    if (u < total) HYP_LOAD(u, c0, c1, c2);
    if (u + G < total) HYP_LOAD(u + G, n0, n1, n2);
    for (; u < total; u += G) {
        const int ct = u % 12, tt = (u / 12) % NTT, bl = u / (12 * NTT);
        const int p0 = tt * 64; const bool lat = p0 >= LC;
        if (u + 2 * G < total) HYP_LOAD(u + 2 * G, m0, m1, m2);
        __syncthreads();
        HYP_PUT(tid, c0); HYP_PUT(tid + 512, c1); if (tid + 1024 < 66 * 16) HYP_PUT(tid + 1024, c2);
        __syncthreads();
        const int ch = tid >> 3, t8 = (tid & 7) * 8, cg = ct * 64 + ch;
        const float w0 = cw[cg], w1 = cw[768 + cg], w2 = cw[1536 + cg];
        float o[8];
#pragma unroll
        for (int q = 0; q < 8; ++q) { const int rr = t8 + q + 1; o[q] = tile[(rr - 1) * 65 + ch] * w0 + tile[rr * 65 + ch] * w1 + tile[(rr + 1) * 65 + ch] * w2; }
        bf16_t* dst = lat ? hyT + ((size_t)bl * 768 + cg) * LQ + (p0 - LC) + t8 : hyT + (size_t)BG * 768 * LQ + ((size_t)bl * 768 + cg) * LC + p0 + t8;
        u32x4 w; w[0] = pack2(o[0], o[1]); w[1] = pack2(o[2], o[3]); w[2] = pack2(o[4], o[5]); w[3] = pack2(o[6], o[7]);
        *(u32x4*)dst = w;
        c0 = n0; c1 = n1; c2 = n2; n0 = m0; n1 = m1; n2 = m2;
    }
#undef HYP_LOAD
#undef HYP_PUT
}

typedef short v4s_t __attribute__((ext_vector_type(4)));
__device__ __forceinline__ v4s_t lds_tr16(const char* p) { return __builtin_amdgcn_ds_read_tr16_b64_v4i16((__attribute__((address_space(3))) v4s_t*)p); }
__device__ __forceinline__ bf16x8 cat_tr(const v4s_t a, const v4s_t b) { return __builtin_shufflevector(a, b, 0, 1, 2, 3, 4, 5, 6, 7); }
template <int DK, int BR>
__device__ __forceinline__ void recur_chunk_unit(const PV& p, int l, int bl, int h, int dir, char* smem, unsigned* qctr, unsigned& nextu) {
    constexpr int RS = DK == 64 ? 160 : 96, NKC = DK / 32, NDT = DK / 16, NST = NDT / 2, VPT = DK / 8, NTG = NTHR / DK, TG = 64 / NTG;
    float* Bf = (float*)smem;
    float* Gp = Bf + 64 * DK;
    float* Bref = Gp + 16 * DK;
    float* Bend = Bref + DK;
    float* Wa = Bend + DK;
    char* Qs = (char*)(Wa + 512);
    char* Ks = Qs + 64 * RS;
    char* STs = Ks + 64 * RS;
    char* Vs = STs + 64 * RS;
    const int tid = TID(), lane = tid & 63, wid = tid >> 6, fr = lane & 15, fq = lane >> 4;
    const int st = tid >> 3, sc = tid & 7;
    const int trq = fr >> 2, trp = fr & 3;

    const int stq = BR == 1 ? st : (wid & 3) * 16 + fr, d0 = BR == 1 ? sc * VPT : (wid >> 2) * 16 + fq * 4;
    const int tt = wid & 3, eh = wid >> 2;
    const bf16_t* proj = wsp<const bf16_t>(p, OFF_BIG);
    bf16_t* obuf = wsp<bf16_t>(p, OFF_OBUF) + ((size_t)dir * 2 + BR) * R * 256;
    __syncthreads();
    float lbv[VPT];
#pragma unroll
    for (int j = 0; j < VPT; ++j) lbv[j] = 0.f;
    if (BR == 1 && l == 1) {
        const float* hl = p.in(21);
#pragma unroll
        for (int j = 0; j < VPT; ++j) { const float a0 = hl[(0 * 2 + dir) * 256 + h * 64 + d0 + j], a1 = hl[(1 * 2 + dir) * 256 + h * 64 + d0 + j]; lbv[j] = 1.0f / (1.0f + __expf(a0 - a1)); }
    }
    float bav[VPT];
#pragma unroll
    for (int j = 0; j < VPT; ++j) bav[j] = 0.f;
    u32x4 wahi = {0u, 0u, 0u, 0u}, walo = {0u, 0u, 0u, 0u};
    if (BR == 0) {
        const float* wa2 = p.in(9) + ((size_t)l * 2 + dir) * 16 * 128; const float* ba = p.in(10) + ((size_t)l * 2 + dir) * 128;
        if (fq < 2) {
            float wv[8];
#pragma unroll
            for (int jj = 0; jj < 8; ++jj) wv[jj] = wa2[(fq * 8 + jj) * 128 + h * 32 + (wid >> 2) * 16 + fr];
#pragma unroll
            for (int jj = 0; jj < 8; jj += 2) {
                const unsigned hi = pack2(wv[jj], wv[jj + 1]);
                const float r0 = wv[jj] - __uint_as_float(hi << 16), r1 = wv[jj + 1] - __uint_as_float(hi & 0xffff0000u);
                wahi[jj >> 1] = hi; walo[jj >> 1] = pack2(r0, r1);
            }
        }
#pragma unroll
        for (int j = 0; j < VPT; ++j) bav[j] = ba[h * 32 + d0 + j];
    }
    __syncthreads();
    f32x4 S[NST];
#pragma unroll
    for (int i = 0; i < NST; ++i) S[i] = (f32x4){0.f, 0.f, 0.f, 0.f};
    float gmask[NTG];
#pragma unroll
    for (int g = 0; g < NTG; ++g) gmask[g] = (dir ? (g > tid / DK) : (g < tid / DK)) ? 1.0f : 0.0f;
    u32x4 rq = {0u, 0u, 0u, 0u}, rk = {0u, 0u, 0u, 0u}, rv = {0u, 0u, 0u, 0u}, ra0 = {0u, 0u, 0u, 0u}, ra1 = {0u, 0u, 0u, 0u};
    auto chunk_pos = [&](int ci) { return dir == 0 ? ci : (ci < 4 ? 3 - ci : 67 - (ci - 4)); };
    auto load_raw = [&](int ci) {
        const bf16_t* row = proj + (size_t)(bl * TT + chunk_pos(ci) * 64 + st) * NP1;
        if (BR == 1) {
            rq = *(const u32x4*)(row + C_HQ + h * 64 + d0); rk = *(const u32x4*)(row + (dir ? C_HFB : C_HFF) + h * 64 + d0); rv = *(const u32x4*)(row + C_HI + h * 64 + sc * 8);
        } else {
            const bf16_t* rowq = proj + (size_t)(bl * TT + chunk_pos(ci) * 64 + stq) * NP1;
            const u32x2 a = *(const u32x2*)(rowq + C_GQ + h * 32 + d0), b = *(const u32x2*)(rowq + C_GK + h * 32 + d0);
            rq[0] = a[0]; rq[1] = a[1]; rk[0] = b[0]; rk[1] = b[1];
            ra0 = (u32x4){0u, 0u, 0u, 0u};
            if (fq < 2) ra0 = *(const u32x4*)(rowq + (dir ? C_GAB : C_GAF) + fq * 8);
            rv = *(const u32x4*)(row + C_GV + h * 64 + sc * 8);
        }
    };
    load_raw(0);
#pragma unroll 1
    for (int ci = 0; ci < TT / 64; ++ci) {
        const int cp = chunk_pos(ci);
        float qv[VPT], kv[VPT], lg[VPT];
        f32x4 z4 = {0.f, 0.f, 0.f, 0.f};
        if (BR == 0) {
            z4 = __builtin_amdgcn_mfma_f32_16x16x32_bf16(__builtin_bit_cast(bf16x8, wahi), __builtin_bit_cast(bf16x8, ra0), z4, 0, 0, 0);
            z4 = __builtin_amdgcn_mfma_f32_16x16x32_bf16(__builtin_bit_cast(bf16x8, walo), __builtin_bit_cast(bf16x8, ra0), z4, 0, 0, 0);
        }
#pragma unroll
        for (int j = 0; j < VPT; ++j) {
            const unsigned wq = rq[j >> 1], wk = rk[j >> 1];
            const float qr = (j & 1) ? __uint_as_float(wq & 0xffff0000u) : __uint_as_float(wq << 16);
            const float kr = (j & 1) ? __uint_as_float(wk & 0xffff0000u) : __uint_as_float(wk << 16);
            if (BR == 1) {
                qv[j] = siluf_(qr);
                const float sg = sigmoidf_(kr), f = lbv[j] + (1.0f - lbv[j]) * sg;
                lg[j] = __builtin_amdgcn_logf(fmaxf(f, 1e-20f)) * 0.6931471805599453f;
                kv[j] = (1.0f - lbv[j]) * (1.0f - sg);
            } else {
                qv[j] = qr * 0.17677669529663687f; kv[j] = kr;
                const float z = bav[j] + z4[j & 3];
                lg[j] = (fminf(z, 0.f) - __builtin_amdgcn_logf(1.0f + __expf(-fabsf(z))) * 0.6931471805599453f) * (1.0f / 16.0f);
            }
        }
#pragma unroll
        for (int j = 0; j < VPT; j += 4) *(f32x4*)(Bf + stq * DK + d0 + j) = (f32x4){lg[j], lg[j + 1], lg[j + 2], lg[j + 3]};
        *(u32x4*)(Vs + st * 160 + sc * 16) = rv;
        if (ci + 1 < TT / 64) load_raw(ci + 1);
        __syncthreads();
        {
            const int sd = tid % DK, tg = tid / DK;
            float lv[TG];
#pragma unroll
            for (int i = 0; i < TG; ++i) lv[i] = Bf[(tg * TG + i) * DK + sd];
            if (dir) {
#pragma unroll
                for (int i = TG - 2; i >= 0; --i) lv[i] += lv[i + 1];
            } else {
#pragma unroll
                for (int i = 1; i < TG; ++i) lv[i] += lv[i - 1];
            }
            Gp[tg * DK + sd] = dir ? lv[0] : lv[TG - 1];
            __syncthreads();
            float gq[NTG];
#pragma unroll
            for (int g = 0; g < NTG; ++g) gq[g] = Gp[g * DK + sd];
            float off = 0.f;
#pragma unroll
            for (int g = 0; g < NTG; ++g) off += gmask[g] * gq[g];
#pragma unroll
            for (int i = 0; i < TG; ++i) Bf[(tg * TG + i) * DK + sd] = lv[i] + off;
            const float vsel = (dir ? lv[0] : lv[TG - 1]) + off;
            if (tg == (dir ? 32 / TG : 31 / TG)) Bref[sd] = vsel;
            if (tg == (dir ? 0 : NTG - 1)) Bend[sd] = vsel;
        }
        __syncthreads();
        {
            unsigned qp[VPT / 2], kp[VPT / 2];
            float bfv[VPT], brv[VPT];
#pragma unroll
            for (int j = 0; j < VPT; j += 4) { const f32x4 t0 = *(const f32x4*)(Bf + stq * DK + d0 + j), t1 = *(const f32x4*)(Bref + d0 + j);
                bfv[j] = t0[0]; bfv[j + 1] = t0[1]; bfv[j + 2] = t0[2]; bfv[j + 3] = t0[3]; brv[j] = t1[0]; brv[j + 1] = t1[1]; brv[j + 2] = t1[2]; brv[j + 3] = t1[3]; }
#pragma unroll
            for (int j = 0; j < VPT; j += 2) {
                const float b0 = bfv[j], b1 = bfv[j + 1], r0 = brv[j], r1 = brv[j + 1];
                const float e0 = __expf(b0 - r0), e1 = __expf(b1 - r1);
                const float q0 = qv[j] * e0, q1 = qv[j + 1] * e1, k0 = kv[j] * __builtin_amdgcn_rcpf(e0), k1 = kv[j + 1] * __builtin_amdgcn_rcpf(e1);
                qp[j >> 1] = pack2(q0, q1); kp[j >> 1] = pack2(k0, k1);
            }
            if (VPT == 8) { *(u32x4*)(Qs + stq * RS + d0 * 2) = (u32x4){qp[0], qp[1], qp[2 % (VPT / 2)], qp[3 % (VPT / 2)]}; *(u32x4*)(Ks + stq * RS + d0 * 2) = (u32x4){kp[0], kp[1], kp[2 % (VPT / 2)], kp[3 % (VPT / 2)]}; }
            else { *(u32x2*)(Qs + stq * RS + d0 * 2) = (u32x2){qp[0], qp[1]}; *(u32x2*)(Ks + stq * RS + d0 * 2) = (u32x2){kp[0], kp[1]}; }
#pragma unroll
            for (int i = 0; i < NST; ++i) {
                const int id = wid * NST + i, et = id / NDT, dt = id % NDT, d = dt * 16 + fr;
                const float er = __expf(Bref[d]);
                const unsigned s01 = pack2(S[i][0] * er, S[i][1] * er), s23 = pack2(S[i][2] * er, S[i][3] * er);
                *(bf16_t*)(STs + (et * 16 + fq * 4 + 0) * RS + d * 2) = (bf16_t)(s01 & 0xffffu); *(bf16_t*)(STs + (et * 16 + fq * 4 + 1) * RS + d * 2) = (bf16_t)(s01 >> 16);
                *(bf16_t*)(STs + (et * 16 + fq * 4 + 2) * RS + d * 2) = (bf16_t)(s23 & 0xffffu); *(bf16_t*)(STs + (et * 16 + fq * 4 + 3) * RS + d * 2) = (bf16_t)(s23 >> 16);
            }
        }
        __syncthreads();
        if (ci == TT / 64 - 1 && threadIdx.x == 0) nextu = __hip_atomic_fetch_add(qctr, 1u, __ATOMIC_RELAXED, __HIP_MEMORY_SCOPE_AGENT);
        {
            bf16x8 qf[NKC];
#pragma unroll
            for (int kc = 0; kc < NKC; ++kc) qf[kc] = *(const bf16x8*)(Qs + (tt * 16 + fr) * RS + kc * 64 + fq * 16);
            u32x4 pk[2];
#pragma unroll
            for (int pr = 0; pr < 2; ++pr) {
                float sv[2][4];
#pragma unroll
                for (int half = 0; half < 2; ++half) {
                    const int stl = pr * 2 + half;
                    const bool allowed = dir ? (stl >= tt) : (stl <= tt);
                    f32x4 c = {0.f, 0.f, 0.f, 0.f};
#pragma unroll
                    for (int kc = 0; kc < NKC; ++kc) {
                        const bf16x8 kf = *(const bf16x8*)(Ks + (stl * 16 + fr) * RS + kc * 64 + fq * 16);
                        c = __builtin_amdgcn_mfma_f32_16x16x32_bf16(kf, qf[kc], c, 0, 0, 0);
                    }
#pragma unroll
                    for (int rg = 0; rg < 4; ++rg) {
                        const int s = fq * 4 + rg;
                        const bool keep = allowed && ((stl != tt) || (dir ? (s >= fr) : (s <= fr)));
                        sv[half][rg] = keep ? c[rg] : 0.f;
                    }
                }
                pk[pr][0] = pack2(sv[0][0], sv[0][1]); pk[pr][1] = pack2(sv[0][2], sv[0][3]); pk[pr][2] = pack2(sv[1][0], sv[1][1]); pk[pr][3] = pack2(sv[1][2], sv[1][3]);
            }
#pragma unroll
            for (int ei = 0; ei < 2; ++ei) {
                const int et = eh * 2 + ei;
                f32x4 O = {0.f, 0.f, 0.f, 0.f};
#pragma unroll
                for (int pr = 0; pr < 2; ++pr) {
                    const bf16x8 cv = cat_tr(lds_tr16(Vs + ((pr * 2) * 16 + fq * 4 + trq) * 160 + (et * 16 + trp * 4) * 2), lds_tr16(Vs + ((pr * 2 + 1) * 16 + fq * 4 + trq) * 160 + (et * 16 + trp * 4) * 2));
                    O = __builtin_amdgcn_mfma_f32_16x16x32_bf16(cv, __builtin_bit_cast(bf16x8, pk[pr]), O, 0, 0, 0);
                }
#pragma unroll
                for (int kc = 0; kc < NKC; ++kc) {
                    const bf16x8 sf = *(const bf16x8*)(STs + (et * 16 + fr) * RS + kc * 64 + fq * 16);
                    O = __builtin_amdgcn_mfma_f32_16x16x32_bf16(sf, qf[kc], O, 0, 0, 0);
                }
                { u32x2 ow; ow[0] = pack2(O[0], O[1]); ow[1] = pack2(O[2], O[3]); *(u32x2*)(obuf + (size_t)(bl * TT + cp * 64 + tt * 16 + fr) * 256 + h * 64 + et * 16 + fq * 4) = ow; }
            }
#pragma unroll
            for (int i = 0; i < NST; ++i) {
                const int id = wid * NST + i, et = id / NDT, dt = id % NDT, d = dt * 16 + fr;
                f32x4 A = {0.f, 0.f, 0.f, 0.f};
#pragma unroll
                for (int k2 = 0; k2 < 2; ++k2) {
                    const bf16x8 vf = cat_tr(lds_tr16(Vs + (k2 * 32 + fq * 8 + trq) * 160 + (et * 16 + trp * 4) * 2), lds_tr16(Vs + (k2 * 32 + fq * 8 + 4 + trq) * 160 + (et * 16 + trp * 4) * 2));
                    const bf16x8 kt = cat_tr(lds_tr16(Ks + (k2 * 32 + fq * 8 + trq) * RS + (dt * 16 + trp * 4) * 2), lds_tr16(Ks + (k2 * 32 + fq * 8 + 4 + trq) * RS + (dt * 16 + trp * 4) * 2));
                    A = __builtin_amdgcn_mfma_f32_16x16x32_bf16(vf, kt, A, 0, 0, 0);
                }
                const float be = Bend[d], e1 = __expf(be), e2 = __expf(be - Bref[d]);
#pragma unroll
                for (int rg = 0; rg < 4; ++rg) S[i][rg] = e1 * S[i][rg] + e2 * A[rg];
            }
        }
        __syncthreads();
    }
}

__device__ __forceinline__ void ph_hcopies(const PV& p) {
    const int tid = TID();
    for (int u = BID(); u < NLAYER * 512; u += gridDim.x) {
        const int l = u / 512, n = u % 512;
        const float* hr = wsp<const float>(p, OFF_HRAW) + (size_t)l * HRAW_L + (size_t)n * LQ;
        const float* psum = wsp<const float>(p, OFF_PSUM) + (size_t)l * 68 * 512;
        float sc = 0.f;
        for (int q = 0; q < 64; ++q) sc += psum[q * 512 + n];
        const float inv = 1.0f / sc;
        char* dst = wsp<char>(p, OFF_HCOP) + (size_t)u * (8 * HY_HSTR);
        for (int i = tid; i < 8 * HY_NS; i += NTHR) {
            const int kap = i / HY_NS, s = i % HY_NS; const int y0 = 8 * s + kap - 16;
            float v[8];
#pragma unroll
            for (int e = 0; e < 8; ++e) { const int y = y0 + e; v[e] = (y >= 0 && y < LQ) ? hr[LQ - 1 - y] * inv : 0.f; }
            u32x4 w; w[0] = pack2(v[0], v[1]); w[1] = pack2(v[2], v[3]); w[2] = pack2(v[4], v[5]); w[3] = pack2(v[6], v[7]);
            *(u32x4*)(dst + kap * HY_HSTR + s * 16) = w;
        }
    }
}

__device__ __forceinline__ void hyena_mfma_unit(const PV& p, int l, int c, char* smem, unsigned* qctr, unsigned& nextu) {
    const int tid = TID(), lane = tid & 63, wid = tid >> 6, fr = lane & 15, fq = lane >> 4;
    const int sg = fr >> 3;
    char* Us = smem; char* Hs = smem + HY_U_BYTES; const char* zero16 = smem + HY_Z_OFF;
    const bf16_t* hyT = wsp<const bf16_t>(p, OFF_HYT);
    bf16_t* outs = wsp<bf16_t>(p, OFF_OUTS);
    __syncthreads();
    {
        u32x4 t[8];
#pragma unroll
        for (int k = 0; k < 8; ++k) t[k] = *(const u32x4*)(hyT + ((size_t)k * 768 + c) * LQ + tid * 8);
#pragma unroll
        for (int k = 0; k < 8; ++k) *(u32x4*)(Us + k * HY_UB + tid * 16) = t[k];
    }
    if (tid < 4) ((unsigned*)(smem + HY_Z_OFF))[tid] = 0u;
    const int tw = wid * 256;
    const int c0 = fq + (fr < 8 ? 1 : 0);
    const char* hl = Hs + ((7 - fr) & 7) * HY_HSTR;
#pragma unroll 1
    for (int o = 0; o < 2; ++o) {
        const char* hc = wsp<const char>(p, OFF_HCOP) + ((size_t)l * 512 + o * 256 + c) * (8 * HY_HSTR);
        {
            u32x4 t[8];
#pragma unroll
            for (int k = 0; k < 8; ++k) t[k] = *(const u32x4*)(hc + (k * NTHR + tid) * 16);
            u32x4 tl = {0u, 0u, 0u, 0u};
            if (tid < 8 * HY_HSTR / 16 - 8 * NTHR) tl = *(const u32x4*)(hc + (8 * NTHR + tid) * 16);
#pragma unroll
            for (int k = 0; k < 8; ++k) *(u32x4*)(Hs + (k * NTHR + tid) * 16) = t[k];
            if (tid < 8 * HY_HSTR / 16 - 8 * NTHR) *(u32x4*)(Hs + (8 * NTHR + tid) * 16) = tl;
        }
        __syncthreads();
        f32x4 acc[16];
#pragma unroll
        for (int m = 0; m < 16; ++m) acc[m] = (f32x4){0.f, 0.f, 0.f, 0.f};
        bf16x8 F[16];
#pragma unroll
        for (int q = 2; q < 16; ++q) { int s = -2 * q + c0; s = s < 0 ? 0 : s; F[q] = *(const bf16x8*)(hl + s * 16); }
        auto ldA = [&](int sraw) { const int s = sraw < 0 ? 0 : (sraw > HY_NS - 1 ? HY_NS - 1 : sraw); return *(const bf16x8*)(hl + s * 16); };
        auto ldB = [&](int j) { const int sidx = tw - 2048 + 32 * j + sg * 2048;
            const char* ba = ((unsigned)sidx < 4096u) ? (Us + (fr & 7) * HY_UB + (sidx + 8 * fq) * 2) : zero16; return *(const bf16x8*)ba; };
        bf16x8 N0 = ldA(c0), N1 = ldA(c0 - 2), Bn = ldB(0);
#pragma unroll 1
        for (int jo = 0; jo < 17; ++jo) {
#pragma unroll
            for (int ji = 0; ji < 8; ++ji) {
                const int j = jo * 8 + ji;
                F[(16 - 2 * ji) & 15] = N0; F[(17 - 2 * ji) & 15] = N1;
                const bf16x8 B = Bn;
                N0 = ldA(4 * (j + 1) + c0); N1 = ldA(4 * (j + 1) - 2 + c0); Bn = ldB(j + 1);
#pragma unroll
                for (int m = 0; m < 16; ++m) acc[m] = __builtin_amdgcn_mfma_f32_16x16x32_bf16(F[(m - 2 * ji) & 15], B, acc[m], 0, 0, 0);
            }
        }
        __syncthreads();
        if (o == 1 && threadIdx.x == 0) nextu = __hip_atomic_fetch_add(qctr, 1u, __ATOMIC_RELAXED, __HIP_MEMORY_SCOPE_AGENT);
        const float bias = p.in(20)[((size_t)l * 2 + o) * 256 + c];
        const int tid2 = TID(), fr2 = tid2 & 15, fq2 = (tid2 >> 4) & 3, b = fr2 & 7, sg2 = fr2 >> 3, tw2 = (tid2 >> 6) * 256;
        const bf16_t* gp = hyT + ((size_t)b * 768 + (o + 1) * 256 + c) * LQ;
        u32x2 grv[16];
#pragma unroll
        for (int m = 0; m < 16; ++m) grv[m] = *(const u32x2*)(gp + tw2 + 16 * m + sg2 * 2048 + 4 * fq2);
        bf16_t* dstp = o == 0 ? (bf16_t*)(Us + b * HY_UB) : wsp<bf16_t>(p, OFF_HYO) + ((size_t)b * 256 + c) * LQ;
        if (o == 0) {
#pragma unroll
            for (int m = 0; m < 16; ++m) {
                const int t = tw2 + 16 * m + sg2 * 2048 + 4 * fq2;
                const u32x2 gr = grv[m];
                const u32x2 zr = *(const u32x2*)(Us + b * HY_UB + t * 2);
                const float r0 = __uint_as_float(gr[0] << 16) * (acc[m][0] + bias * __uint_as_float(zr[0] << 16)), r1 = __uint_as_float(gr[0] & 0xffff0000u) * (acc[m][1] + bias * __uint_as_float(zr[0] & 0xffff0000u));
                const float r2 = __uint_as_float(gr[1] << 16) * (acc[m][2] + bias * __uint_as_float(zr[1] << 16)), r3 = __uint_as_float(gr[1] & 0xffff0000u) * (acc[m][3] + bias * __uint_as_float(zr[1] & 0xffff0000u));
                u32x2 w; w[0] = pack2(r0, r1); w[1] = pack2(r2, r3);
                *(u32x2*)(Us + b * HY_UB + t * 2) = w;
            }
        } else {
#pragma unroll
            for (int m = 0; m < 16; ++m) {
                const int t = tw2 + 16 * m + sg2 * 2048 + 4 * fq2;
                const u32x2 gr = grv[m];
                const u32x2 zr = *(const u32x2*)(Us + b * HY_UB + t * 2);
                const float r0 = __uint_as_float(gr[0] << 16) * (acc[m][0] + bias * __uint_as_float(zr[0] << 16)), r1 = __uint_as_float(gr[0] & 0xffff0000u) * (acc[m][1] + bias * __uint_as_float(zr[0] & 0xffff0000u));
                const float r2 = __uint_as_float(gr[1] << 16) * (acc[m][2] + bias * __uint_as_float(zr[1] << 16)), r3 = __uint_as_float(gr[1] & 0xffff0000u) * (acc[m][3] + bias * __uint_as_float(zr[1] & 0xffff0000u));
                u32x2 w; w[0] = pack2(r0, r1); w[1] = pack2(r2, r3);
                *(u32x2*)(dstp + t) = w;
            }
        }
        __syncthreads();
    }
}

__device__ __forceinline__ void hyena_ctx_unit(const PV& p, int l, int c, char* smem) {
    float* up = (float*)smem;
    float* hS = up + BG * 512;
    const int tid = TID(), b = tid >> 6, t0 = (tid & 63) * 4;
    const bf16_t* hyT = wsp<const bf16_t>(p, OFF_HYT) + (size_t)BG * 768 * LQ;
    const float* hraw = wsp<const float>(p, OFF_HRAW) + (size_t)l * HRAW_L + (size_t)512 * LQ;
    const float* psum = wsp<const float>(p, OFF_PSUM) + (size_t)l * 68 * 512 + 64 * 512;
    bf16_t* outs = wsp<bf16_t>(p, OFF_OUTS);
    __syncthreads();
    float z[4];
    {
        const u32x2 raw = *(const u32x2*)(hyT + ((size_t)b * 768 + c) * LC + t0);
        z[0] = __uint_as_float(raw[0] << 16); z[1] = __uint_as_float(raw[0] & 0xffff0000u); z[2] = __uint_as_float(raw[1] << 16); z[3] = __uint_as_float(raw[1] & 0xffff0000u);
        float* ub0 = up + b * 512; const int q2 = (tid & 63) * 2;
        ub0[128 + t0] = z[0]; ub0[128 + t0 + 1] = z[1]; ub0[128 + t0 + 2] = z[2]; ub0[128 + t0 + 3] = z[3];
        ub0[q2] = 0.f; ub0[q2 + 1] = 0.f; ub0[384 + q2] = 0.f; ub0[384 + q2 + 1] = 0.f;
    }
#pragma unroll 1
    for (int o = 0; o < 2; ++o) {
        const int n = o * 256 + c;
        const float inv = 1.0f / (psum[n] + psum[512 + n] + psum[1024 + n] + psum[1536 + n]);
        if (tid < LC) hS[tid] = hraw[(size_t)n * LC + tid];
        __syncthreads();
        float acc[4] = {0.f, 0.f, 0.f, 0.f}, w[4];
        const float* ub = up + b * 512 + t0 + 256;
#pragma unroll
        for (int i = 0; i < 4; ++i) w[i] = ub[i];
#pragma unroll 4
        for (int j = 0; j < LC; ++j) {
            const float hj = hS[j];
#pragma unroll
            for (int i = 0; i < 4; ++i) acc[i] += hj * w[i];
            w[3] = w[2]; w[2] = w[1]; w[1] = w[0]; w[0] = ub[-(j + 1)];
        }
        const float bias = p.in(20)[((size_t)l * 2 + o) * 256 + c];
        {
            const u32x2 gr = *(const u32x2*)(hyT + ((size_t)b * 768 + (o + 1) * 256 + c) * LC + t0);
            const float gt[4] = {__uint_as_float(gr[0] << 16), __uint_as_float(gr[0] & 0xffff0000u), __uint_as_float(gr[1] << 16), __uint_as_float(gr[1] & 0xffff0000u)};
#pragma unroll
            for (int i = 0; i < 4; ++i) z[i] = gt[i] * (acc[i] * inv + bias * z[i]);
        }
        __syncthreads();
        if (o == 0) {
#pragma unroll
            for (int i = 0; i < 4; ++i) up[b * 512 + 128 + t0 + i] = z[i];
        } else {
#pragma unroll
            for (int i = 0; i < 4; ++i) outs[(size_t)(b * TT + t0 + i) * D + 256 + c] = f2bf(z[i]);
        }
        __syncthreads();
    }
}

__device__ __forceinline__ void attn_unit(const PV& p, int l, int bl, int h, int q0, int nkeys, char* smem, unsigned* qctr, unsigned& nextu) {
    constexpr int KROW = 160, VROW = 160, KT_BYTES = 64 * KROW, STG = KT_BYTES + 64 * VROW;
    const int tid = TID(), lane = tid & 63, wid = tid >> 6, fr = lane & 15, fq = lane >> 4;
    const bf16_t* Qa = wsp<const bf16_t>(p, OFF_QA) + ((size_t)bl * 4 + h) * TT * 64;
    const bf16_t* Ka = wsp<const bf16_t>(p, OFF_KA) + ((size_t)bl * 4 + h) * TT * 64;
    const bf16_t* Vp = wsp<const bf16_t>(p, OFF_BIG) + (size_t)bl * TT * NP1 + C_DV + h * 64;
    const int trq = fr >> 2, trp = fr & 3;
    const int ln32 = tid & 31;
    float gqm = fabsf(p.in(23)[l * 32 + ln32]), gkm = fabsf(p.in(24)[l * 32 + ln32]);
#pragma unroll
    for (int o = 16; o > 0; o >>= 1) { gqm = fmaxf(gqm, __shfl_xor(gqm, o)); gkm = fmaxf(gkm, __shfl_xor(gkm, o)); }
    const float Mx2 = 32.0f * 0.17677669529663687f * 1.4426950408889634f * gqm * gkm;
    const float* lp = p.in(25) + (size_t)l * 128;
    float s01 = lp[ln32] * lp[32 + ln32], s23 = lp[64 + ln32] * lp[96 + ln32];
#pragma unroll
    for (int o = 16; o > 0; o >>= 1) { s01 += __shfl_xor(s01, o); s23 += __shfl_xor(s23, o); }
    const float lam_init = 0.8f - 0.6f * expf(-0.3f * (float)l);
    const float lam = expf(s01) - expf(s23) + lam_init;
    const f32x4 cinit = {-Mx2, -Mx2, -Mx2, -Mx2};
    const int qw = q0 + wid * 32;
    bf16x8 qf[2][2];
#pragma unroll
    for (int br = 0; br < 2; ++br)
#pragma unroll
        for (int qt = 0; qt < 2; ++qt) qf[br][qt] = *(const bf16x8*)(Qa + (size_t)(qw + qt * 16 + fr) * 64 + br * 32 + fq * 8);
    f32x4 O[2][2][4], Ls[2][2];
#pragma unroll
    for (int br = 0; br < 2; ++br)
#pragma unroll
        for (int qt = 0; qt < 2; ++qt) { Ls[br][qt] = (f32x4){0.f, 0.f, 0.f, 0.f};
#pragma unroll
            for (int dt = 0; dt < 4; ++dt) O[br][qt][dt] = (f32x4){0.f, 0.f, 0.f, 0.f}; }
    bf16x8 ones;
#pragma unroll
    for (int j = 0; j < 8; ++j) ones[j] = (short)0x3F80;
    const int srow = tid >> 3, sc = tid & 7;
    const bf16_t* kg = Ka + (size_t)srow * 64 + sc * 8;
    const bf16_t* vg = Vp + (size_t)srow * NP1 + sc * 8;
    const int kso = srow * KROW + sc * 16, vso = KT_BYTES + srow * VROW + sc * 16;
    u32x4 rk = *(const u32x4*)kg, rv = *(const u32x4*)vg;
    const int nt = nkeys / 64;
    u32x4 rk2 = rk, rv2 = rv;
    if (nt > 1) { rk2 = *(const u32x4*)(kg + (size_t)64 * 64); rv2 = *(const u32x4*)(vg + (size_t)64 * NP1); }
    __syncthreads();
    *(u32x4*)(smem + kso) = rk; *(u32x4*)(smem + vso) = rv;
    __syncthreads();
    for (int kt = 0; kt < nt; ++kt) {
        const char* cur = smem + (kt & 1) * STG; char* nxt = smem + ((kt + 1) & 1) * STG;
        rk = rk2; rv = rv2;
        if (kt + 2 < nt) { rk2 = *(const u32x4*)(kg + (size_t)(kt + 2) * 64 * 64); rv2 = *(const u32x4*)(vg + (size_t)(kt + 2) * 64 * NP1); }
#define AT_LDK(kp_, kf_) do { _Pragma("unroll") for (int br = 0; br < 2; ++br) _Pragma("unroll") for (int t = 0; t < 2; ++t) \
            kf_[br][t] = *(const bf16x8*)(cur + ((kp_) * 32 + t * 16 + fr) * KROW + br * 64 + fq * 16); } while (0)
#define AT_LDV(kp_, vf_) do { _Pragma("unroll") for (int dt = 0; dt < 4; ++dt) {   \
            vf_[dt] = cat_tr(lds_tr16(cur + KT_BYTES + ((kp_) * 32 + fq * 4 + trq) * VROW + (dt * 16 + trp * 4) * 2), \
                             lds_tr16(cur + KT_BYTES + ((kp_) * 32 + 16 + fq * 4 + trq) * VROW + (dt * 16 + trp * 4) * 2)); } } while (0)
#define AT_S(kf_, qt_, s_) do { _Pragma("unroll") for (int br = 0; br < 2; ++br) _Pragma("unroll") for (int t = 0; t < 2; ++t) \
            s_[br][t] = __builtin_amdgcn_mfma_f32_16x16x32_bf16(kf_[br][t], qf[br][qt_], cinit, 0, 0, 0); } while (0)
#define AT_P(s_, pk_) do { _Pragma("unroll") for (int br = 0; br < 2; ++br) { \
            pk_[br][0] = cvt_pk_bf16(__builtin_amdgcn_exp2f(s_[br][0][0]), __builtin_amdgcn_exp2f(s_[br][0][1])); \
            pk_[br][1] = cvt_pk_bf16(__builtin_amdgcn_exp2f(s_[br][0][2]), __builtin_amdgcn_exp2f(s_[br][0][3])); \
            pk_[br][2] = cvt_pk_bf16(__builtin_amdgcn_exp2f(s_[br][1][0]), __builtin_amdgcn_exp2f(s_[br][1][1])); \
            pk_[br][3] = cvt_pk_bf16(__builtin_amdgcn_exp2f(s_[br][1][2]), __builtin_amdgcn_exp2f(s_[br][1][3])); } } while (0)
#define AT_PV(vf_, qt_, pk_) do { _Pragma("unroll") for (int br = 0; br < 2; ++br) { const bf16x8 pb_ = __builtin_bit_cast(bf16x8, pk_[br]); \
            _Pragma("unroll") for (int dt = 0; dt < 4; ++dt) O[br][qt_][dt] = __builtin_amdgcn_mfma_f32_16x16x32_bf16(vf_[dt], pb_, O[br][qt_][dt], 0, 0, 0); \
            Ls[br][qt_] = __builtin_amdgcn_mfma_f32_16x16x32_bf16(ones, pb_, Ls[br][qt_], 0, 0, 0); } } while (0)
        {
            bf16x8 kf0[2][2], kf1[2][2], vf0[4], vf1[4];
            f32x4 sA[2][2], sB[2][2];
            u32x4 pA[2], pB[2];
            AT_LDK(0, kf0); AT_LDV(0, vf0);
            AT_S(kf0, 0, sA);
            AT_LDK(1, kf1);
            AT_S(kf0, 1, sB);
            AT_P(sA, pA);
            AT_LDV(1, vf1);
            AT_S(kf1, 0, sA);
            AT_P(sB, pB);
            AT_PV(vf0, 0, pA);
            AT_S(kf1, 1, sB);
            AT_P(sA, pA);
            AT_PV(vf0, 1, pB);
            AT_P(sB, pB);
            AT_PV(vf1, 0, pA);
            AT_PV(vf1, 1, pB);
        }
#undef AT_LDK
#undef AT_LDV
#undef AT_S
#undef AT_P
#undef AT_PV
        if (kt + 1 < nt) { *(u32x4*)(nxt + kso) = rk; *(u32x4*)(nxt + vso) = rv; }
        __syncthreads();
    }
    asm volatile("" ::: "memory");
    if (threadIdx.x == 0) nextu = __hip_atomic_fetch_add(qctr, 1u, __ATOMIC_RELAXED, __HIP_MEMORY_SCOPE_AGENT);
    const float* gn = p.in(26) + l * 64;
#pragma unroll
    for (int qt = 0; qt < 2; ++qt) {
        const float i1 = 1.0f / Ls[0][qt][0], i2 = lam / Ls[1][qt][0];
        float o[4][4], ss = 0.f;
#pragma unroll
        for (int dt = 0; dt < 4; ++dt)
#pragma unroll
            for (int j = 0; j < 4; ++j) { o[dt][j] = O[0][qt][dt][j] * i1 - O[1][qt][dt][j] * i2; ss += o[dt][j] * o[dt][j]; }
        ss += __shfl_xor(ss, 16); ss += __shfl_xor(ss, 32);
        const float rs = rsqrtf(ss * (1.0f / 64.0f) + 1e-6f) * (1.0f - lam_init);
        bf16_t* dst = wsp<bf16_t>(p, OFF_OUTS) + (size_t)(bl * TT + qw + qt * 16 + fr) * D + 768 + h * 64;
#pragma unroll
        for (int dt = 0; dt < 4; ++dt) {
            const f32x4 g = *(const f32x4*)(gn + dt * 16 + fq * 4);
            u32x2 w; w[0] = pack2(o[dt][0] * rs * g[0], o[dt][1] * rs * g[1]); w[1] = pack2(o[dt][2] * rs * g[2], o[dt][3] * rs * g[3]);
            *(u32x2*)(dst + dt * 16 + fq * 4) = w;
        }
    }
}

constexpr int QCTR_WORD0 = 3584;
__device__ __forceinline__ void ph_branches(const PV& p, int l, int it, char* smem) {
    const bool last = l == NLAYER - 1;
    const int NR = BG * 4 * 2 * 2, NH = 256, NA = BG * 4 * 16, NAC = last ? 0 : BG * 4, NHC = last ? 0 : 256;
    const int total = NR + NH + NA + NAC + NHC;
    unsigned* ctr = wsp<unsigned>(p, OFF_BAR) + QCTR_WORD0 + 64 * it;
    volatile __attribute__((address_space(3))) unsigned* qw = (volatile __attribute__((address_space(3))) unsigned*)(smem + SMEM_BYTES + 16 + 280);
    unsigned nextu = 0xffffffffu;
    for (;;) {
        __syncthreads();
        if (threadIdx.x == 0) *qw = nextu != 0xffffffffu ? nextu : __hip_atomic_fetch_add(ctr, 1u, __ATOMIC_RELAXED, __HIP_MEMORY_SCOPE_AGENT);
        __syncthreads();
        int u = (int)__builtin_amdgcn_readfirstlane(*qw);
        nextu = 0xffffffffu;
        if (u >= total) break;
        if (u < NR) {
            const int dir = u & 1, br = (u >> 1) & 1, h = (u >> 2) & 3, bl = u >> 4;
            if (br == 0) recur_chunk_unit<32, 0>(p, l, bl, h, dir, smem, ctr, nextu); else recur_chunk_unit<64, 1>(p, l, bl, h, dir, smem, ctr, nextu);
            continue;
        }
        u -= NR;
        if (u < NA) { const int qb = u & 15, h = (u >> 4) & 3, bl = u >> 6; attn_unit(p, l, bl, h, LC + qb * 256, TT, smem, ctr, nextu); continue; }
        u -= NA;
        if (u < NH) { hyena_mfma_unit(p, l, u, smem, ctr, nextu); continue; }
        u -= NH;
        if (u < NAC) { attn_unit(p, l, u >> 2, u & 3, 0, LC, smem, ctr, nextu); continue; }
        u -= NAC;
        hyena_ctx_unit(p, l, u, smem);
    }
}

__device__ __forceinline__ void ph_hy_unprep(const PV& p, char* smem) {
    bf16_t* tile = (bf16_t*)smem;
    const int tid = TID();
    const bf16_t* hyO = wsp<const bf16_t>(p, OFF_HYO);
    bf16_t* outs = wsp<bf16_t>(p, OFF_OUTS);
    const int total = BG * 4 * (LQ / 64), G = gridDim.x;
    const int ch = tid >> 3, t8 = (tid & 7) * 8;
    u32x4 cur = {0u, 0u, 0u, 0u}, nxt = {0u, 0u, 0u, 0u};
    int u = BID();
    if (u < total) { const int ct = u & 3, tt = (u >> 2) % (LQ / 64), bl = u / (4 * (LQ / 64)); cur = *(const u32x4*)(hyO + ((size_t)bl * 256 + ct * 64 + ch) * LQ + tt * 64 + t8); }
    for (; u < total; u += G) {
        const int ct = u & 3, tt = (u >> 2) % (LQ / 64), bl = u / (4 * (LQ / 64));
        if (u + G < total) { const int u2 = u + G, ct2 = u2 & 3, tt2 = (u2 >> 2) % (LQ / 64), bl2 = u2 / (4 * (LQ / 64)); nxt = *(const u32x4*)(hyO + ((size_t)bl2 * 256 + ct2 * 64 + ch) * LQ + tt2 * 64 + t8); }
        __syncthreads();
        *(u32x4*)(tile + ch * 72 + t8) = cur;
        __syncthreads();
        const int tok = tid >> 3, c8 = (tid & 7) * 8;
        u32x4 w;
#pragma unroll
        for (int j = 0; j < 4; ++j) w[j] = (unsigned)tile[(c8 + 2 * j) * 72 + tok] | ((unsigned)tile[(c8 + 2 * j + 1) * 72 + tok] << 16);
        *(u32x4*)(outs + (size_t)(bl * TT + LC + tt * 64 + tok) * D + 256 + ct * 64 + c8) = w;
        cur = nxt;
    }
}

__device__ __forceinline__ void ph_gated(const PV& p, int l) {
    const int tid = TID(), lane = tid & 63, wid = tid >> 6;
    const bf16_t* proj = wsp<const bf16_t>(p, OFF_BIG);
    const bf16_t* obuf = wsp<const bf16_t>(p, OFF_OBUF);
    bf16_t* outs = wsp<bf16_t>(p, OFF_OUTS);
    u32x2 pa0, pa1, pb0, pb1, pg0, pg1;
#define GATED_LOAD(rr) do { pa0 = *(const u32x2*)(obuf + ((size_t)0 * R + (rr)) * 256 + lane * 4); pa1 = *(const u32x2*)(obuf + ((size_t)1 * R + (rr)) * 256 + lane * 4); \
        pb0 = *(const u32x2*)(obuf + ((size_t)2 * R + (rr)) * 256 + lane * 4); pb1 = *(const u32x2*)(obuf + ((size_t)3 * R + (rr)) * 256 + lane * 4); \
        pg0 = *(const u32x2*)(proj + (size_t)(rr) * NP1 + C_GG + lane * 4); pg1 = *(const u32x2*)(proj + (size_t)(rr) * NP1 + C_HGG + lane * 4); } while (0)
    if (BID() * 8 + wid < R) GATED_LOAD(BID() * 8 + wid);
    const f32x4 gnv[2] = {*(const f32x4*)(p.in(11) + l * 64 + (lane & 15) * 4), *(const f32x4*)(p.in(22) + l * 64 + (lane & 15) * 4)};
    for (int r = BID() * 8 + wid; r < R; r += gridDim.x * 8) {
        const u32x2 ca[2] = {pa0, pa1}, cb[2] = {pb0, pb1}, cg[2] = {pg0, pg1};
        if (r + (int)gridDim.x * 8 < R) GATED_LOAD(r + gridDim.x * 8);
#pragma unroll
        for (int br = 0; br < 2; ++br) {
            const u32x2 a = ca[br];
            const u32x2 b = cb[br];
            float o[4] = {__uint_as_float(a[0] << 16) + __uint_as_float(b[0] << 16), __uint_as_float(a[0] & 0xffff0000u) + __uint_as_float(b[0] & 0xffff0000u),
                          __uint_as_float(a[1] << 16) + __uint_as_float(b[1] << 16), __uint_as_float(a[1] & 0xffff0000u) + __uint_as_float(b[1] & 0xffff0000u)};
            float ss = o[0] * o[0] + o[1] * o[1] + o[2] * o[2] + o[3] * o[3];
            ss += __shfl_xor(ss, 1); ss += __shfl_xor(ss, 2); ss += __shfl_xor(ss, 4); ss += __shfl_xor(ss, 8);
            const float rs = rsqrtf(ss * (1.0f / 64.0f) + 1e-6f);
            const u32x2 graw = cg[br];
            const float gt[4] = {bf2f((bf16_t)(graw[0] & 0xffff)), bf2f((bf16_t)(graw[0] >> 16)), bf2f((bf16_t)(graw[1] & 0xffff)), bf2f((bf16_t)(graw[1] >> 16))};
#pragma unroll
            for (int c = 0; c < 4; ++c) o[c] = o[c] * rs * gnv[br][c] * siluf_(gt[c]);
            u32x2 w; w[0] = pack2(o[0], o[1]); w[1] = pack2(o[2], o[3]);
            *(u32x2*)(outs + (size_t)r * D + (br ? 512 : 0) + lane * 4) = w;
        }
    }
}

__device__ __forceinline__ void ph_branchmm(const PV& p, int l, char* smem) {
    const bool last = l == NLAYER - 1;
    pg8::Gemm g; g.A = wsp<const bf16_t>(p, OFF_OUTS); g.Bt = wsp<const bf16_t>(p, OFF_BTBR) + (size_t)l * 4 * 1024 * 256; g.lda = D; g.ldb = 256; g.K = 256; g.bstride = 0; g.gidx = nullptr;
    SOrder S; S.init(last ? BG * 16 : R / 256, 16, last ? 5 : 4);
    EpiStoreBf16 E; E.O = wsp<bf16_t>(p, OFF_BIG); E.ldc = 4096; E.rowscale = nullptr;
    __syncthreads();
    pg8::gemm_phase((PG8_LAS unsigned char*)smem, g, S, E);
    __syncthreads();
}
struct EpiMerge {
    static constexpr bool PERM = false, AFTER_DRAIN = false;
    const bf16_t* Bm; bf16_t* M;
    __device__ __forceinline__ void operator()(const f32x4 (&acc)[2][2][4][2], const pg8::Unit& u, int wr, int wc, int fr, int fq) const {
        const int row0 = u.pm * 256 + wr * 64 + fr, mc0 = u.pn * 64 + wc * 16 + fq * 4;
        u32x2 bn[4];
        { const bf16_t* b0 = Bm + (size_t)row0 * 4096 + mc0;
#pragma unroll
          for (int i = 0; i < 4; ++i) bn[i] = *(const u32x2*)(b0 + i * 1024); }
#pragma unroll
        for (int ai = 0; ai < 2; ++ai)
#pragma unroll
            for (int m = 0; m < 4; ++m) {
                const int row = row0 + ai * 128 + m * 16;
                u32x2 br[4];
#pragma unroll
                for (int i = 0; i < 4; ++i) br[i] = bn[i];
                if (ai * 4 + m + 1 < 8) { const int g1 = ai * 4 + m + 1; const bf16_t* b1 = Bm + (size_t)(row0 + (g1 >> 2) * 128 + (g1 & 3) * 16) * 4096 + mc0;
#pragma unroll
                    for (int i = 0; i < 4; ++i) bn[i] = *(const u32x2*)(b1 + i * 1024); }
                asm volatile("" ::: "memory");
                float s[4] = {0.f, 0.f, 0.f, 0.f};
#pragma unroll
                for (int i = 0; i < 4; ++i) {
                    const f32x4 gv = acc[ai][i >> 1][m][i & 1];
                    const float b0 = __uint_as_float(br[i][0] << 16), b1 = __uint_as_float(br[i][0] & 0xffff0000u), b2 = __uint_as_float(br[i][1] << 16), b3 = __uint_as_float(br[i][1] & 0xffff0000u);
                    { constexpr float kc = -0.03125f * 1.4426950408889634f;
                      s[0] += __builtin_amdgcn_rcpf(1.0f + __builtin_amdgcn_exp2f(gv[0] * kc)) * b0; s[1] += __builtin_amdgcn_rcpf(1.0f + __builtin_amdgcn_exp2f(gv[1] * kc)) * b1;
                      s[2] += __builtin_amdgcn_rcpf(1.0f + __builtin_amdgcn_exp2f(gv[2] * kc)) * b2; s[3] += __builtin_amdgcn_rcpf(1.0f + __builtin_amdgcn_exp2f(gv[3] * kc)) * b3; }
                }
                u32x2 w; w[0] = pack2(s[0], s[1]); w[1] = pack2(s[2], s[3]);
                *(u32x2*)(M + (size_t)row * D + mc0) = w;
            }
    }
};
__device__ __forceinline__ void ph_merge(const PV& p, int l, char* smem) {
    const bool last = l == NLAYER - 1;
    pg8::Gemm g; g.A = wsp<const bf16_t>(p, OFF_HX8); g.Bt = wsp<const bf16_t>(p, OFF_BTGATE) + (size_t)l * 4096 * D / 2; g.lda = D / 2; g.ldb = D / 2; g.K = D / 2; g.bstride = 0; g.gidx = nullptr;
    SOrder S; S.init(last ? BG * 16 : R / 256, 16, (last ? 1 : 0) | 8);
    EpiMerge E; E.Bm = wsp<const bf16_t>(p, OFF_BIG); E.M = wsp<bf16_t>(p, OFF_OUTS);
    __syncthreads();
    pg8::gemm_phase<EpiMerge, SOrder, false, true>((PG8_LAS unsigned char*)smem, g, S, E);
    __syncthreads();
}

__device__ __forceinline__ void ph_wout(const PV& p, int l, int grp, char* smem) {
    const bool last = l == NLAYER - 1;
    pg8::Gemm g; g.A = wsp<const bf16_t>(p, OFF_OUTS); g.Bt = wsp<const bf16_t>(p, OFF_BTOUT) + (size_t)l * D * D; g.lda = D; g.ldb = D; g.K = D; g.bstride = 0; g.gidx = nullptr;
    SOrder S; S.init(last ? BG * 16 : R / 256, D / 256, last ? 1 : 0);
    EpiResid E; E.pp = &p; E.l = l; E.grp = grp;
    __syncthreads();
    pg8::gemm_phase((PG8_LAS unsigned char*)smem, g, S, E);
    __syncthreads();
}

__device__ __forceinline__ void ph_topk(const PV& p, int l, char* smem) {
    unsigned* keys = (unsigned*)smem;
    unsigned* red = keys + 4096;
    const int tid = TID(), lane = tid & 63, wid = tid >> 6;
    const bool last = l == NLAYER - 1;
    const int NU = BG * NEXP * (last ? 1 : 2);
    for (int u = BID(); u < NU; u += gridDim.x) {
        const int isctx = u >= BG * NEXP, v = isctx ? u - BG * NEXP : u, bl = v / NEXP, e = v % NEXP;
        const int L = isctx ? LC : LQ, cap = isctx ? CAPC : CAPL;
        const float* aff = wsp<const float>(p, OFF_AFF) + (isctx ? (size_t)BG * NEXP * LQ + (size_t)v * LC : (size_t)v * LQ);
        __syncthreads();
        {
            unsigned t[8];
#pragma unroll
            for (int k = 0; k < 8; ++k) { const int i = k * NTHR + tid; t[k] = i < L ? __float_as_uint(aff[i]) : 0u; }
#pragma unroll
            for (int k = 0; k < 8; ++k) keys[k * NTHR + tid] = t[k];
        }
        __syncthreads();
        unsigned my[8];
#pragma unroll
        for (int i = 0; i < 8; ++i) my[i] = keys[tid * 8 + i];
        unsigned T = 0u;
        {
            const unsigned cand = 1u << 30; int c = 0;
#pragma unroll
            for (int i = 0; i < 8; ++i) c += __popcll(__ballot(my[i] >= cand));
            if (lane == 0) red[wid] = (unsigned)c;
            __syncthreads();
            int tot = 0;
#pragma unroll
            for (int w = 0; w < 8; ++w) tot += (int)red[w];
            __syncthreads();
            if (tot >= cap) T = cand;
        }
        for (int bit = 28; bit >= 0; bit -= 2) {
            const unsigned c1 = T | (1u << bit), c2 = T | (2u << bit), c3 = T | (3u << bit);
            int n1 = 0, n2 = 0, n3 = 0;
#pragma unroll
            for (int i = 0; i < 8; ++i) { n1 += __popcll(__ballot(my[i] >= c1)); n2 += __popcll(__ballot(my[i] >= c2)); n3 += __popcll(__ballot(my[i] >= c3)); }
            if (lane == 0) { red[wid] = (unsigned)n1; red[16 + wid] = (unsigned)n2; red[24 + wid] = (unsigned)n3; }
            __syncthreads();
            int t1 = 0, t2 = 0, t3 = 0;
#pragma unroll
            for (int w = 0; w < 8; ++w) { t1 += (int)red[w]; t2 += (int)red[16 + w]; t3 += (int)red[24 + w]; }
            __syncthreads();
            T = t3 >= cap ? c3 : (t2 >= cap ? c2 : (t1 >= cap ? c1 : T));
        }
        int cg = 0, ce = 0;
#pragma unroll
        for (int i = 0; i < 8; ++i) { cg += (my[i] > T) ? 1 : 0; ce += (my[i] == T) ? 1 : 0; }
        unsigned pk = (unsigned)cg | ((unsigned)ce << 16), inc = pk;
#pragma unroll
        for (int o = 1; o < 64; o <<= 1) { const unsigned t = __shfl_up(inc, o); if (lane >= o) inc += t; }
        if (lane == 63) red[8 + wid] = inc;
        __syncthreads();
        unsigned base = 0u, totpk = 0u;
#pragma unroll
        for (int w = 0; w < 8; ++w) { const unsigned t = red[8 + w]; if (w < wid) base += t; totpk += t; }
        const unsigned ex = base + inc - pk;
        int rg = (int)(ex & 0xffffu), re = (int)(ex >> 16); const int G = (int)(totpk & 0xffffu);
        const int sbase = isctx ? LATS + (e * BG + bl) * CAPC : (e * BG + bl) * CAPL;
        int* sidx = wsp<int>(p, OFF_SIDX); float* sgv = wsp<float>(p, OFF_SGV); int* inv = wsp<int>(p, OFF_INV);
#pragma unroll
        for (int i = 0; i < 8; ++i) {
            const int tok = tid * 8 + i; int slot = -1;
            if (my[i] > T) slot = rg++;
            else if (my[i] == T) { if (G + re < cap) slot = G + re; re++; }
            if (slot >= 0 && tok < L) {
                const int r = bl * TT + (isctx ? tok : LC + tok);
                sidx[sbase + slot] = r; sgv[sbase + slot] = __uint_as_float(my[i]); inv[(size_t)r * NEXP + e] = sbase + slot;
            }
        }
    }
}

__device__ __forceinline__ void ph_moe1(const PV& p, int l, char* smem) {
    const bool last = l == NLAYER - 1;
    pg8::Gemm g; g.A = wsp<const bf16_t>(p, OFF_HX); g.Bt = wsp<const bf16_t>(p, OFF_BTW13) + (size_t)l * NEXP * 2048 * D; g.lda = D; g.ldb = D; g.K = D; g.bstride = (size_t)2048 * D; g.gidx = wsp<const int>(p, OFF_SIDX);
    SOrder S; S.init(last ? LATS / 256 : NSLOT / 256, 2048 / 256, 2);
    EpiSwiglu E; E.H = wsp<bf16_t>(p, OFF_BIG) + (size_t)NSLOT * D;
    __syncthreads();
    pg8::gemm_phase<EpiSwiglu, SOrder, true>((PG8_LAS unsigned char*)smem, g, S, E);
    __syncthreads();
}
__device__ __forceinline__ void ph_moe2(const PV& p, int l, char* smem) {
    const bool last = l == NLAYER - 1;
    pg8::Gemm g; g.A = wsp<const bf16_t>(p, OFF_BIG) + (size_t)NSLOT * D; g.Bt = wsp<const bf16_t>(p, OFF_BTW2) + (size_t)l * NEXP * D * D; g.lda = D; g.ldb = D; g.K = D; g.bstride = (size_t)D * D; g.gidx = nullptr;
    SOrder S; S.init(last ? LATS / 256 : NSLOT / 256, D / 256, 2);
    EpiStoreBf16 E; E.O = wsp<bf16_t>(p, OFF_BIG); E.ldc = D; E.rowscale = nullptr;
    __syncthreads();
    pg8::gemm_phase((PG8_LAS unsigned char*)smem, g, S, E);
    __syncthreads();
}

__device__ __forceinline__ void ph_combine(const PV& p, int l, int grp) {
    const int tid = TID(), lane = tid & 63, wid = tid >> 6;
    const bool last = l == NLAYER - 1;
    const bf16_t* Y = wsp<const bf16_t>(p, OFF_BIG); const int* inv = wsp<const int>(p, OFF_INV); const float* sgv = wsp<const float>(p, OFF_SGV);
    const int nrows = last ? BG * LQ : R, G = gridDim.x, rpc = (nrows + G - 1) / G;
    const int j0 = row_chunk_id() * rpc, j1 = (j0 + rpc < nrows) ? j0 + rpc : nrows;
    auto rowof = [&](int q) { return last ? (q / LQ) * TT + LC + (q % LQ) : q; };
    int invn = -1; u32x4 xn0 = {0u, 0u, 0u, 0u}, xn1 = {0u, 0u, 0u, 0u};
    if (j0 + wid < j1) { const int r0 = rowof(j0 + wid); if (lane < NEXP) invn = inv[(size_t)r0 * NEXP + lane];
        const bf16_t* x1p = wsp<const bf16_t>(p, OFF_X1) + (size_t)r0 * D; xn0 = *(const u32x4*)(x1p + lane * 8); xn1 = *(const u32x4*)(x1p + 512 + lane * 8); }
    int curkey = -1; f32x4 md[4], gsc[4], shv[4];
#pragma unroll
    for (int i = 0; i < 4; ++i) { md[i] = (f32x4){0.f, 0.f, 0.f, 0.f}; gsc[i] = md[i]; shv[i] = md[i]; }
    for (int q = j0 + wid; q < j1; q += 8) {
        const int r = rowof(q);
        const int bl = r / TT, pp = r % TT, b = grp * BG + bl, key = bl * 2 + (pp < LC ? 1 : 0);
        float* dst = stream_dst(p, b, pp);
        if (key != curkey) {
            const float* m5 = (pp < LC ? wsp<const float>(p, OFF_MODC) + (size_t)l * 6144 : wsp<const float>(p, OFF_MODX) + ((size_t)l * NB + b) * 6144) + 5 * D;
#pragma unroll
            for (int i = 0; i < 4; ++i) md[i] = *(const f32x4*)(m5 + (i >> 1) * 512 + lane * 8 + (i & 1) * 4);
            if (!last) {
                const float* gain = p.in(6) + (size_t)(l + 1) * D;
                const float* m1 = (pp < LC ? wsp<const float>(p, OFF_MODC) + (size_t)(l + 1) * 6144 : wsp<const float>(p, OFF_MODX) + ((size_t)(l + 1) * NB + b) * 6144);
#pragma unroll
                for (int i = 0; i < 4; ++i) { const int c = (i >> 1) * 512 + lane * 8 + (i & 1) * 4;
                    const f32x4 g = *(const f32x4*)(gain + c), sc = *(const f32x4*)(m1 + D + c); shv[i] = *(const f32x4*)(m1 + c);
#pragma unroll
                    for (int k = 0; k < 4; ++k) gsc[i][k] = g[k] * (1.0f + sc[k]); }
            }
            curkey = key;
        }
        const int myinv = invn; const u32x4 a0 = xn0, a1 = xn1;
        if (q + 8 < j1) { const int r1 = rowof(q + 8); if (lane < NEXP) invn = inv[(size_t)r1 * NEXP + lane];
            const bf16_t* x1p = wsp<const bf16_t>(p, OFF_X1) + (size_t)r1 * D; xn0 = *(const u32x4*)(x1p + lane * 8); xn1 = *(const u32x4*)(x1p + 512 + lane * 8); }
        f32x4 xr[4];
        xr[0] = (f32x4){__uint_as_float(a0[0] << 16), __uint_as_float(a0[0] & 0xffff0000u), __uint_as_float(a0[1] << 16), __uint_as_float(a0[1] & 0xffff0000u)};
        xr[1] = (f32x4){__uint_as_float(a0[2] << 16), __uint_as_float(a0[2] & 0xffff0000u), __uint_as_float(a0[3] << 16), __uint_as_float(a0[3] & 0xffff0000u)};
        xr[2] = (f32x4){__uint_as_float(a1[0] << 16), __uint_as_float(a1[0] & 0xffff0000u), __uint_as_float(a1[1] << 16), __uint_as_float(a1[1] & 0xffff0000u)};
        xr[3] = (f32x4){__uint_as_float(a1[2] << 16), __uint_as_float(a1[2] & 0xffff0000u), __uint_as_float(a1[3] << 16), __uint_as_float(a1[3] & 0xffff0000u)};
        float acc[16];
#pragma unroll
        for (int i = 0; i < 16; ++i) acc[i] = 0.f;
        unsigned long long mask = __ballot(myinv >= 0);
        while (mask) {
            const int e0 = __builtin_ctzll(mask); mask &= mask - 1;
            const bool two = mask != 0ull; const int e1 = two ? __builtin_ctzll(mask) : e0; if (two) mask &= mask - 1;
            const int s0 = __builtin_amdgcn_readfirstlane(__shfl(myinv, e0)), s1 = __builtin_amdgcn_readfirstlane(__shfl(myinv, e1));
            const float g0 = sgv[s0], g1 = two ? sgv[s1] : 0.0f;
            u32x4 w0[2], w1[2];
#pragma unroll
            for (int i = 0; i < 2; ++i) { w0[i] = *(const u32x4*)(Y + (size_t)s0 * D + i * 512 + lane * 8); w1[i] = *(const u32x4*)(Y + (size_t)s1 * D + i * 512 + lane * 8); }
#pragma unroll
            for (int i = 0; i < 2; ++i)
#pragma unroll
                for (int j = 0; j < 4; ++j) {
                    acc[i * 8 + 2 * j] += g0 * __uint_as_float(w0[i][j] << 16) + g1 * __uint_as_float(w1[i][j] << 16);
                    acc[i * 8 + 2 * j + 1] += g0 * __uint_as_float(w0[i][j] & 0xffff0000u) + g1 * __uint_as_float(w1[i][j] & 0xffff0000u);
                }
        }
        float ss = 0.f;
#pragma unroll
        for (int i = 0; i < 2; ++i)
#pragma unroll
            for (int j = 0; j < 2; ++j) {
                const int c = i * 512 + lane * 8 + j * 4;
                f32x4 x = xr[i * 2 + j];
#pragma unroll
                for (int k = 0; k < 4; ++k) { x[k] += md[i * 2 + j][k] * acc[i * 8 + j * 4 + k]; acc[i * 8 + j * 4 + k] = x[k]; ss += x[k] * x[k]; }
                *(f32x4*)(dst + c) = x;
            }
        if (!last) {
            ss = wave_sum(ss);
            const float rs = rsqrtf(ss * (1.0f / D) + 1e-6f);
            bf16_t* hx = wsp<bf16_t>(p, OFF_HX) + (size_t)r * D;
#pragma unroll
            for (int i = 0; i < 2; ++i) {
                const int c = i * 512 + lane * 8;
                float y[8];
#pragma unroll
                for (int j = 0; j < 2; ++j)
#pragma unroll
                    for (int k = 0; k < 4; ++k) y[j * 4 + k] = (acc[i * 8 + j * 4 + k] * rs) * gsc[i * 2 + j][k] + shv[i * 2 + j][k];
                u32x4 w; w[0] = pack2(y[0], y[1]); w[1] = pack2(y[2], y[3]); w[2] = pack2(y[4], y[5]); w[3] = pack2(y[6], y[7]);
                *(u32x4*)(hx + c) = w;
                int q0 = 0, q1 = 0;
                q0 = __builtin_amdgcn_cvt_pk_fp8_f32(y[0], y[1], q0, false); q0 = __builtin_amdgcn_cvt_pk_fp8_f32(y[2], y[3], q0, true);
                q1 = __builtin_amdgcn_cvt_pk_fp8_f32(y[4], y[5], q1, false); q1 = __builtin_amdgcn_cvt_pk_fp8_f32(y[6], y[7], q1, true);
                *(u32x2*)(wsp<unsigned char>(p, OFF_HX8) + (size_t)r * D + c) = (u32x2){(unsigned)q0, (unsigned)q1};
            }
        }
    }
}

#define XB_TMO      128
#define XB_XCNT(j)  (256  + 64 * (j))
#define XB_XSUB(j)  (1280 + 64 * (j))
#define XB_XGEN(j)  (2304 + 64 * (j))
#define XB_TOP      3328
#define XB_TOPGEN   3392
#define XCD_BAR_WORDS 3456
#define XB_SPIN_CAP (1u << 18)
#define LAS __attribute__((address_space(3)))

__device__ __forceinline__ unsigned xb_ld(unsigned* p)              { return __hip_atomic_load(p, __ATOMIC_RELAXED, __HIP_MEMORY_SCOPE_AGENT); }
__device__ __forceinline__ unsigned xb_add(unsigned* p, unsigned v) { return __hip_atomic_fetch_add(p, v, __ATOMIC_RELAXED, __HIP_MEMORY_SCOPE_AGENT); }
__device__ __forceinline__ unsigned xb_xcc_id() { return (unsigned)__builtin_amdgcn_s_getreg((3 << 11) | 20) & 0xFu; }
#define XB_SPIN(cond, bar) do { unsigned _sp = 0; while (cond) { __builtin_amdgcn_s_sleep(1); \
    if ((++_sp & 255u) == 0u) { if (xb_ld(&(bar)[XB_TMO])) break; if (_sp > XB_SPIN_CAP) { atomicAdd(&(bar)[XB_TMO], 1u); break; } } } } while (0)

struct XcdBarrier {
    unsigned* bar; unsigned x;
    volatile LAS unsigned* st;
};

__device__ __forceinline__ XcdBarrier xcd_barrier_post(unsigned* bar, volatile LAS unsigned* st) {
    XcdBarrier b; b.bar = bar; b.x = xb_xcc_id(); b.st = st;
    if (threadIdx.x == 0) (void)xb_add(&bar[XB_XCNT(b.x)], 1u);
    return b;
}
__device__ __forceinline__ void xcd_barrier_complete(unsigned* bar, unsigned x, unsigned& nloc, unsigned& nx) {
    const unsigned G = gridDim.x * gridDim.y * gridDim.z;
    unsigned sum, cnt, mine, sp = 0u;
    for (;;) {
        sum = 0u; cnt = 0u; mine = 0u;
#pragma unroll
        for (unsigned j = 0; j < 16; ++j) { const unsigned c = xb_ld(&bar[XB_XCNT(j)]); sum += c; cnt += (c > 0u) ? 1u : 0u; mine = (j == x) ? c : mine; }
        if (sum == G) break;
        __builtin_amdgcn_s_sleep(1);
        if ((++sp & 255u) == 0u) { if (xb_ld(&bar[XB_TMO])) break; if (sp > XB_SPIN_CAP) { atomicAdd(&bar[XB_TMO], 1u); break; } }
    }
    nloc = mine > 0u ? mine : 1u; nx = cnt > 0u ? cnt : 1u;
}

__device__ __forceinline__ void xcd_barrier(const XcdBarrier& b) {
    asm volatile("s_waitcnt vmcnt(0)" ::: "memory");
    __syncthreads();
    if (threadIdx.x == 0) {
        unsigned* bar = b.bar;
        unsigned bx = b.x; asm volatile("" : "+s"(bx));
        __builtin_amdgcn_s_waitcnt(0);
        unsigned nloc = b.st[0], nx = b.st[1];
        if (nloc == 0u) { xcd_barrier_complete(bar, bx, nloc, nx); b.st[0] = nloc; b.st[1] = nx; }
        const unsigned old = xb_add(&bar[XB_XSUB(bx)], 1u);
        const unsigned gen = old / nloc;
        if (old + 1u == (gen + 1u) * nloc) {
            __builtin_amdgcn_fence(__ATOMIC_RELEASE, "agent");
            asm volatile("s_waitcnt vmcnt(0)" ::: "memory");
            const unsigned og = xb_add(&bar[XB_TOP], 1u);
            const unsigned tg = og / nx;
            if (og + 1u == (tg + 1u) * nx) xb_add(&bar[XB_TOPGEN], 1u);
            else XB_SPIN(xb_ld(&bar[XB_TOPGEN]) == tg, bar);
            __builtin_amdgcn_fence(__ATOMIC_ACQUIRE, "agent");
            xb_add(&bar[XB_XGEN(bx)], 1u);
            asm volatile("s_waitcnt vmcnt(0)" ::: "memory");
        } else {
            XB_SPIN(xb_ld(&bar[XB_XGEN(bx)]) == gen, bar);
            __builtin_amdgcn_fence(__ATOMIC_ACQUIRE, "agent");
            asm volatile("s_waitcnt vmcnt(0)" ::: "memory");
        }
    }
    __syncthreads();
}


#define GRID_SYNC() xcd_barrier(bar)
__global__ void __launch_bounds__(NTHR, 2) k_fused(P pk) {
    extern __shared__ __attribute__((aligned(16))) char smem[];
    volatile LAS unsigned* xbw = (volatile LAS unsigned*)(smem + SMEM_BYTES);
    if (threadIdx.x == 0) { xbw[0] = 0u; xbw[1] = 0u; xbw[2] = 0u; xbw[3] = 0u; }
    {
        LAS unsigned* tab = (LAS unsigned*)(smem + SMEM_BYTES + 16);
        if (threadIdx.x == 0) {
#pragma unroll
            for (int i = 0; i < 35; ++i) {
                const unsigned long long v = i < 33 ? (unsigned long long)pk.in[i < 33 ? i : 0] : (i == 33 ? (unsigned long long)pk.out : (unsigned long long)pk.ws);
                tab[2 * i] = (unsigned)v; tab[2 * i + 1] = (unsigned)(v >> 32);
            }
        }
    }
    __syncthreads();
    PV p; p.tab = (const LAS unsigned*)(smem + SMEM_BYTES + 16);
    XcdBarrier bar = xcd_barrier_post(wsp<unsigned>(p, OFF_BAR), xbw);
    ph_mod(p, smem);
    ph_hfilt(p, smem);
    ph_weights(p, smem);
    GRID_SYNC();
    ph_hcopies(p);
#pragma unroll 1
    for (int grp = 0; grp < NGRP; ++grp) {
#pragma unroll 1
        for (int l = 0; l < NLAYER; ++l) {
            if (l == 0 && grp == 0) { ph_norm1(p, l, grp); GRID_SYNC(); }
            ph_g1(p, l, smem); GRID_SYNC();
            ph_attn_prep(p, l, smem); ph_hy_prep(p, l, smem); GRID_SYNC();
            ph_branches(p, l, grp * NLAYER + l, smem); GRID_SYNC();
            ph_gated(p, l); ph_hy_unprep(p, smem); GRID_SYNC();
            ph_branchmm(p, l, smem); GRID_SYNC();
            ph_merge(p, l, smem); GRID_SYNC();
            ph_wout(p, l, grp, smem); GRID_SYNC();
            ph_norm2(p, l, grp, smem); GRID_SYNC();
            ph_topk(p, l, smem); GRID_SYNC();
            ph_moe1(p, l, smem); GRID_SYNC();
            ph_moe2(p, l, smem); GRID_SYNC();
            ph_combine(p, l, grp);
            if (l == NLAYER - 1 && grp + 1 < NGRP) ph_norm1(p, 0, grp + 1);
            GRID_SYNC();
        }
    }
}

extern "C" void kernel_launch(void* const* d_in, const int* in_sizes, int n_in, void* d_out, int out_size, void* d_ws, size_t ws_size, hipStream_t stream) {
    P p{};
    for (int i = 0; i < 33; ++i) p.in[i] = (const float*)d_in[i];
    p.out = (float*)d_out; p.ws = (char*)d_ws;
    static int grid = 0;
    if (!grid) {
        int dev = 0, cus = 0, per_cu = 0;
        (void)hipGetDevice(&dev);
        (void)hipDeviceGetAttribute(&cus, hipDeviceAttributeMultiprocessorCount, dev);
        (void)hipFuncSetAttribute((const void*)k_fused, hipFuncAttributeMaxDynamicSharedMemorySize, SMEM_TOTAL);
        (void)hipOccupancyMaxActiveBlocksPerMultiprocessor(&per_cu, k_fused, NTHR, SMEM_TOTAL);
        grid = cus * (per_cu < 1 ? per_cu : 1);
        if (grid <= 0) grid = 256;
    }
    (void)hipMemsetAsync(d_ws, 0, 16384, stream);
    k_fused<<<grid, NTHR, SMEM_TOTAL, stream>>>(p);
}
```
